# Optimizing an MI355X kernel written in HIP

```python
import jax, jax.numpy as jnp
from jax import lax
import numpy as np

D_MODEL = 4096
BATCH = 8
SEQ = 2048
DEPTH = 2
DEC_BATCH = 4
DEC_SEQ = 4096
PAST_LEN = 128

CHUNK = 128
D_A = D_MODEL // 2
A_HEAD_DIM = 128
A_HEADS = D_A // A_HEAD_DIM
D_B = D_MODEL // 2
B_GROUPS = 8
B_GROUP_DIM = D_B // B_GROUPS
D_IN = 3 * D_A + 2 * D_B + 2 * D_MODEL
SPLITS = (D_A, 2 * D_A, 3 * D_A, 3 * D_A + D_B, 3 * D_A + 2 * D_B, 3 * D_A + 2 * D_B + D_MODEL)
EPS = 1e-6

kernel_name = "gated_gmlp_fnet_hybrid_encoder"


def rms_norm(x, g):
    xf = x.astype(jnp.float32)
    y = xf * lax.rsqrt(jnp.mean(xf * xf, axis=-1, keepdims=True) + EPS)
    return (y * g.astype(jnp.float32)).astype(x.dtype)


def layer_norm(x, g, b):
    xf = x.astype(jnp.float32)
    mu = jnp.mean(xf, axis=-1, keepdims=True)
    xc = xf - mu
    var = jnp.mean(xc * xc, axis=-1, keepdims=True)
    y = xc * lax.rsqrt(var + EPS)
    return (y * g.astype(jnp.float32) + b.astype(jnp.float32)).astype(x.dtype)


def spatial_gating_branch(u, v, z, ln_g, ln_b, w_s, b_s):
    bsz, s, _ = u.shape
    u = jax.nn.gelu(u)
    v = layer_norm(jax.nn.gelu(v), ln_g, ln_b)
    vc = v.reshape(bsz, s // CHUNK, CHUNK, A_HEADS, A_HEAD_DIM)
    mixed = jnp.einsum('hpq,bcqhd->bcphd', w_s, vc) + jnp.transpose(b_s)[None, None, :, :, None]
    mixed = mixed.reshape(bsz, s, D_A)
    return u * mixed * jax.nn.silu(z)


def fourier_branch(xb, z):
    bsz, s, _ = xb.shape
    xg = xb.astype(jnp.float32).reshape(bsz, s, B_GROUPS, B_GROUP_DIM)
    f = jnp.fft.fft2(xg, axes=(1, 3), norm='ortho').real
    f = f.reshape(bsz, s, D_B).astype(xb.dtype)
    return f * jax.nn.silu(z)


def mixer_layer(x, norm_g, w_in, sgu_ln_g, sgu_ln_b, w_spatial, b_spatial, w_a, w_b, b_gate, w_out):
    h = rms_norm(x, norm_g)
    p = jnp.einsum('bsd,de->bse', h, w_in)
    u, v, z_a, xb, z_b, g_a, g_b = jnp.split(p, SPLITS, axis=-1)
    y_a = jnp.einsum('bsc,cd->bsd', spatial_gating_branch(u, v, z_a, sgu_ln_g, sgu_ln_b, w_spatial, b_spatial), w_a)
    y_b = jnp.einsum('bsc,cd->bsd', fourier_branch(xb, z_b), w_b)
    m = jax.nn.sigmoid(g_a + b_gate[0]) * y_a + jax.nn.sigmoid(g_b + b_gate[1]) * y_b
    return x + jnp.einsum('bsd,de->bse', m, w_out)


def trunk(x, norm_g, w_in, sgu_ln_g, sgu_ln_b, w_spatial, b_spatial, w_a, w_b, b_gate, w_out, final_g):
    for l in range(DEPTH):
        x = mixer_layer(x, norm_g[l], w_in[l], sgu_ln_g[l], sgu_ln_b[l], w_spatial[l], b_spatial[l],
                        w_a[l], w_b[l], b_gate[l], w_out[l])
    return rms_norm(x, final_g)


def setup_inputs(seed: int = 0) -> dict:
    key = jax.random.key(seed)
    ks = jax.random.split(key, 14)
    f32 = jnp.float32
    x_prompt = jax.random.normal(ks[0], (BATCH, SEQ, D_MODEL), f32)
    x_sample = jax.random.normal(ks[1], (DEC_BATCH, DEC_SEQ, D_MODEL), f32)
    norm_g = 1.0 + 0.02 * jax.random.normal(ks[2], (DEPTH, D_MODEL), f32)
    w_in = jax.random.normal(ks[3], (DEPTH, D_MODEL, D_IN), f32) * D_MODEL ** -0.5
    sgu_ln_g = 1.0 + 0.02 * jax.random.normal(ks[4], (DEPTH, D_A), f32)
    sgu_ln_b = 0.02 * jax.random.normal(ks[5], (DEPTH, D_A), f32)
    w_spatial = jax.random.normal(ks[6], (DEPTH, A_HEADS, CHUNK, CHUNK), f32) * CHUNK ** -0.5
    b_spatial = 1.0 + 0.02 * jax.random.normal(ks[7], (DEPTH, A_HEADS, CHUNK), f32)
    w_a = jax.random.normal(ks[8], (DEPTH, D_A, D_MODEL), f32) * D_A ** -0.5
    w_b = jax.random.normal(ks[9], (DEPTH, D_B, D_MODEL), f32) * D_B ** -0.5
    b_gate = 0.02 * jax.random.normal(ks[10], (DEPTH, 2, D_MODEL), f32)
    w_out = jax.random.normal(ks[11], (DEPTH, D_MODEL, D_MODEL), f32) * D_MODEL ** -0.5
    final_g = 1.0 + 0.02 * jax.random.normal(ks[12], (D_MODEL,), f32)
    return {"x_prompt": x_prompt, "x_sample": x_sample, "norm_g": norm_g, "w_in": w_in,
            "sgu_ln_g": sgu_ln_g, "sgu_ln_b": sgu_ln_b, "w_spatial": w_spatial, "b_spatial": b_spatial,
            "w_a": w_a, "w_b": w_b, "b_gate": b_gate, "w_out": w_out, "final_g": final_g}


def reference(x_prompt, x_sample, norm_g, w_in, sgu_ln_g, sgu_ln_b, w_spatial, b_spatial, w_a, w_b, b_gate, w_out, final_g):
    y_prompt = trunk(x_prompt, norm_g, w_in, sgu_ln_g, sgu_ln_b, w_spatial, b_spatial, w_a, w_b, b_gate, w_out, final_g)
    y_sample = trunk(x_sample, norm_g, w_in, sgu_ln_g, sgu_ln_b, w_spatial, b_spatial, w_a, w_b, b_gate, w_out, final_g)
    return (y_prompt, y_sample)
```

```cpp
#include <hip/hip_runtime.h>
#include <cstdio>
#include <cstdint>

#ifndef MK_PER_PHASE
#define MK_PER_PHASE 0
#endif

#define GAS __attribute__((address_space(1)))
#define LAS __attribute__((address_space(3)))
typedef unsigned short bf16;
typedef unsigned v4u __attribute__((ext_vector_type(4)));
typedef unsigned v2u __attribute__((ext_vector_type(2)));
typedef float f32x4 __attribute__((ext_vector_type(4)));
typedef float f32x2 __attribute__((ext_vector_type(2)));
typedef short bf16x8 __attribute__((ext_vector_type(8)));
typedef GAS unsigned gu32;

constexpr int DM = 4096, DIN = 18432, DA = 2048, DB = 2048;
constexpr int MPR = 16384;
constexpr int MTOT = 32768;
constexpr int LDP = DIN;
constexpr int C_U = 0, C_GV = 2048, C_ZA = 4096, C_XB = 6144, C_ZB = 8192, C_GA = 10240, C_GB = 14336;
constexpr float EPS = 1e-6f;
constexpr int NWAVES = 8;
constexpr int N_PHASES = 15;

constexpr size_t MiB = 1u << 20;
constexpr size_t WS_CTL = 0, CTL_ZERO_BYTES = 32768;
constexpr size_t WS_W1T = 1 * MiB;
constexpr size_t WS_WAT = 145 * MiB;
constexpr size_t WS_WBT = 161 * MiB;
constexpr size_t WS_WOT = 177 * MiB;
constexpr size_t WS_DC = 210 * MiB;
constexpr size_t WS_TW = 212 * MiB;
constexpr size_t WS_T = 211 * MiB;
constexpr size_t WS_RSTD = 213 * MiB;
constexpr size_t WS_PART = 291 * MiB;
constexpr size_t WS_H = 300 * MiB;
constexpr size_t WS_P = 556 * MiB;
constexpr size_t WS_Z = 1708 * MiB;
constexpr size_t WS_X1 = 1964 * MiB;
constexpr size_t WS_END = 2220 * MiB;
constexpr int CW_BAR = 4096;

constexpr int RING_OFF = 0, RING_BYTES = 131072;
constexpr int LDSCTL_OFF = RING_BYTES, MISC_OFF = LDSCTL_OFF + 320;
constexpr int STAT_OFF = RING_BYTES + 1024;
constexpr int RS_OFF = RING_BYTES + 4096;
constexpr int LDS_BYTES = 147456;

#define RLX_AGENT __ATOMIC_RELAXED, __HIP_MEMORY_SCOPE_AGENT
#define LDS_WAIT() asm volatile("s_waitcnt lgkmcnt(0)" ::: "memory")
#define VM_WAIT() asm volatile("s_waitcnt vmcnt(0)" ::: "memory")

typedef __bf16 bf16x2_t __attribute__((ext_vector_type(2)));
__device__ __forceinline__ unsigned cvt_pk_bf16(float lo, float hi) { const f32x2 v = {lo, hi}; const bf16x2_t b = __builtin_convertvector(v, bf16x2_t); return __builtin_bit_cast(unsigned, b); }
__device__ __forceinline__ int lane_id() { return (int)__builtin_amdgcn_mbcnt_hi(~0u, __builtin_amdgcn_mbcnt_lo(~0u, 0u)); }
__device__ __forceinline__ float bf_lo(unsigned w) { return __builtin_bit_cast(float, w << 16); }
__device__ __forceinline__ float bf_hi(unsigned w) { return __builtin_bit_cast(float, w & 0xffff0000u); }
__device__ __forceinline__ float bf2f(bf16 b) { return __builtin_bit_cast(float, ((unsigned)b) << 16); }
__device__ __forceinline__ unsigned f2bf(float f) { unsigned u = __builtin_bit_cast(unsigned, f); return (u + 0x7fffu + ((u >> 16) & 1u)) >> 16; }
__device__ __forceinline__ unsigned pk2(float lo, float hi) { return f2bf(lo) | (f2bf(hi) << 16); }

namespace pg8 {
constexpr int BM = 256, BK = 64, HALF = 128, HTB = HALF * BK * 2, STAGE_BYTES = 8 * HTB, NXCD = 8, WGM = 8;
__host__ __device__ __forceinline__ int lds_byte(int r, int c) { const int st = (r >> 4) * 2 + (c >> 5), rr = r & 15, cc = c & 31, ob = rr * 64 + cc * 2; return st * 1024 + (ob ^ (((ob >> 9) & 1) << 5)); }
__host__ __device__ __forceinline__ void stage_rc(int b, int& R, int& C) { const int st = b / 1024, sb = b % 1024, swz = sb ^ (((sb >> 9) & 1) << 5); R = (st >> 1) * 16 + swz / 64; C = (st & 1) * 32 + (swz % 64) / 2; }
__host__ __device__ __forceinline__ int perm32(int rho) { const int n = rho >> 4, i = rho & 15; return 8 * (i >> 2) + 4 * n + (i & 3); }

struct Unit { const char* a; const char* b; int pm, pn, aux; };

struct OrderMN {
    int nM, nN, nwg, G, c; const char* A; const char* B; size_t tA, tB;
    __device__ __forceinline__ void init(int nM_, int nN_, int G_, int c_, const void* A_, size_t tA_, const void* B_, size_t tB_) { nM = nM_; nN = nN_; nwg = nM * nN; G = G_; c = c_; A = (const char*)A_; B = (const char*)B_; tA = tA_; tB = tB_; }
    __device__ __forceinline__ bool next(int i, Unit& u) const {
        const long L = (long)i * G + c; if (L >= nwg) return false;
        int wgid = (int)L; { const int q = nwg / NXCD, r = nwg % NXCD, xcd = wgid % NXCD, off = wgid / NXCD; wgid = (xcd < r ? xcd * (q + 1) : r * (q + 1) + (xcd - r) * q) + off; }
        const int nig = WGM * nN, gid = wgid / nig, fm = gid * WGM, gsz = (nM - fm) < WGM ? (nM - fm) : WGM;
        u.pm = fm + ((wgid % nig) % gsz); u.pn = (wgid % nig) / gsz; u.aux = 0;
        u.a = A + (size_t)u.pm * tA; u.b = B + (size_t)u.pn * tB; return true;
    }
    __device__ __forceinline__ void a_ready(const Unit&) const {}
    __device__ __forceinline__ void done(const Unit&) const {}
};

template <class Epi, class Sched, bool ALIGN_EPI, bool SP2>
__device__ __forceinline__ void gemm_phase(const int ws_, LAS unsigned char* lds, const int lda, const int ldb, const int K, const Sched& S, const Epi& E) {
    int tid_ = (ws_ << 6) | lane_id(); asm volatile("" : "+v"(tid_));
    const int tid = tid_, wid = __builtin_amdgcn_readfirstlane(tid >> 6), lane = tid & 63, wr = wid >> 2, wc = wid & 3, fr = lane & 15, fq = lane >> 4;
    const int nt = K / BK;
    unsigned voffA[2], voffB[2];
#pragma unroll
    for (int i = 0; i < 2; ++i) { int R, C; stage_rc(tid * 16 + i * 8192, R, C); const int Rb = Epi::PERM ? ((R & ~31) + perm32(R & 31)) : R;
        voffA[i] = (unsigned)(R * lda + C) * 2u; voffB[i] = (unsigned)(Rb * ldb + C) * 2u; }
    const size_t kstep = (size_t)(BK * 2);
    const size_t hstepA = (size_t)HALF * lda * 2, hstepB = (size_t)HALF * ldb * 2;
    const unsigned ldsw = (unsigned)wid * 1024u;
    const int aoff = lds_byte(wr * 64 + fr, fq * 8), boff = lds_byte(wc * 32 + fr, fq * 8);
#define PG8_SA(b, h) (((b) * 2 + (h)) * HTB)
#define PG8_SB(b, h) ((4 + (b) * 2 + (h)) * HTB)
#define PG8_STAGE(bufoff, gbase, voff) do { _Pragma("unroll") for (int _i = 0; _i < 2; ++_i) \
        __builtin_amdgcn_global_load_lds((const unsigned*)((const char*)(gbase) + (voff)[_i]), (LAS unsigned*)(lds + (bufoff) + ldsw + _i * 8192), 16, 0, 0); } while (0)
#define PG8_LDA(dst, b, h) do { _Pragma("unroll") for (int m = 0; m < 4; ++m) _Pragma("unroll") for (int k = 0; k < 2; ++k) dst[m][k] = *(const LAS bf16x8*)(lds + PG8_SA(b, h) + aoff + m * 2048 + k * 1024); } while (0)
#define PG8_LDB(dst, b, h) do { _Pragma("unroll") for (int n = 0; n < 2; ++n) _Pragma("unroll") for (int k = 0; k < 2; ++k) dst[n][k] = *(const LAS bf16x8*)(lds + PG8_SB(b, h) + boff + n * 2048 + k * 1024); } while (0)
#define PG8_MMA(ai, bj, At, Bt) do { __builtin_amdgcn_s_setprio(1); _Pragma("unroll") for (int m = 0; m < 4; ++m) _Pragma("unroll") for (int n = 0; n < 2; ++n) _Pragma("unroll") for (int k = 0; k < 2; ++k) \
        acc[ai][bj][m][n] = __builtin_amdgcn_mfma_f32_16x16x32_bf16(Bt[n][k], At[m][k], acc[ai][bj][m][n], 0, 0, 0); __builtin_amdgcn_s_setprio(0); } while (0)
#define PG8_WAIT_V(n) asm volatile("s_waitcnt vmcnt(" #n ")" ::: "memory")
#define PG8_WAIT_L(n) asm volatile("s_waitcnt lgkmcnt(" #n ")" ::: "memory")
#define PG8_BAR __builtin_amdgcn_s_barrier()
#define PG8_SCHED __builtin_amdgcn_sched_barrier(0)
    Unit cur, nxt; int ui = 0;
    if (!S.next(0, cur)) return;
    float carry = 0.f;
    if constexpr (Epi::CARRY) carry = E.pre(cur, tid);
    f32x4 acc[2][2][4][2];
#pragma unroll
    for (int a = 0; a < 2; ++a)
#pragma unroll
        for (int b = 0; b < 2; ++b)
#pragma unroll
            for (int m = 0; m < 4; ++m)
#pragma unroll
                for (int n = 0; n < 2; ++n) acc[a][b][m][n] = (f32x4){0.f, 0.f, 0.f, 0.f};
    bf16x8 At[4][2], B0[2][2], B1[2][2];
    const char* cA = cur.a; const char* cB = cur.b;
    S.a_ready(cur);
    if constexpr (SP2) {
        PG8_STAGE(PG8_SB(0, 0), cB, voffB); PG8_STAGE(PG8_SB(0, 1), cB + hstepB, voffB); PG8_STAGE(PG8_SA(0, 0), cA, voffA); PG8_STAGE(PG8_SA(0, 1), cA + hstepA, voffA);
        if (wr == 1) PG8_BAR;
        PG8_WAIT_V(2); PG8_BAR;
        PG8_STAGE(PG8_SB(1, 0), cB + kstep, voffB); PG8_STAGE(PG8_SA(1, 0), cA + kstep, voffA); PG8_STAGE(PG8_SB(1, 1), cB + hstepB + kstep, voffB);
        PG8_WAIT_V(6); PG8_BAR;
    } else {
        PG8_STAGE(PG8_SB(0, 0), cB, voffB); PG8_STAGE(PG8_SA(0, 0), cA, voffA); PG8_STAGE(PG8_SB(0, 1), cB + hstepB, voffB); PG8_STAGE(PG8_SA(0, 1), cA + hstepA, voffA);
        if (wr == 1) PG8_BAR;
        PG8_WAIT_V(4); PG8_BAR;
        PG8_STAGE(PG8_SB(1, 0), cB + kstep, voffB); PG8_STAGE(PG8_SA(1, 0), cA + kstep, voffA); PG8_STAGE(PG8_SB(1, 1), cB + hstepB + kstep, voffB);
        PG8_WAIT_V(6); PG8_BAR;
    }
    for (;;) {
        const bool has_next = S.next(ui + 1, nxt);
        const char* nA = has_next ? nxt.a : cA; const char* nB = has_next ? nxt.b : cB;
        for (int t = 0; t < nt; t += 2) {
            const bool last = (t == nt - 2);
            const char* a1 = cA + (size_t)(t + 1) * kstep;
            const char* a2 = last ? nA : cA + (size_t)(t + 2) * kstep; const char* b2 = last ? nB : cB + (size_t)(t + 2) * kstep;
            const char* a3 = a2 + kstep; const char* b3 = b2 + kstep;
            if (last && has_next) S.a_ready(nxt);
            if constexpr (SP2) {
            PG8_LDB(B0, 0, 0); PG8_LDB(B1, 0, 1); PG8_SCHED; PG8_LDA(At, 0, 0); PG8_STAGE(PG8_SA(1, 1), a1 + hstepA, voffA);
            PG8_WAIT_V(8); PG8_WAIT_L(0); PG8_BAR; PG8_MMA(0, 0, At, B0); PG8_MMA(0, 1, At, B1); PG8_BAR; PG8_SCHED;
            PG8_LDA(At, 0, 1); PG8_STAGE(PG8_SB(0, 0), b2, voffB); PG8_STAGE(PG8_SB(0, 1), b2 + hstepB, voffB); PG8_STAGE(PG8_SA(0, 0), a2, voffA);
            PG8_WAIT_V(8); PG8_WAIT_L(0); PG8_BAR; PG8_MMA(1, 0, At, B0); PG8_MMA(1, 1, At, B1); PG8_BAR; PG8_SCHED;
            PG8_LDB(B0, 1, 0); PG8_LDB(B1, 1, 1); PG8_SCHED; PG8_LDA(At, 1, 0); PG8_STAGE(PG8_SA(0, 1), a2 + hstepA, voffA);
            PG8_WAIT_V(8); PG8_WAIT_L(0); PG8_BAR; PG8_MMA(0, 0, At, B0); PG8_MMA(0, 1, At, B1); PG8_BAR; PG8_SCHED;
            PG8_LDA(At, 1, 1); PG8_STAGE(PG8_SB(1, 0), b3, voffB); PG8_STAGE(PG8_SB(1, 1), b3 + hstepB, voffB); PG8_STAGE(PG8_SA(1, 0), a3, voffA);
            PG8_WAIT_V(8); PG8_WAIT_L(0); PG8_BAR; PG8_MMA(1, 0, At, B0); PG8_MMA(1, 1, At, B1); PG8_BAR; PG8_SCHED;
            } else {
            PG8_LDB(B0, 0, 0); PG8_SCHED; PG8_LDA(At, 0, 0); PG8_STAGE(PG8_SA(1, 1), a1 + hstepA, voffA);
            PG8_WAIT_L(8); PG8_BAR; PG8_WAIT_L(0); PG8_MMA(0, 0, At, B0); PG8_BAR; PG8_SCHED;
            PG8_LDB(B1, 0, 1); PG8_STAGE(PG8_SB(0, 0), b2, voffB);
            PG8_BAR; PG8_WAIT_L(0); PG8_MMA(0, 1, At, B1); PG8_BAR;
            PG8_LDA(At, 0, 1); PG8_STAGE(PG8_SA(0, 0), a2, voffA);
            PG8_BAR; PG8_WAIT_L(0); PG8_MMA(1, 0, At, B0); PG8_BAR; PG8_SCHED;
            PG8_STAGE(PG8_SB(0, 1), b2 + hstepB, voffB);
            PG8_WAIT_V(6); PG8_BAR; PG8_MMA(1, 1, At, B1); PG8_BAR;
            PG8_LDB(B0, 1, 0); PG8_SCHED; PG8_LDA(At, 1, 0); PG8_STAGE(PG8_SA(0, 1), a2 + hstepA, voffA);
            PG8_WAIT_L(8); PG8_BAR; PG8_WAIT_L(0); PG8_MMA(0, 0, At, B0); PG8_BAR; PG8_SCHED;
            PG8_LDB(B1, 1, 1); PG8_STAGE(PG8_SB(1, 0), b3, voffB);
            PG8_BAR; PG8_WAIT_L(0); PG8_MMA(0, 1, At, B1); PG8_BAR;
            PG8_LDA(At, 1, 1); PG8_STAGE(PG8_SA(1, 0), a3, voffA);
            PG8_BAR; PG8_WAIT_L(0); PG8_MMA(1, 0, At, B0); PG8_BAR; PG8_SCHED;
            PG8_STAGE(PG8_SB(1, 1), b3 + hstepB, voffB);
            PG8_WAIT_V(6); PG8_BAR; PG8_MMA(1, 1, At, B1); PG8_BAR;
            }
        }
        if constexpr (ALIGN_EPI) { if (wr == 0) PG8_BAR; }
        { int l2 = lane_id(); asm volatile("" : "+v"(l2));
          if constexpr (Epi::CARRY) { E(acc, cur, wr, wc, l2 & 15, l2 >> 4, carry, (wid << 6) | l2); if (has_next) carry = E.pre(nxt, (wid << 6) | l2); }
          else E(acc, cur, wr, wc, l2 & 15, l2 >> 4); }
        S.done(cur);
        if (!has_next) break;
        bool zero_acc = true;
        if constexpr (Epi::KEEP) zero_acc = !E.keep(cur);
        if (zero_acc) {
#pragma unroll
        for (int a = 0; a < 2; ++a)
#pragma unroll
            for (int b = 0; b < 2; ++b)
#pragma unroll
                for (int m = 0; m < 4; ++m)
#pragma unroll
                    for (int n = 0; n < 2; ++n) acc[a][b][m][n] = (f32x4){0.f, 0.f, 0.f, 0.f};
        }
        cur = nxt; cA = nA; cB = nB; ++ui;
        if constexpr (ALIGN_EPI) { if (wr == 1) PG8_BAR; }
    }
    PG8_WAIT_V(0);
    if constexpr (!ALIGN_EPI) { if (wr == 0) PG8_BAR; }
    PG8_BAR;
#undef PG8_SA
#undef PG8_SB
#undef PG8_STAGE
#undef PG8_LDA
#undef PG8_LDB
#undef PG8_MMA
#undef PG8_WAIT_V
#undef PG8_WAIT_L
#undef PG8_BAR
#undef PG8_SCHED
}
}

#ifndef PG8_SP2
#define PG8_SP2 true
#endif
#ifndef PG8_ALIGN
#define PG8_ALIGN true
#endif
using pg8::Unit;
typedef const f32x4 (&AccRef)[2][2][4][2];
typedef f32x4 (&AccMut)[2][2][4][2];

__device__ __forceinline__ float act_one(float x, float c1, float c3, float off, bool mulx) {
    const float t = fmaf(x, fmaf(c3, x * x, c1), off);
    const float e = __builtin_amdgcn_exp2f(t * -1.4426950408889634f);
    const float sg = __builtin_amdgcn_rcpf(1.0f + e);
    return (mulx ? x : 1.0f) * sg;
}
template <bool SCALE> __device__ __forceinline__ void epi1_gate(AccRef acc, bf16* P, const float* bgate, const LAS float* rs, int pm, int t, int wr, int wc, int fr, int fq) {
    const int row0 = pm * 256 + wr * 64 + fr, cw = t * 128 + wc * 32 + 8 * fq;
    float rsv[2][4];
#pragma unroll
    for (int ai = 0; ai < 2; ++ai)
#pragma unroll
        for (int m = 0; m < 4; ++m) rsv[ai][m] = SCALE ? rs[wr * 64 + fr + ai * 128 + m * 16] : 1.0f;
    f32x4 ba[2], bb[2];
#pragma unroll
    for (int n = 0; n < 2; ++n) { ba[n] = *(const f32x4*)(bgate + cw + 4 * n) * -1.4426950408889634f; bb[n] = *(const f32x4*)(bgate + DM + cw + 4 * n) * -1.4426950408889634f; }
#pragma unroll
    for (int ai = 0; ai < 2; ++ai)
#pragma unroll
        for (int m = 0; m < 4; ++m) {
            const int row = row0 + ai * 128 + m * 16; bf16* rowp = P + (size_t)row * LDP + cw;
            float orr[8], og[8];
#pragma unroll
            for (int n = 0; n < 2; ++n)
#pragma unroll
                for (int j = 0; j < 4; ++j) { const float xa = SCALE ? acc[ai][0][m][n][j] * rsv[ai][m] : acc[ai][0][m][n][j], xb = SCALE ? acc[ai][1][m][n][j] * rsv[ai][m] : acc[ai][1][m][n][j];
                    const float da = 1.0f + __builtin_amdgcn_exp2f(fmaf(xa, -1.4426950408889634f, ba[n][j]));
                    const float db = 1.0f + __builtin_amdgcn_exp2f(fminf(fmaf(xb, -1.4426950408889634f, bb[n][j]), 64.0f));
                    og[4 * n + j] = __builtin_amdgcn_rcpf(db); orr[4 * n + j] = db * __builtin_amdgcn_rcpf(da); }
            v4u w; w.x = cvt_pk_bf16(orr[0], orr[1]); w.y = cvt_pk_bf16(orr[2], orr[3]); w.z = cvt_pk_bf16(orr[4], orr[5]); w.w = cvt_pk_bf16(orr[6], orr[7]);
            *(v4u*)(rowp + C_GA) = w;
            v4u g; g.x = cvt_pk_bf16(og[0], og[1]); g.y = cvt_pk_bf16(og[2], og[3]); g.z = cvt_pk_bf16(og[4], og[5]); g.w = cvt_pk_bf16(og[6], og[7]);
            *(v4u*)(rowp + C_GB) = g;
        }
}
template <int MODE, bool STATS, bool SCALE> __device__ __forceinline__ void epi1_body(AccRef acc, bf16* P, const float* bgate, f32x2* part, const LAS float* rs, int pm, int pn, int wr, int wc, int fr, int fq) {
    const int row0 = pm * 256 + wr * 64 + fr, col0 = pn * 256 + wc * 32 + 8 * fq;
    float rsv[2][4];
#pragma unroll
    for (int ai = 0; ai < 2; ++ai)
#pragma unroll
        for (int m = 0; m < 4; ++m) rsv[ai][m] = SCALE ? rs[wr * 64 + fr + ai * 128 + m * 16] : 1.0f;
    f32x4 bv[2][2];
    if (MODE == 3) {
#pragma unroll
        for (int bj = 0; bj < 2; ++bj)
#pragma unroll
            for (int n = 0; n < 2; ++n) bv[bj][n] = *(const f32x4*)(bgate + (col0 - C_GA) + bj * 128 + 4 * n) * -1.4426950408889634f;
    }
#pragma unroll
    for (int ai = 0; ai < 2; ++ai)
#pragma unroll
        for (int m = 0; m < 4; ++m) {
            const int row = row0 + ai * 128 + m * 16; bf16* rowp = P + (size_t)row * LDP + col0; float rs = 0.f, rq = 0.f;
#pragma unroll
            for (int bj = 0; bj < 2; ++bj) {
                float o[8];
#pragma unroll
                for (int n = 0; n < 2; ++n)
#pragma unroll
                    for (int j = 0; j < 4; ++j) { const float x = SCALE ? acc[ai][bj][m][n][j] * rsv[ai][m] : acc[ai][bj][m][n][j]; float r;
                        if (MODE == 0) { const float t = x * fmaf(-0.10294324576f, x * x, -2.3022081985f); r = x * __builtin_amdgcn_rcpf(1.0f + __builtin_amdgcn_exp2f(t)); }
                        else if (MODE == 1) { r = x * __builtin_amdgcn_rcpf(1.0f + __builtin_amdgcn_exp2f(x * -1.4426950408889634f)); }
                        else if (MODE == 2) { r = x; }
                        else { r = __builtin_amdgcn_rcpf(1.0f + __builtin_amdgcn_exp2f(fmaf(x, -1.4426950408889634f, bv[bj][n][j]))); }
                        o[4 * n + j] = r; if (STATS) { rs += r; rq += r * r; } }
                v4u w; w.x = cvt_pk_bf16(o[0], o[1]); w.y = cvt_pk_bf16(o[2], o[3]); w.z = cvt_pk_bf16(o[4], o[5]); w.w = cvt_pk_bf16(o[6], o[7]);
                *(v4u*)(rowp + bj * 128) = w;
            }
            if (STATS) { rs += __shfl_xor(rs, 16); rs += __shfl_xor(rs, 32); rq += __shfl_xor(rq, 16); rq += __shfl_xor(rq, 32);
                if (fq == 0) part[(size_t)((pn - 8) * 4 + wc) * MTOT + row] = (f32x2){rs, rq}; }
        }
}
template <bool SCALE> struct Epi1 {
    static constexpr bool PERM = true; static constexpr bool KEEP = false; static constexpr bool CARRY = SCALE;
    bf16* P; const float* bgate; f32x2* part; const float* rs; LAS float* rsl;
    __device__ __forceinline__ float pre(const Unit& u, int tid) const { return rs[u.pm * 256 + (tid & 255)]; }
    __device__ __forceinline__ void body(AccRef acc, const Unit& u, int wr, int wc, int fr, int fq) const {
        const int pn = u.pn;
        if (pn < 8) epi1_body<0, false, SCALE>(acc, P, bgate, part, rsl, u.pm, pn, wr, wc, fr, fq);
        else if (pn < 16) epi1_body<0, true, SCALE>(acc, P, bgate, part, rsl, u.pm, pn, wr, wc, fr, fq);
        else if (pn >= 40) epi1_gate<SCALE>(acc, P, bgate, rsl, u.pm, pn - 40, wr, wc, fr, fq);
        else if (pn >= 24 && pn < 32) epi1_body<2, false, SCALE>(acc, P, bgate, part, rsl, u.pm, pn, wr, wc, fr, fq);
        else epi1_body<1, false, SCALE>(acc, P, bgate, part, rsl, u.pm, pn, wr, wc, fr, fq);
    }
    __device__ __forceinline__ void operator()(AccRef acc, const Unit& u, int wr, int wc, int fr, int fq) const { body(acc, u, wr, wc, fr, fq); }
    __device__ __forceinline__ void operator()(AccRef acc, const Unit& u, int wr, int wc, int fr, int fq, float carry, int tid) const {
        if (tid < 256) rsl[tid] = carry;
        asm volatile("s_waitcnt lgkmcnt(0)" ::: "memory"); __builtin_amdgcn_s_barrier();
        body(acc, u, wr, wc, fr, fq);
    }
};
struct EpiD1 {
    static constexpr bool PERM = true; static constexpr bool KEEP = false; static constexpr bool CARRY = false;
    bf16* YT;
    __device__ __forceinline__ void operator()(AccRef acc, const Unit& u, int wr, int wc, int fr, int fq) const {
        bf16* o0 = YT + ((size_t)u.pn * 2048 + (size_t)(u.aux * 256 + wr * 64 + fr)) * 512 + u.pm * 256 + wc * 32 + 8 * fq;
#pragma unroll
        for (int ai = 0; ai < 2; ++ai)
#pragma unroll
            for (int m = 0; m < 4; ++m) { bf16* rowp = o0 + (size_t)(ai * 128 + m * 16) * 512;
#pragma unroll
                for (int bj = 0; bj < 2; ++bj) { const f32x4 v0 = acc[ai][bj][m][0] * 0.0625f, v1 = acc[ai][bj][m][1] * 0.0625f;
                    v4u w; w.x = cvt_pk_bf16(v0[0], v0[1]); w.y = cvt_pk_bf16(v0[2], v0[3]); w.z = cvt_pk_bf16(v1[0], v1[1]); w.w = cvt_pk_bf16(v1[2], v1[3]);
                    *(v4u*)(rowp + bj * 128) = w; } }
    }
};
struct EpiD2 {
    static constexpr bool PERM = true; static constexpr bool KEEP = false; static constexpr bool CARRY = false;
    bf16* P;
    __device__ __forceinline__ void operator()(AccRef acc, const Unit& u, int wr, int wc, int fr, int fq) const {
        const int rt = u.aux; int tok0, N1;
        if (rt < 64) { N1 = 8; tok0 = (rt >> 3) * 2048 + (rt & 7); } else { N1 = 16; tok0 = MPR + ((rt - 64) >> 4) * 4096 + ((rt - 64) & 15); }
        const float scale = 0.0625f;
        const size_t rstride = (size_t)N1 * LDP;
        const bf16* Pb = P + (size_t)(tok0 + N1 * (wr * 64 + fr)) * LDP + C_ZB + u.pn * 256 + wc * 32 + 8 * fq;
        v4u z[2][4][2];
#pragma unroll
        for (int ai = 0; ai < 2; ++ai)
#pragma unroll
            for (int m = 0; m < 4; ++m)
#pragma unroll
                for (int bj = 0; bj < 2; ++bj) z[ai][m][bj] = *(const v4u*)(Pb + (size_t)(ai * 128 + m * 16) * rstride + bj * 128);
        asm volatile("" ::: "memory");
#pragma unroll
        for (int ai = 0; ai < 2; ++ai)
#pragma unroll
            for (int m = 0; m < 4; ++m) { bf16* rowp = (bf16*)Pb + (size_t)(ai * 128 + m * 16) * rstride;
#pragma unroll
                for (int bj = 0; bj < 2; ++bj) { const v4u zz = z[ai][m][bj]; const f32x4 v0 = acc[ai][bj][m][0] * scale, v1 = acc[ai][bj][m][1] * scale;
                    v4u w; w.x = cvt_pk_bf16(v0[0] * bf_lo(zz.x), v0[1] * bf_hi(zz.x)); w.y = cvt_pk_bf16(v0[2] * bf_lo(zz.y), v0[3] * bf_hi(zz.y));
                    w.z = cvt_pk_bf16(v1[0] * bf_lo(zz.z), v1[1] * bf_hi(zz.z)); w.w = cvt_pk_bf16(v1[2] * bf_lo(zz.w), v1[3] * bf_hi(zz.w));
                    *(v4u*)(rowp + bj * 128) = w; } }
        asm volatile("" ::: "memory");
    }
};
struct OrderG2 {
    pg8::OrderMN o; const char* A2; const char* B2;
    __device__ __forceinline__ bool next(int i, Unit& u) const {
        if (!o.next(i >> 1, u)) return false;
        u.aux = i & 1; if (u.aux) { u.a = A2 + (size_t)u.pm * o.tA; u.b = B2 + (size_t)u.pn * o.tB; } return true; }
    __device__ __forceinline__ void a_ready(const Unit&) const {}
    __device__ __forceinline__ void done(const Unit&) const {}
};
struct Epi2G {
    static constexpr bool PERM = true; static constexpr bool KEEP = true; static constexpr bool CARRY = false;
    const bf16* P; bf16* Mb;
    __device__ __forceinline__ bool keep(const Unit& u) const { return u.aux == 0; }
    __device__ __forceinline__ void operator()(AccMut acc, const Unit& u, int wr, int wc, int fr, int fq) const {
        const int row0 = u.pm * 256 + wr * 64 + fr, col0 = u.pn * 256 + wc * 32 + 8 * fq;
        const bf16* gp = P + (size_t)row0 * LDP + (u.aux ? C_GB : C_GA) + col0;
        v4u g[2][4][2];
#pragma unroll
        for (int ai = 0; ai < 2; ++ai)
#pragma unroll
            for (int m = 0; m < 4; ++m)
#pragma unroll
                for (int bj = 0; bj < 2; ++bj) g[ai][m][bj] = *(const v4u*)(gp + (size_t)(ai * 128 + m * 16) * LDP + bj * 128);
        asm volatile("" ::: "memory");
        if (u.aux == 0) {
#pragma unroll
            for (int ai = 0; ai < 2; ++ai)
#pragma unroll
                for (int m = 0; m < 4; ++m)
#pragma unroll
                    for (int bj = 0; bj < 2; ++bj) { v4u gg = g[ai][m][bj]; asm volatile("" : "+v"(gg.x), "+v"(gg.y), "+v"(gg.z), "+v"(gg.w));
                        acc[ai][bj][m][0] *= (f32x4){bf_lo(gg.x), bf_hi(gg.x), bf_lo(gg.y), bf_hi(gg.y)}; acc[ai][bj][m][1] *= (f32x4){bf_lo(gg.z), bf_hi(gg.z), bf_lo(gg.w), bf_hi(gg.w)}; }
        } else {
#pragma unroll
            for (int ai = 0; ai < 2; ++ai)
#pragma unroll
                for (int m = 0; m < 4; ++m) { bf16* op = Mb + (size_t)(row0 + ai * 128 + m * 16) * DM + col0;
#pragma unroll
                    for (int bj = 0; bj < 2; ++bj) { v4u gg = g[ai][m][bj]; asm volatile("" : "+v"(gg.x), "+v"(gg.y), "+v"(gg.z), "+v"(gg.w)); const f32x4 a0 = acc[ai][bj][m][0], a1 = acc[ai][bj][m][1];
                        v4u w; w.x = cvt_pk_bf16(a0[0] * bf_lo(gg.x), a0[1] * bf_hi(gg.x)); w.y = cvt_pk_bf16(a0[2] * bf_lo(gg.y), a0[3] * bf_hi(gg.y));
                        w.z = cvt_pk_bf16(a1[0] * bf_lo(gg.z), a1[1] * bf_hi(gg.z)); w.w = cvt_pk_bf16(a1[2] * bf_lo(gg.w), a1[3] * bf_hi(gg.w));
                        *(v4u*)(op + bj * 128) = w; } }
            asm volatile("" ::: "memory");
        }
    }
};
struct Epi3 {
    static constexpr bool PERM = true; static constexpr bool KEEP = false; static constexpr bool CARRY = false;
    const float* xp; const float* xs; bf16* x1; float* ss; int first;
    __device__ __forceinline__ void operator()(AccRef acc, const Unit& u, int wr, int wc, int fr, int fq) const {
        const int rt = u.pm * 256;
        const int r0 = wr * 64 + fr, col0 = u.pn * 256 + wc * 32 + 8 * fq;
        bf16* xh = x1 + (size_t)rt * DM;
        if (first) {
            const float* xb = (rt < MPR) ? xp + (size_t)rt * DM : xs + (size_t)(rt - MPR) * DM;
#pragma unroll
            for (int ai = 0; ai < 2; ++ai) {
                f32x4 xv[4][2][2];
#pragma unroll
                for (int m = 0; m < 4; ++m)
#pragma unroll
                    for (int bj = 0; bj < 2; ++bj)
#pragma unroll
                        for (int n = 0; n < 2; ++n) xv[m][bj][n] = *(const f32x4*)(xb + (size_t)(r0 + ai * 128 + m * 16) * DM + col0 + bj * 128 + n * 4);
                asm volatile("" ::: "memory");
#pragma unroll
                for (int m = 0; m < 4; ++m) { float q = 0.f; int rr = r0 + ai * 128 + m * 16; asm volatile("" : "+v"(rr));
#pragma unroll
                    for (int bj = 0; bj < 2; ++bj) { const f32x4 v0 = xv[m][bj][0] + acc[ai][bj][m][0], v1 = xv[m][bj][1] + acc[ai][bj][m][1];
                        q += (v0.x * v0.x + v0.y * v0.y) + (v0.z * v0.z + v0.w * v0.w) + (v1.x * v1.x + v1.y * v1.y) + (v1.z * v1.z + v1.w * v1.w);
                        v4u w; w.x = cvt_pk_bf16(v0.x, v0.y); w.y = cvt_pk_bf16(v0.z, v0.w); w.z = cvt_pk_bf16(v1.x, v1.y); w.w = cvt_pk_bf16(v1.z, v1.w);
                        *(v4u*)(xh + (size_t)rr * DM + col0 + bj * 128) = w; }
                    q += __shfl_xor(q, 16); q += __shfl_xor(q, 32);
                    if (fq == 0) ss[(size_t)(u.pn * 4 + wc) * MTOT + rt + rr] = q; }
                asm volatile("" ::: "memory");
            }
        } else {
            v4u xw[2][4][2];
#pragma unroll
            for (int ai = 0; ai < 2; ++ai)
#pragma unroll
                for (int m = 0; m < 4; ++m)
#pragma unroll
                    for (int bj = 0; bj < 2; ++bj) xw[ai][m][bj] = *(const v4u*)(xh + (size_t)(r0 + ai * 128 + m * 16) * DM + col0 + bj * 128);
            asm volatile("" ::: "memory");
#pragma unroll
            for (int ai = 0; ai < 2; ++ai)
#pragma unroll
                for (int m = 0; m < 4; ++m)
#pragma unroll
                    for (int bj = 0; bj < 2; ++bj) { v4u w = xw[ai][m][bj]; asm volatile("" : "+v"(w.x), "+v"(w.y), "+v"(w.z), "+v"(w.w));
                        const f32x4 v0 = (f32x4){bf_lo(w.x), bf_hi(w.x), bf_lo(w.y), bf_hi(w.y)} + acc[ai][bj][m][0], v1 = (f32x4){bf_lo(w.z), bf_hi(w.z), bf_lo(w.w), bf_hi(w.w)} + acc[ai][bj][m][1];
                        v4u o; o.x = cvt_pk_bf16(v0.x, v0.y); o.y = cvt_pk_bf16(v0.z, v0.w); o.z = cvt_pk_bf16(v1.x, v1.y); o.w = cvt_pk_bf16(v1.z, v1.w);
                        *(v4u*)(xh + (size_t)(r0 + ai * 128 + m * 16) * DM + col0 + bj * 128) = o; }
            asm volatile("" ::: "memory");
        }
    }
};

struct OrderD1 {
    int G, c; const char* D; const char* Z;
    __device__ __forceinline__ bool next(int i, Unit& u) const {
        const int L0 = i * G + c; if (L0 >= 2048) return false;
        const int L = 2047 - L0;
        u.pn = L >> 4; u.aux = (L >> 1) & 7; u.pm = L & 1;
        u.a = D + (size_t)u.pm * (256 * 512 * 2); u.b = Z + ((size_t)u.pn * 256 * 4096 + (size_t)u.aux * 512) * 2; return true; }
    __device__ __forceinline__ void a_ready(const Unit&) const {}
    __device__ __forceinline__ void done(const Unit&) const {}
};
struct OrderD2 {
    int G, c; const char* T; const char* YT;
    __device__ __forceinline__ bool next(int i, Unit& u) const {
        const int L = i * G + c; if (L >= 1024) return false;
        u.aux = L >> 3; u.pn = L & 7; u.pm = 0;
        u.a = T; u.b = YT + ((size_t)u.aux * 2048 + (size_t)u.pn * 256) * 512 * 2; return true; }
    __device__ __forceinline__ void a_ready(const Unit&) const {}
    __device__ __forceinline__ void done(const Unit&) const {}
};

__device__ constexpr float C16[16] = {1.0f, 0.9238795325112867f, 0.7071067811865476f, 0.3826834323650898f, 0.0f, -0.3826834323650898f, -0.7071067811865476f, -0.9238795325112867f,
                                      -1.0f, -0.9238795325112867f, -0.7071067811865476f, -0.3826834323650898f, 0.0f, 0.3826834323650898f, 0.7071067811865476f, 0.9238795325112867f};
__device__ constexpr float S16[16] = {0.0f, 0.3826834323650898f, 0.7071067811865476f, 0.9238795325112867f, 1.0f, 0.9238795325112867f, 0.7071067811865476f, 0.3826834323650898f,
                                      0.0f, -0.3826834323650898f, -0.7071067811865476f, -0.9238795325112867f, -1.0f, -0.9238795325112867f, -0.7071067811865476f, -0.3826834323650898f};
template <int N1> __device__ __forceinline__ void s1_items(const bf16* P, bf16* Z, const f32x2* TW, int row_base, int nb, int gt, int NGT) {
    constexpr int S = 256 * N1;
    const int nitems = nb * 256 * 512;
    for (int it = gt; it < nitems; it += NGT) {
        const int cg = it & 511, bn = it >> 9, n2 = bn & 255, b = bn >> 8, ch = cg * 4, g = ch >> 8, c = ch & 255;
        const bf16* src = P + (size_t)(row_base + b * S + n2) * LDP + C_XB + ch;
        float x[N1][4];
#pragma unroll
        for (int n1 = 0; n1 < N1; ++n1) { const v2u w = *(const v2u*)(src + (size_t)n1 * 256 * LDP); x[n1][0] = bf_lo(w.x); x[n1][1] = bf_hi(w.x); x[n1][2] = bf_lo(w.y); x[n1][3] = bf_hi(w.y); }
        bf16* dst = Z + (size_t)(row_base + b * S + n2) * 4096 + g * 512 + c;
#pragma unroll
        for (int k1 = 0; k1 <= N1 / 2; ++k1) {
            float re[4] = {0.f, 0.f, 0.f, 0.f}, im[4] = {0.f, 0.f, 0.f, 0.f};
#pragma unroll
            for (int n1 = 0; n1 < N1; ++n1) { const float cs = C16[((n1 * k1) % N1) * (16 / N1)], sn = S16[((n1 * k1) % N1) * (16 / N1)];
#pragma unroll
                for (int j = 0; j < 4; ++j) { re[j] = fmaf(x[n1][j], cs, re[j]); im[j] = fmaf(x[n1][j], -sn, im[j]); } }
#pragma unroll
            for (int mir = 0; mir < 2; ++mir) {
                if (mir == 1 && (k1 == 0 || k1 == N1 / 2)) continue;
                const int kk = mir ? N1 - k1 : k1;
                float imm[4];
#pragma unroll
                for (int j = 0; j < 4; ++j) imm[j] = mir ? -im[j] : im[j];
                const f32x2 tw = TW[(n2 * kk) & (S - 1)]; const float ct = tw.x, st = tw.y;
                v2u wr_, wi_;
                wr_.x = cvt_pk_bf16(re[0] * ct + imm[0] * st, re[1] * ct + imm[1] * st); wr_.y = cvt_pk_bf16(re[2] * ct + imm[2] * st, re[3] * ct + imm[3] * st);
                wi_.x = cvt_pk_bf16(imm[0] * ct - re[0] * st, imm[1] * ct - re[1] * st); wi_.y = cvt_pk_bf16(imm[2] * ct - re[2] * st, imm[3] * ct - re[3] * st);
                *(v2u*)(dst + (size_t)kk * 256 * 4096) = wr_; *(v2u*)(dst + (size_t)kk * 256 * 4096 + 256) = wi_;
            }
        }
    }
}

#define XB_TMO      128
#define XB_XCNT(j)  (256  + 64 * (j))
#define XB_XSUB(j)  (1280 + 64 * (j))
#define XB_XGEN(j)  (2304 + 64 * (j))
#define XB_TOP      3328
#define XB_TOPGEN   3392
#define XCD_BAR_WORDS 3456
#define XB_SPIN_CAP (1u << 18)
__device__ __forceinline__ unsigned xb_ld(unsigned* p)              { return __hip_atomic_load(p, __ATOMIC_RELAXED, __HIP_MEMORY_SCOPE_AGENT); }
__device__ __forceinline__ unsigned xb_add(unsigned* p, unsigned v) { return __hip_atomic_fetch_add(p, v, __ATOMIC_RELAXED, __HIP_MEMORY_SCOPE_AGENT); }
__device__ __forceinline__ unsigned xb_xcc_id() { return (unsigned)__builtin_amdgcn_s_getreg((3 << 11) | 20) & 0xFu; }
#define XB_SPIN(cond, bar) do { unsigned _sp = 0; while (cond) { __builtin_amdgcn_s_sleep(1); \
    if ((++_sp & 255u) == 0u) { if (xb_ld(&(bar)[XB_TMO])) break; if (_sp > XB_SPIN_CAP) { atomicAdd(&(bar)[XB_TMO], 1u); break; } } } } while (0)
struct XcdBarrier { unsigned* bar; unsigned x; volatile LAS unsigned* st; };
__device__ __forceinline__ XcdBarrier xcd_barrier_post(unsigned* bar, volatile LAS unsigned* st, bool leader) {
    XcdBarrier b; b.bar = bar; b.x = xb_xcc_id(); b.st = st;
    if (leader) (void)xb_add(&bar[XB_XCNT(b.x)], 1u);
    return b;
}
__device__ __forceinline__ void xcd_barrier_complete(unsigned* bar, unsigned x, unsigned& nloc, unsigned& nx) {
    const unsigned G = gridDim.x * gridDim.y * gridDim.z;
    unsigned sum, cnt, mine, sp = 0u;
    for (;;) {
        sum = 0u; cnt = 0u; mine = 0u;
#pragma unroll
        for (unsigned j = 0; j < 16; ++j) { const unsigned c = xb_ld(&bar[XB_XCNT(j)]); sum += c; cnt += (c > 0u) ? 1u : 0u; mine = (j == x) ? c : mine; }
        if (sum == G) break;
        __builtin_amdgcn_s_sleep(1);
        if ((++sp & 255u) == 0u) { if (xb_ld(&bar[XB_TMO])) break; if (sp > XB_SPIN_CAP) { atomicAdd(&bar[XB_TMO], 1u); break; } }
    }
    nloc = mine > 0u ? mine : 1u; nx = cnt > 0u ? cnt : 1u;
}
__device__ __forceinline__ void xcd_barrier(const XcdBarrier& b, bool leader) {
    asm volatile("s_waitcnt vmcnt(0)" ::: "memory");
    __syncthreads();
    if (leader) {
        unsigned* bar = b.bar;
        __builtin_amdgcn_s_waitcnt(0);
        unsigned nloc = b.st[0], nx = b.st[1];
        if (nloc == 0u) { xcd_barrier_complete(bar, b.x, nloc, nx); b.st[0] = nloc; b.st[1] = nx; }
        const unsigned old = xb_add(&bar[XB_XSUB(b.x)], 1u);
        const unsigned gen = old / nloc;
        if (old + 1u == (gen + 1u) * nloc) {
            __builtin_amdgcn_fence(__ATOMIC_RELEASE, "agent");
            asm volatile("s_waitcnt vmcnt(0)" ::: "memory");
            const unsigned og = xb_add(&bar[XB_TOP], 1u);
            const unsigned tg = og / nx;
            if (og + 1u == (tg + 1u) * nx) xb_add(&bar[XB_TOPGEN], 1u);
            else XB_SPIN(xb_ld(&bar[XB_TOPGEN]) == tg, bar);
            __builtin_amdgcn_fence(__ATOMIC_ACQUIRE, "agent");
            xb_add(&bar[XB_XGEN(b.x)], 1u);
            asm volatile("s_waitcnt vmcnt(0)" ::: "memory");
        } else {
            XB_SPIN(xb_ld(&bar[XB_XGEN(b.x)]) == gen, bar);
            __builtin_amdgcn_fence(__ATOMIC_ACQUIRE, "agent");
            asm volatile("s_waitcnt vmcnt(0)" ::: "memory");
        }
    }
    __syncthreads();
}

__device__ __forceinline__ float wave_sum(float v) {
#pragma unroll
    for (int o = 1; o < 64; o <<= 1) v += __shfl_xor(v, o);
    return v;
}
__device__ __forceinline__ void p0_transpose_item(const float* W, int K, int N, bf16* WT, LAS float* scr, int item, int lane, bool deal = false, const float* gk = nullptr) {
    const int nblk = N / 32, kb = item / nblk, nb = item % nblk, k0 = 64 * kb, n0 = 32 * nb;
    float wv[32];
#pragma unroll
    for (int i = 0; i < 32; ++i) wv[i] = W[(size_t)(k0 + 2 * i + (lane >> 5)) * N + n0 + (lane & 31)];
#pragma unroll
    for (int i = 0; i < 32; ++i) scr[(2 * i + (lane >> 5)) * 33 + (lane & 31)] = wv[i];
    LDS_WAIT(); asm volatile("" ::: "memory");
    const int c = lane & 7;
    f32x4 ga = {1.f, 1.f, 1.f, 1.f}, gb = {1.f, 1.f, 1.f, 1.f};
    if (gk) { ga = *(const f32x4*)(gk + k0 + 8 * c); gb = *(const f32x4*)(gk + k0 + 8 * c + 4); }
    int nd = n0;
    if (deal && n0 >= C_GA) { const int g = n0 - C_GA, hb = (g >= DM) ? 1 : 0, gg = g - hb * DM; nd = C_GA + ((gg >> 7) << 8) + hb * 128 + (gg & 127); }
#pragma unroll
    for (int j = 0; j < 4; ++j) { const int n = (lane >> 3) + 8 * j; const LAS float* s = scr + (8 * c) * 33 + n;
        v4u o; o.x = pk2(s[0 * 33] * ga.x, s[1 * 33] * ga.y); o.y = pk2(s[2 * 33] * ga.z, s[3 * 33] * ga.w); o.z = pk2(s[4 * 33] * gb.x, s[5 * 33] * gb.y); o.w = pk2(s[6 * 33] * gb.z, s[7 * 33] * gb.w);
        *(GAS v4u*)(WT + (size_t)(nd + n) * K + k0 + 8 * c) = o; }
    LDS_WAIT(); asm volatile("" ::: "memory");
}
__device__ __forceinline__ void rms_row_to_bf16(const float* xrow, const f32x4 (&gg)[16], bf16* orow, int lane) {
    const GAS f32x4* xr = (const GAS f32x4*)xrow + lane;
    f32x4 v[16]; float s = 0.f;
#pragma unroll
    for (int j = 0; j < 16; ++j) { v[j] = xr[64 * j]; s += (v[j].x * v[j].x + v[j].y * v[j].y) + (v[j].z * v[j].z + v[j].w * v[j].w); }
    const float rstd = 1.0f / sqrtf(wave_sum(s) * (1.0f / DM) + EPS);
    GAS v2u* o8 = (GAS v2u*)orow + lane;
#pragma unroll
    for (int j = 0; j < 16; ++j) { v2u w; w.x = cvt_pk_bf16(v[j].x * rstd * gg[j].x, v[j].y * rstd * gg[j].y); w.y = cvt_pk_bf16(v[j].z * rstd * gg[j].z, v[j].w * rstd * gg[j].w); o8[64 * j] = w; }
}
__device__ __forceinline__ void rms_row_bf16_to_f32(const bf16* xrow, const f32x4 (&g8)[8][2], float* orow, int lane) {
    const GAS v4u* xr = (const GAS v4u*)xrow + lane;
    v4u w[8]; float s = 0.f;
#pragma unroll
    for (int j = 0; j < 8; ++j) w[j] = xr[64 * j];
#pragma unroll
    for (int j = 0; j < 8; ++j) { const float a0 = bf_lo(w[j].x), a1 = bf_hi(w[j].x), a2 = bf_lo(w[j].y), a3 = bf_hi(w[j].y), a4 = bf_lo(w[j].z), a5 = bf_hi(w[j].z), a6 = bf_lo(w[j].w), a7 = bf_hi(w[j].w);
        s += (a0 * a0 + a1 * a1) + (a2 * a2 + a3 * a3) + (a4 * a4 + a5 * a5) + (a6 * a6 + a7 * a7); }
    const float rstd = 1.0f / sqrtf(wave_sum(s) * (1.0f / DM) + EPS);
    GAS f32x4* o = (GAS f32x4*)orow + 2 * lane;
#pragma unroll
    for (int j = 0; j < 8; ++j) { const f32x4 ga = g8[j][0] * rstd, gb = g8[j][1] * rstd;
        o[128 * j] = (f32x4){bf_lo(w[j].x) * ga.x, bf_hi(w[j].x) * ga.y, bf_lo(w[j].y) * ga.z, bf_hi(w[j].y) * ga.w};
        o[128 * j + 1] = (f32x4){bf_lo(w[j].z) * gb.x, bf_hi(w[j].z) * gb.y, bf_lo(w[j].w) * gb.z, bf_hi(w[j].w) * gb.w}; }
}

struct Args { const float* in[13]; float* out; unsigned char* ws; int ph_lo, ph_hi, li, pad; };
typedef __attribute__((address_space(4))) const Args CArgs;
#define PHASE_BEGIN() \
    unsigned oz_ = 0u; asm volatile("" : "+s"(oz_));              \
    CArgs* AP = (CArgs*)((__attribute__((address_space(4))) const char*)__builtin_amdgcn_kernarg_segment_ptr() + oz_); \
    int t_ = (wave0 << 6) | (int)__builtin_amdgcn_mbcnt_hi(~0u, __builtin_amdgcn_mbcnt_lo(~0u, oz_)); asm volatile("" : "+v"(t_));       \
    const int tid = t_, lane = tid & 63, wave = __builtin_amdgcn_readfirstlane(tid >> 6); \
    int G = G0, vcu = vcu0, bx = bx0; asm volatile("" : "+s"(G), "+s"(vcu), "+s"(bx)); (void)bx; \
    unsigned char* ws = AP->ws; float* out = AP->out; (void)lane; (void)wave; (void)out; \
    const int gw = vcu * NWAVES + wave, NGW = G * NWAVES, gt = vcu * (NWAVES * 64) + tid, NGT = G * NWAVES * 64; (void)gw; (void)NGW; (void)gt; (void)NGT

__global__ void __launch_bounds__(NWAVES * 64, 2) trunk_fwd(Args args) {
    extern __shared__ __attribute__((aligned(16))) unsigned char lds_raw[];
    LAS unsigned char* lds = (LAS unsigned char*)lds_raw;
    const int G0 = gridDim.x, bx0 = blockIdx.x; const int vcu0 = (G0 % 8 == 0) ? (bx0 % 8) * (G0 / 8) + bx0 / 8 : bx0;
    const int wave0 = __builtin_amdgcn_readfirstlane(threadIdx.x >> 6);
    for (int u = threadIdx.x; u < (LDS_BYTES - LDSCTL_OFF) / 4; u += NWAVES * 64) ((LAS unsigned*)(lds + LDSCTL_OFF))[u] = 0u;
    __syncthreads();
#if !MK_PER_PHASE
    (void)xcd_barrier_post((unsigned*)(args.ws + WS_CTL) + CW_BAR, (volatile LAS unsigned*)(lds + MISC_OFF) + 8, threadIdx.x == 0);
#define GRID_BAR() do { unsigned ozb_ = 0u; asm volatile("" : "+s"(ozb_)); \
        CArgs* AB_ = (CArgs*)((__attribute__((address_space(4))) const char*)__builtin_amdgcn_kernarg_segment_ptr() + ozb_); \
        XcdBarrier b_; b_.bar = (unsigned*)(AB_->ws + WS_CTL) + CW_BAR; b_.x = xb_xcc_id(); b_.st = (volatile LAS unsigned*)(lds + MISC_OFF) + 8; xcd_barrier(b_, wave0 == 0 && lane_id() == 0); } while (0)
#else
#define GRID_BAR() do { } while (0)
#endif
    const int lo = args.ph_lo, hi = args.ph_hi;
#define IN(k) (lo <= (k) && (k) < hi)
#define BOTH(k) (IN(k) && IN((k) + 1))

    if (IN(0)) {
        PHASE_BEGIN();
            bf16* DC = (bf16*)(ws + WS_DC); bf16* TT = (bf16*)(ws + WS_T);
            for (int e = gt; e < 512 * 512 / 8; e += NGT) { const int r = e >> 6, q0 = (e & 63) * 8; const int po = r >> 8, m = r & 255, pi = q0 >> 8, c0 = q0 & 255; float v[8];
#pragma unroll
                for (int j = 0; j < 8; ++j) { const float ph = (float)((m * (c0 + j)) & 255) * (1.0f / 128.0f); v[j] = (po == pi) ? cospif(ph) : ((po == 0) ? sinpif(ph) : -sinpif(ph)); }
                v4u w; w.x = pk2(v[0], v[1]); w.y = pk2(v[2], v[3]); w.z = pk2(v[4], v[5]); w.w = pk2(v[6], v[7]); *(GAS v4u*)(DC + (size_t)e * 8) = w; }
            for (int e = gt; e < 256 * 512 / 8; e += NGT) { const int k2 = e >> 6, q0 = (e & 63) * 8; const int pi = q0 >> 8, n0 = q0 & 255; float v[8];
#pragma unroll
                for (int j = 0; j < 8; ++j) { const float ph = (float)((k2 * (n0 + j)) & 255) * (1.0f / 128.0f); v[j] = pi ? sinpif(ph) : cospif(ph); }
                v4u w; w.x = pk2(v[0], v[1]); w.y = pk2(v[2], v[3]); w.z = pk2(v[4], v[5]); w.w = pk2(v[6], v[7]); *(GAS v4u*)(TT + (size_t)e * 8) = w; }

        { f32x2* TW = (f32x2*)(ws + WS_TW);
          for (int e = gt; e < 2048 + 4096; e += NGT) { const bool big = e >= 2048; const int j = big ? e - 2048 : e; const float ph = (float)j * (big ? (2.0f / 4096.0f) : (2.0f / 2048.0f)), sc = big ? 0.25f : 0.35355339059327373f;
              TW[e] = (f32x2){cospif(ph) * sc, sinpif(ph) * sc}; } }
    }

    for (int l = 0; l < 2; ++l) {
        const int pb = 7 * l;

        if (IN(pb + 0)) {
            PHASE_BEGIN();
            const float* norm_g = AP->in[2] + (size_t)l * DM;
            const float* w_in = AP->in[3] + (size_t)l * DM * DIN;
            const float* w_a = AP->in[8] + (size_t)l * DA * DM;
            const float* w_b = AP->in[9] + (size_t)l * DB * DM;
            const float* w_out = AP->in[11] + (size_t)l * DM * DM;
            bf16* W1T = (bf16*)(ws + WS_W1T); bf16* WAT = (bf16*)(ws + WS_WAT); bf16* WBT = (bf16*)(ws + WS_WBT); bf16* WOT = (bf16*)(ws + WS_WOT);
            bf16* H = (bf16*)(ws + WS_H);
            LAS float* scr = (LAS float*)(lds + RING_OFF + wave * 16384);
            constexpr int I_1 = (DM / 64) * (DIN / 32), I_A = (DA / 64) * (DM / 32), I_O = (DM / 64) * (DM / 32);
            constexpr int NITEMS = I_1 + 2 * I_A + I_O;
            for (int it = gw; it < NITEMS; it += NGW) {
                int r = it;
                if (r < I_1) { p0_transpose_item(w_in, DM, DIN, W1T, scr, r, lane, true, (l == 0) ? (const float*)nullptr : norm_g); continue; } r -= I_1;
                if (r < I_A) { p0_transpose_item(w_a, DA, DM, WAT, scr, r, lane); continue; } r -= I_A;
                if (r < I_A) { p0_transpose_item(w_b, DB, DM, WBT, scr, r, lane); continue; } r -= I_A;
                p0_transpose_item(w_out, DM, DM, WOT, scr, r, lane);
            }
            if (l == 0) {
                const float* x_prompt = AP->in[0]; const float* x_sample = AP->in[1];
                f32x4 gg[16];
#pragma unroll
                for (int j = 0; j < 16; ++j) gg[j] = ((const GAS f32x4*)norm_g)[lane + 64 * j];
                for (int m = gw; m < MTOT; m += NGW) {
                    const float* xrow = (m < MPR) ? x_prompt + (size_t)m * DM : x_sample + (size_t)(m - MPR) * DM;
                    rms_row_to_bf16(xrow, gg, H + (size_t)m * DM, lane);
                }
            } else {
                float* RS = (float*)(ws + WS_RSTD); const float* SS = (const float*)(ws + WS_PART);
                for (int m = gt; m < MTOT; m += NGT) { float s = 0.f;
#pragma unroll 16
                    for (int j = 0; j < 64; ++j) s += SS[(size_t)j * MTOT + m];
                    RS[m] = 1.0f / sqrtf(s * (1.0f / DM) + EPS); }
            }
            VM_WAIT(); __syncthreads();
            if (BOTH(pb + 0)) GRID_BAR();
        }

        if (IN(pb + 1)) {
            if (l == 0) { PHASE_BEGIN();
                pg8::OrderMN S; S.init(MTOT / 256, DIN / 256, G, bx, ws + WS_H, (size_t)256 * DM * 2, ws + WS_W1T, (size_t)256 * DM * 2);
                Epi1<false> E{(bf16*)(ws + WS_P), AP->in[10], (f32x2*)(ws + WS_PART), (const float*)nullptr, (LAS float*)nullptr};
                pg8::gemm_phase<Epi1<false>, pg8::OrderMN, PG8_ALIGN, PG8_SP2>(wave0, lds + RING_OFF, DM, DM, DM, S, E); }
            else { PHASE_BEGIN();
                pg8::OrderMN S; S.init(MTOT / 256, DIN / 256, G, bx, ws + WS_X1, (size_t)256 * DM * 2, ws + WS_W1T, (size_t)256 * DM * 2);
                Epi1<true> E{(bf16*)(ws + WS_P), AP->in[10] + (size_t)2 * DM, (f32x2*)(ws + WS_PART), (const float*)(ws + WS_RSTD), (LAS float*)(lds + RS_OFF)};
                pg8::gemm_phase<Epi1<true>, pg8::OrderMN, PG8_ALIGN, PG8_SP2>(wave0, lds + RING_OFF, DM, DM, DM, S, E); }
            if (BOTH(pb + 1)) GRID_BAR();
        }

        if (IN(pb + 2)) {
            PHASE_BEGIN();
            const float* ln_g = AP->in[4] + (size_t)l * DA;
            const float* ln_b = AP->in[5] + (size_t)l * DA;
            const float* w_sp = AP->in[6] + (size_t)l * 16 * 128 * 128;
            const float* b_sp = AP->in[7] + (size_t)l * 16 * 128;
            bf16* P = (bf16*)(ws + WS_P); const f32x2* PART = (const f32x2*)(ws + WS_PART);
            LAS unsigned char* tile = lds + RING_OFF;
            LAS float* red = (LAS float*)(lds + RING_OFF + 65536);
            LAS float* st = (LAS float*)(lds + STAT_OFF);
            const int fr = lane & 15, g4 = lane >> 4, wp = wave >> 1, wcx = wave & 1;
            for (int chunk = vcu; chunk < 256; chunk += G) {
                const int r0 = chunk * 128;
                { const int row = tid & 127, grp = tid >> 7; float s = 0.f, q = 0.f;
#pragma unroll
                  for (int k = 0; k < 8; ++k) { const f32x2 p = PART[(size_t)(grp * 8 + k) * MTOT + r0 + row]; s += p.x; q += p.y; }
                  red[(grp * 128 + row) * 2] = s; red[(grp * 128 + row) * 2 + 1] = q; }
                __syncthreads();
                if (tid < 128) { float s = 0.f, q = 0.f;
#pragma unroll
                    for (int k = 0; k < 4; ++k) { s += red[(k * 128 + tid) * 2]; q += red[(k * 128 + tid) * 2 + 1]; }
                    const float mu = s * (1.0f / DA); const float var = q * (1.0f / DA) - mu * mu; st[tid] = mu; st[128 + tid] = 1.0f / sqrtf(var + EPS); }
                const int sq = tid >> 2, spart = tid & 3;
                const bf16* gsrc = P + (size_t)(r0 + sq) * LDP + C_GV + spart * 32;
                v4u gr[4];
#pragma unroll
                for (int j = 0; j < 4; ++j) gr[j] = *(const v4u*)(gsrc + 8 * j);
                for (int head = 0; head < 16; ++head) {
                    const int cc0 = head * 128;
                    int th_ = tid; asm volatile("" : "+v"(th_));
                    const int fr = th_ & 15, g4 = (th_ >> 4) & 3, sq = th_ >> 2, spart = th_ & 3;
                    const bf16* gsrc = P + (size_t)(r0 + sq) * LDP + C_GV + spart * 32;
                    __syncthreads();
#pragma unroll
                    for (int j = 0; j < 4; ++j) *(LAS v4u*)(tile + sq * 288 + spart * 64 + 16 * j) = gr[j];
                    __syncthreads();
                    if (head + 1 < 16) {
#pragma unroll
                        for (int j = 0; j < 4; ++j) gr[j] = *(const v4u*)(gsrc + (cc0 + 128) + 8 * j);
                    }
                    v2u uq[4][2], zq[4][2];
#pragma unroll
                    for (int ci = 0; ci < 4; ++ci) { const int c = 64 * wcx + 16 * ci + 4 * g4;
#pragma unroll
                        for (int pj = 0; pj < 2; ++pj) { const bf16* up = P + (size_t)(r0 + 32 * wp + 16 * pj + fr) * LDP + cc0 + c; uq[ci][pj] = *(const v2u*)(up + C_U); zq[ci][pj] = *(const v2u*)(up + C_ZA); } }
                    bf16x8 wf[2][4]; float av[2], w1v[2], bsv[2];
                    const float* wsrc = w_sp + (size_t)head * 128 * 128;
#pragma unroll
                    for (int pj = 0; pj < 2; ++pj) { const int p = 32 * wp + 16 * pj + fr; float ap = 0.f, w1 = 0.f;
#pragma unroll
                        for (int ks = 0; ks < 4; ++ks) { const int q0 = 32 * ks + 8 * g4;
                            const f32x4 wa = *(const f32x4*)(wsrc + p * 128 + q0), wb = *(const f32x4*)(wsrc + p * 128 + q0 + 4);
                            const f32x4 ra = *(const LAS f32x4*)(st + 128 + q0), rb = *(const LAS f32x4*)(st + 128 + q0 + 4);
                            const f32x4 ma = *(const LAS f32x4*)(st + q0), mb = *(const LAS f32x4*)(st + q0 + 4);
                            const f32x4 sa = wa * ra, sb = wb * rb;
                            ap += (sa.x * ma.x + sa.y * ma.y) + (sa.z * ma.z + sa.w * ma.w) + (sb.x * mb.x + sb.y * mb.y) + (sb.z * mb.z + sb.w * mb.w);
                            w1 += (wa.x + wa.y) + (wa.z + wa.w) + (wb.x + wb.y) + (wb.z + wb.w);
                            v4u pk; pk.x = cvt_pk_bf16(sa.x, sa.y); pk.y = cvt_pk_bf16(sa.z, sa.w); pk.z = cvt_pk_bf16(sb.x, sb.y); pk.w = cvt_pk_bf16(sb.z, sb.w);
                            wf[pj][ks] = __builtin_bit_cast(bf16x8, pk); }
                        ap += __shfl_xor(ap, 16); ap += __shfl_xor(ap, 32); w1 += __shfl_xor(w1, 16); w1 += __shfl_xor(w1, 32);
                        av[pj] = ap; w1v[pj] = w1; bsv[pj] = b_sp[head * 128 + p]; }
                    f32x4 acc[4][2];
#pragma unroll
                    for (int ci = 0; ci < 4; ++ci)
#pragma unroll
                        for (int pj = 0; pj < 2; ++pj) acc[ci][pj] = (f32x4){0.f, 0.f, 0.f, 0.f};
                    const int trq = fr >> 2, trp = fr & 3;
#pragma unroll
                    for (int ci = 0; ci < 4; ++ci)
#pragma unroll
                        for (int ks = 0; ks < 4; ++ks) {
                            typedef short v4s __attribute__((ext_vector_type(4)));
                            const LAS unsigned char* ta = tile + (32 * ks + 8 * g4 + trq) * 288 + (64 * wcx + 16 * ci) * 2 + 8 * trp;
                            const v4s t0 = __builtin_amdgcn_ds_read_tr16_b64_v4i16((LAS v4s*)ta);
                            const v4s t1 = __builtin_amdgcn_ds_read_tr16_b64_v4i16((LAS v4s*)(ta + 4 * 288));
                            const bf16x8 gf = {t0[0], t0[1], t0[2], t0[3], t1[0], t1[1], t1[2], t1[3]};
#pragma unroll
                            for (int pj = 0; pj < 2; ++pj) acc[ci][pj] = __builtin_amdgcn_mfma_f32_16x16x32_bf16(gf, wf[pj][ks], acc[ci][pj], 0, 0, 0);
                        }
#pragma unroll
                    for (int ci = 0; ci < 4; ++ci) { const int c = 64 * wcx + 16 * ci + 4 * g4;
                        const f32x4 gam = *(const f32x4*)(ln_g + cc0 + c), bet = *(const f32x4*)(ln_b + cc0 + c);
#pragma unroll
                        for (int pj = 0; pj < 2; ++pj) { const int p = 32 * wp + 16 * pj + fr; bf16* up = P + (size_t)(r0 + p) * LDP + cc0 + c;
                            const v2u u4 = uq[ci][pj], z4 = zq[ci][pj];
                            const f32x4 mx = gam * (acc[ci][pj] - av[pj]) + bet * w1v[pj] + bsv[pj];
                            v2u o; o.x = cvt_pk_bf16(bf_lo(u4.x) * mx.x * bf_lo(z4.x), bf_hi(u4.x) * mx.y * bf_hi(z4.x)); o.y = cvt_pk_bf16(bf_lo(u4.y) * mx.z * bf_lo(z4.y), bf_hi(u4.y) * mx.w * bf_hi(z4.y));
                            *(v2u*)(up + C_U) = o; } }
                }
                __syncthreads();
            }
            { int gt1 = gt; asm volatile("" : "+v"(gt1));
              s1_items<8>(P, (bf16*)(ws + WS_Z), (const f32x2*)(ws + WS_TW), 0, 8, gt1, NGT);
              int gt2 = gt; asm volatile("" : "+v"(gt2));
              s1_items<16>(P, (bf16*)(ws + WS_Z), (const f32x2*)(ws + WS_TW) + 2048, MPR, 4, gt2, NGT); }
            VM_WAIT(); __syncthreads();
            if (BOTH(pb + 2)) GRID_BAR();
        }

        if (IN(pb + 3)) {
            PHASE_BEGIN();
            OrderD1 S{G, vcu, (const char*)(ws + WS_DC), (const char*)(ws + WS_Z)};
            EpiD1 E{(bf16*)(ws + WS_H)};
            pg8::gemm_phase<EpiD1, OrderD1, PG8_ALIGN, PG8_SP2>(wave0, lds + RING_OFF, 512, 4096, 512, S, E);
            if (BOTH(pb + 3)) GRID_BAR();
        }

        if (IN(pb + 4)) {
            PHASE_BEGIN();
            OrderD2 S{G, vcu, (const char*)(ws + WS_T), (const char*)(ws + WS_H)};
            EpiD2 E{(bf16*)(ws + WS_P)};
            pg8::gemm_phase<EpiD2, OrderD2, PG8_ALIGN, PG8_SP2>(wave0, lds + RING_OFF, 512, 512, 512, S, E);
            if (BOTH(pb + 4)) GRID_BAR();
        }

        if (IN(pb + 5)) {
            PHASE_BEGIN();
            OrderG2 S; S.o.init(MTOT / 256, DM / 256, G, bx, ws + WS_P + (size_t)C_U * 2, (size_t)256 * LDP * 2, ws + WS_WAT, (size_t)256 * DA * 2);
            S.A2 = (const char*)(ws + WS_P + (size_t)C_ZB * 2); S.B2 = (const char*)(ws + WS_WBT);
            Epi2G E{(const bf16*)(ws + WS_P), (bf16*)(ws + WS_H)};
            pg8::gemm_phase<Epi2G, OrderG2, PG8_ALIGN, PG8_SP2>(wave0, lds + RING_OFF, LDP, DA, DA, S, E);
            if (BOTH(pb + 5)) GRID_BAR();
        }

        if (IN(pb + 6)) {
            PHASE_BEGIN();
            pg8::OrderMN S; S.init(MTOT / 256, DM / 256, G, bx, ws + WS_H, (size_t)256 * DM * 2, ws + WS_WOT, (size_t)256 * DM * 2);
            Epi3 E{AP->in[0], AP->in[1], (bf16*)(ws + WS_X1), (float*)(ws + WS_PART), (l == 0) ? 1 : 0};
            pg8::gemm_phase<Epi3, pg8::OrderMN, PG8_ALIGN, PG8_SP2>(wave0, lds + RING_OFF, DM, DM, DM, S, E);
            if (BOTH(pb + 6)) GRID_BAR();
        }
    }

    if (IN(14)) {
        PHASE_BEGIN();
        const float* final_g = AP->in[12];
        const bf16* X2 = (const bf16*)(ws + WS_X1);
        f32x4 g8[8][2];
#pragma unroll
        for (int j = 0; j < 8; ++j) { g8[j][0] = ((const GAS f32x4*)final_g)[2 * (lane + 64 * j)]; g8[j][1] = ((const GAS f32x4*)final_g)[2 * (lane + 64 * j) + 1]; }
        for (int m = MTOT - 1 - gw; m >= 0; m -= NGW) rms_row_bf16_to_f32(X2 + (size_t)m * DM, g8, out + (size_t)m * DM, lane);
    }
#undef IN
#undef BOTH
}

extern "C" void kernel_launch(void* const* d_in, const int* in_sizes, int n_in, void* d_out, int out_size, void* d_ws, size_t ws_size, hipStream_t stream) {
    static int grid = 0;
    if (grid == 0) {
        if (n_in != 13 || out_size != MTOT * DM || ws_size < WS_END) { fprintf(stderr, "kernel_launch: unexpected shapes (n_in %d out %d ws %zu); nothing launched\n", n_in, out_size, ws_size); grid = -1; return; }
        int dev = 0, cus = 0, per_cu = 0;
        if (hipGetDevice(&dev) != hipSuccess || hipDeviceGetAttribute(&cus, hipDeviceAttributeMultiprocessorCount, dev) != hipSuccess) { grid = -1; return; }
        if (hipFuncSetAttribute((const void*)trunk_fwd, hipFuncAttributeMaxDynamicSharedMemorySize, LDS_BYTES) != hipSuccess) { fprintf(stderr, "kernel_launch: hipFuncSetAttribute failed\n"); grid = -1; return; }
        if (hipOccupancyMaxActiveBlocksPerMultiprocessor(&per_cu, (const void*)trunk_fwd, NWAVES * 64, LDS_BYTES) != hipSuccess || per_cu < 1)
            fprintf(stderr, "kernel_launch: note: occupancy query reports %d workgroups per CU\n", per_cu);
        (void)hipGetLastError();
        grid = cus;
    }
    if (grid < 0) return;
    if (hipMemsetAsync((char*)d_ws + WS_CTL, 0, CTL_ZERO_BYTES, stream) != hipSuccess) return;
    Args a{};
    for (int i = 0; i < 13; ++i) a.in[i] = (const float*)d_in[i];
    a.out = (float*)d_out; a.ws = (unsigned char*)d_ws;
#if MK_PER_PHASE
    for (int p = 0; p < N_PHASES; ++p) { a.ph_lo = p; a.ph_hi = p + 1; a.li = p;
        hipLaunchKernelGGL(trunk_fwd, dim3(grid), dim3(NWAVES * 64), LDS_BYTES, stream, a); }
#else
    a.ph_lo = 0; a.ph_hi = N_PHASES; a.li = 0;
    hipLaunchKernelGGL(trunk_fwd, dim3(grid), dim3(NWAVES * 64), LDS_BYTES, stream, a);
#endif
}
```

```cpp
#include <hip/hip_runtime.h>
#include <cstdio>
#include <cstdint>

#ifndef MK_PER_PHASE
#define MK_PER_PHASE 0
#endif

#define GAS __attribute__((address_space(1)))
#define LAS __attribute__((address_space(3)))
typedef unsigned short bf16;
typedef unsigned v4u __attribute__((ext_vector_type(4)));
typedef unsigned v2u __attribute__((ext_vector_type(2)));
typedef float f32x4 __attribute__((ext_vector_type(4)));
typedef float f32x2 __attribute__((ext_vector_type(2)));
typedef short bf16x8 __attribute__((ext_vector_type(8)));
typedef GAS unsigned gu32;

constexpr int DM = 4096, DIN = 18432, DA = 2048, DB = 2048;
constexpr int MPR = 16384;
constexpr int MTOT = 32768;
constexpr int LDP = DIN;
constexpr int C_U = 0, C_GV = 2048, C_ZA = 4096, C_XB = 6144, C_ZB = 8192, C_GA = 10240, C_GB = 14336;
constexpr float EPS = 1e-6f;
constexpr int NWAVES = 8;
constexpr int N_PHASES = 15;

constexpr size_t MiB = 1u << 20;
constexpr size_t WS_CTL = 0, CTL_ZERO_BYTES = 32768;
constexpr size_t WS_W1T = 1 * MiB;
constexpr size_t WS_WAT = 145 * MiB;
constexpr size_t WS_WBT = 161 * MiB;
constexpr size_t WS_WOT = 177 * MiB;
constexpr size_t WS_DC = 210 * MiB;
constexpr size_t WS_TW = 212 * MiB;
constexpr size_t WS_T = 211 * MiB;
constexpr size_t WS_RSTD = 213 * MiB;
constexpr size_t WS_PART = 291 * MiB;
constexpr size_t WS_H = 300 * MiB;
constexpr size_t WS_P = 556 * MiB;
constexpr size_t WS_Z = 1708 * MiB;
constexpr size_t WS_X1 = 1964 * MiB;
constexpr size_t WS_END = 2220 * MiB;
constexpr int CW_BAR = 4096;

constexpr int RING_OFF = 0, RING_BYTES = 131072;
constexpr int LDSCTL_OFF = RING_BYTES, MISC_OFF = LDSCTL_OFF + 320;
constexpr int STAT_OFF = RING_BYTES + 1024;
constexpr int RS_OFF = RING_BYTES + 4096;
constexpr int LDS_BYTES = 147456;

#define RLX_AGENT __ATOMIC_RELAXED, __HIP_MEMORY_SCOPE_AGENT
#define LDS_WAIT() asm volatile("s_waitcnt lgkmcnt(0)" ::: "memory")
#define VM_WAIT() asm volatile("s_waitcnt vmcnt(0)" ::: "memory")

typedef __bf16 bf16x2_t __attribute__((ext_vector_type(2)));
__device__ __forceinline__ unsigned cvt_pk_bf16(float lo, float hi) { const f32x2 v = {lo, hi}; const bf16x2_t b = __builtin_convertvector(v, bf16x2_t); return __builtin_bit_cast(unsigned, b); }
__device__ __forceinline__ int lane_id() { return (int)__builtin_amdgcn_mbcnt_hi(~0u, __builtin_amdgcn_mbcnt_lo(~0u, 0u)); }
__device__ __forceinline__ float bf_lo(unsigned w) { return __builtin_bit_cast(float, w << 16); }
__device__ __forceinline__ float bf_hi(unsigned w) { return __builtin_bit_cast(float, w & 0xffff0000u); }
__device__ __forceinline__ float bf2f(bf16 b) { return __builtin_bit_cast(float, ((unsigned)b) << 16); }
__device__ __forceinline__ unsigned f2bf(float f) { unsigned u = __builtin_bit_cast(unsigned, f); return (u + 0x7fffu + ((u >> 16) & 1u)) >> 16; }
__device__ __forceinline__ unsigned pk2(float lo, float hi) { return f2bf(lo) | (f2bf(hi) << 16); }

namespace pg8 {
constexpr int BM = 256, BK = 64, HALF = 128, HTB = HALF * BK * 2, STAGE_BYTES = 8 * HTB, NXCD = 8, WGM = 8;
__host__ __device__ __forceinline__ int lds_byte(int r, int c) { const int st = (r >> 4) * 2 + (c >> 5), rr = r & 15, cc = c & 31, ob = rr * 64 + cc * 2; return st * 1024 + (ob ^ (((ob >> 9) & 1) << 5)); }
__host__ __device__ __forceinline__ void stage_rc(int b, int& R, int& C) { const int st = b / 1024, sb = b % 1024, swz = sb ^ (((sb >> 9) & 1) << 5); R = (st >> 1) * 16 + swz / 64; C = (st & 1) * 32 + (swz % 64) / 2; }
__host__ __device__ __forceinline__ int perm32(int rho) { const int n = rho >> 4, i = rho & 15; return 8 * (i >> 2) + 4 * n + (i & 3); }

struct Unit { const char* a; const char* b; int pm, pn, aux; };

struct OrderMN {
    int nM, nN, nwg, G, c; const char* A; const char* B; size_t tA, tB;
    __device__ __forceinline__ void init(int nM_, int nN_, int G_, int c_, const void* A_, size_t tA_, const void* B_, size_t tB_) { nM = nM_; nN = nN_; nwg = nM * nN; G = G_; c = c_; A = (const char*)A_; B = (const char*)B_; tA = tA_; tB = tB_; }
    __device__ __forceinline__ bool next(int i, Unit& u) const {
        const long L = (long)i * G + c; if (L >= nwg) return false;
        int wgid = (int)L; { const int q = nwg / NXCD, r = nwg % NXCD, xcd = wgid % NXCD, off = wgid / NXCD; wgid = (xcd < r ? xcd * (q + 1) : r * (q + 1) + (xcd - r) * q) + off; }
        const int nig = WGM * nN, gid = wgid / nig, fm = gid * WGM, gsz = (nM - fm) < WGM ? (nM - fm) : WGM;
        u.pm = fm + ((wgid % nig) % gsz); u.pn = (wgid % nig) / gsz; u.aux = 0;
        u.a = A + (size_t)u.pm * tA; u.b = B + (size_t)u.pn * tB; return true;
    }
    __device__ __forceinline__ void a_ready(const Unit&) const {}
    __device__ __forceinline__ void done(const Unit&) const {}
};

template <class Epi, class Sched, bool ALIGN_EPI, bool SP2>
__device__ __forceinline__ void gemm_phase(const int ws_, LAS unsigned char* lds, const int lda, const int ldb, const int K, const Sched& S, const Epi& E) {
    int tid_ = (ws_ << 6) | lane_id(); asm volatile("" : "+v"(tid_));
    const int tid = tid_, wid = __builtin_amdgcn_readfirstlane(tid >> 6), lane = tid & 63, wr = wid >> 2, wc = wid & 3, fr = lane & 15, fq = lane >> 4;
    const int nt = K / BK;
    unsigned voffA[2], voffB[2];
#pragma unroll
    for (int i = 0; i < 2; ++i) { int R, C; stage_rc(tid * 16 + i * 8192, R, C); const int Rb = Epi::PERM ? ((R & ~31) + perm32(R & 31)) : R;
        voffA[i] = (unsigned)(R * lda + C) * 2u; voffB[i] = (unsigned)(Rb * ldb + C) * 2u; }
    const size_t kstep = (size_t)(BK * 2);
    const size_t hstepA = (size_t)HALF * lda * 2, hstepB = (size_t)HALF * ldb * 2;
    const unsigned ldsw = (unsigned)wid * 1024u;
    const int aoff = lds_byte(wr * 64 + fr, fq * 8), boff = lds_byte(wc * 32 + fr, fq * 8);
#define PG8_SA(b, h) (((b) * 2 + (h)) * HTB)
#define PG8_SB(b, h) ((4 + (b) * 2 + (h)) * HTB)
#define PG8_STAGE(bufoff, gbase, voff) do { _Pragma("unroll") for (int _i = 0; _i < 2; ++_i) \
        __builtin_amdgcn_global_load_lds((const unsigned*)((const char*)(gbase) + (voff)[_i]), (LAS unsigned*)(lds + (bufoff) + ldsw + _i * 8192), 16, 0, 0); } while (0)
#define PG8_LDA(dst, b, h) do { _Pragma("unroll") for (int m = 0; m < 4; ++m) _Pragma("unroll") for (int k = 0; k < 2; ++k) dst[m][k] = *(const LAS bf16x8*)(lds + PG8_SA(b, h) + aoff + m * 2048 + k * 1024); } while (0)
#define PG8_LDB(dst, b, h) do { _Pragma("unroll") for (int n = 0; n < 2; ++n) _Pragma("unroll") for (int k = 0; k < 2; ++k) dst[n][k] = *(const LAS bf16x8*)(lds + PG8_SB(b, h) + boff + n * 2048 + k * 1024); } while (0)
#define PG8_MMA(ai, bj, At, Bt) do { __builtin_amdgcn_s_setprio(1); _Pragma("unroll") for (int m = 0; m < 4; ++m) _Pragma("unroll") for (int n = 0; n < 2; ++n) _Pragma("unroll") for (int k = 0; k < 2; ++k) \
        acc[ai][bj][m][n] = __builtin_amdgcn_mfma_f32_16x16x32_bf16(Bt[n][k], At[m][k], acc[ai][bj][m][n], 0, 0, 0); __builtin_amdgcn_s_setprio(0); } while (0)
#define PG8_WAIT_V(n) asm volatile("s_waitcnt vmcnt(" #n ")" ::: "memory")
#define PG8_WAIT_L(n) asm volatile("s_waitcnt lgkmcnt(" #n ")" ::: "memory")
#define PG8_BAR __builtin_amdgcn_s_barrier()
#define PG8_SCHED __builtin_amdgcn_sched_barrier(0)
    Unit cur, nxt; int ui = 0;
    if (!S.next(0, cur)) return;
    float carry = 0.f;
    if constexpr (Epi::CARRY) carry = E.pre(cur, tid);
    f32x4 acc[2][2][4][2];
#pragma unroll
    for (int a = 0; a < 2; ++a)
#pragma unroll
        for (int b = 0; b < 2; ++b)
#pragma unroll
            for (int m = 0; m < 4; ++m)
#pragma unroll
                for (int n = 0; n < 2; ++n) acc[a][b][m][n] = (f32x4){0.f, 0.f, 0.f, 0.f};
    bf16x8 At[4][2], B0[2][2], B1[2][2];
    const char* cA = cur.a; const char* cB = cur.b;
    S.a_ready(cur);
    if constexpr (SP2) {
        PG8_STAGE(PG8_SB(0, 0), cB, voffB); PG8_STAGE(PG8_SB(0, 1), cB + hstepB, voffB); PG8_STAGE(PG8_SA(0, 0), cA, voffA); PG8_STAGE(PG8_SA(0, 1), cA + hstepA, voffA);
        if (wr == 1) PG8_BAR;
        PG8_WAIT_V(2); PG8_BAR;
        PG8_STAGE(PG8_SB(1, 0), cB + kstep, voffB); PG8_STAGE(PG8_SA(1, 0), cA + kstep, voffA); PG8_STAGE(PG8_SB(1, 1), cB + hstepB + kstep, voffB);
        PG8_WAIT_V(6); PG8_BAR;
    } else {
        PG8_STAGE(PG8_SB(0, 0), cB, voffB); PG8_STAGE(PG8_SA(0, 0), cA, voffA); PG8_STAGE(PG8_SB(0, 1), cB + hstepB, voffB); PG8_STAGE(PG8_SA(0, 1), cA + hstepA, voffA);
        if (wr == 1) PG8_BAR;
        PG8_WAIT_V(4); PG8_BAR;
        PG8_STAGE(PG8_SB(1, 0), cB + kstep, voffB); PG8_STAGE(PG8_SA(1, 0), cA + kstep, voffA); PG8_STAGE(PG8_SB(1, 1), cB + hstepB + kstep, voffB);
        PG8_WAIT_V(6); PG8_BAR;
    }
    for (;;) {
        const bool has_next = S.next(ui + 1, nxt);
        const char* nA = has_next ? nxt.a : cA; const char* nB = has_next ? nxt.b : cB;
        for (int t = 0; t < nt; t += 2) {
            const bool last = (t == nt - 2);
            const char* a1 = cA + (size_t)(t + 1) * kstep;
            const char* a2 = last ? nA : cA + (size_t)(t + 2) * kstep; const char* b2 = last ? nB : cB + (size_t)(t + 2) * kstep;
            const char* a3 = a2 + kstep; const char* b3 = b2 + kstep;
            if (last && has_next) S.a_ready(nxt);
            if constexpr (SP2) {
            PG8_LDB(B0, 0, 0); PG8_LDB(B1, 0, 1); PG8_SCHED; PG8_LDA(At, 0, 0); PG8_STAGE(PG8_SA(1, 1), a1 + hstepA, voffA);
            PG8_WAIT_V(8); PG8_WAIT_L(0); PG8_BAR; PG8_MMA(0, 0, At, B0); PG8_MMA(0, 1, At, B1); PG8_BAR; PG8_SCHED;
            PG8_LDA(At, 0, 1); PG8_STAGE(PG8_SB(0, 0), b2, voffB); PG8_STAGE(PG8_SB(0, 1), b2 + hstepB, voffB); PG8_STAGE(PG8_SA(0, 0), a2, voffA);
            PG8_WAIT_V(8); PG8_WAIT_L(0); PG8_BAR; PG8_MMA(1, 0, At, B0); PG8_MMA(1, 1, At, B1); PG8_BAR; PG8_SCHED;
            PG8_LDB(B0, 1, 0); PG8_LDB(B1, 1, 1); PG8_SCHED; PG8_LDA(At, 1, 0); PG8_STAGE(PG8_SA(0, 1), a2 + hstepA, voffA);
            PG8_WAIT_V(8); PG8_WAIT_L(0); PG8_BAR; PG8_MMA(0, 0, At, B0); PG8_MMA(0, 1, At, B1); PG8_BAR; PG8_SCHED;
            PG8_LDA(At, 1, 1); PG8_STAGE(PG8_SB(1, 0), b3, voffB); PG8_STAGE(PG8_SB(1, 1), b3 + hstepB, voffB); PG8_STAGE(PG8_SA(1, 0), a3, voffA);
            PG8_WAIT_V(8); PG8_WAIT_L(0); PG8_BAR; PG8_MMA(1, 0, At, B0); PG8_MMA(1, 1, At, B1); PG8_BAR; PG8_SCHED;
            } else {
            PG8_LDB(B0, 0, 0); PG8_SCHED; PG8_LDA(At, 0, 0); PG8_STAGE(PG8_SA(1, 1), a1 + hstepA, voffA);
            PG8_WAIT_L(8); PG8_BAR; PG8_WAIT_L(0); PG8_MMA(0, 0, At, B0); PG8_BAR; PG8_SCHED;
            PG8_LDB(B1, 0, 1); PG8_STAGE(PG8_SB(0, 0), b2, voffB);
            PG8_BAR; PG8_WAIT_L(0); PG8_MMA(0, 1, At, B1); PG8_BAR;
            PG8_LDA(At, 0, 1); PG8_STAGE(PG8_SA(0, 0), a2, voffA);
            PG8_BAR; PG8_WAIT_L(0); PG8_MMA(1, 0, At, B0); PG8_BAR; PG8_SCHED;
            PG8_STAGE(PG8_SB(0, 1), b2 + hstepB, voffB);
            PG8_WAIT_V(6); PG8_BAR; PG8_MMA(1, 1, At, B1); PG8_BAR;
            PG8_LDB(B0, 1, 0); PG8_SCHED; PG8_LDA(At, 1, 0); PG8_STAGE(PG8_SA(0, 1), a2 + hstepA, voffA);
            PG8_WAIT_L(8); PG8_BAR; PG8_WAIT_L(0); PG8_MMA(0, 0, At, B0); PG8_BAR; PG8_SCHED;
            PG8_LDB(B1, 1, 1); PG8_STAGE(PG8_SB(1, 0), b3, voffB);
            PG8_BAR; PG8_WAIT_L(0); PG8_MMA(0, 1, At, B1); PG8_BAR;
            PG8_LDA(At, 1, 1); PG8_STAGE(PG8_SA(1, 0), a3, voffA);
            PG8_BAR; PG8_WAIT_L(0); PG8_MMA(1, 0, At, B0); PG8_BAR; PG8_SCHED;
            PG8_STAGE(PG8_SB(1, 1), b3 + hstepB, voffB);
            PG8_WAIT_V(6); PG8_BAR; PG8_MMA(1, 1, At, B1); PG8_BAR;
            }
        }
        if constexpr (ALIGN_EPI) { if (wr == 0) PG8_BAR; }
        { int l2 = lane_id(); asm volatile("" : "+v"(l2));
          if constexpr (Epi::CARRY) { E(acc, cur, wr, wc, l2 & 15, l2 >> 4, carry, (wid << 6) | l2); if (has_next) carry = E.pre(nxt, (wid << 6) | l2); }
          else E(acc, cur, wr, wc, l2 & 15, l2 >> 4); }
        S.done(cur);
        if (!has_next) break;
        bool zero_acc = true;
        if constexpr (Epi::KEEP) zero_acc = !E.keep(cur);
        if (zero_acc) {
#pragma unroll
        for (int a = 0; a < 2; ++a)
#pragma unroll
            for (int b = 0; b < 2; ++b)
#pragma unroll
                for (int m = 0; m < 4; ++m)
#pragma unroll
                    for (int n = 0; n < 2; ++n) acc[a][b][m][n] = (f32x4){0.f, 0.f, 0.f, 0.f};
        }
        cur = nxt; cA = nA; cB = nB; ++ui;
        if constexpr (ALIGN_EPI) { if (wr == 1) PG8_BAR; }
    }
    PG8_WAIT_V(0);
    if constexpr (!ALIGN_EPI) { if (wr == 0) PG8_BAR; }
    PG8_BAR;
#undef PG8_SA
#undef PG8_SB
#undef PG8_STAGE
#undef PG8_LDA
#undef PG8_LDB
#undef PG8_MMA
#undef PG8_WAIT_V
#undef PG8_WAIT_L
#undef PG8_BAR
#undef PG8_SCHED
}
}

#ifndef PG8_SP2
#define PG8_SP2 true
#endif
#ifndef PG8_ALIGN
#define PG8_ALIGN true
#endif
using pg8::Unit;
typedef const f32x4 (&AccRef)[2][2][4][2];
typedef f32x4 (&AccMut)[2][2][4][2];

__device__ __forceinline__ float act_one(float x, float c1, float c3, float off, bool mulx) {
    const float t = fmaf(x, fmaf(c3, x * x, c1), off);
    const float e = __builtin_amdgcn_exp2f(t * -1.4426950408889634f);
    const float sg = __builtin_amdgcn_rcpf(1.0f + e);
    return (mulx ? x : 1.0f) * sg;
}
template <bool SCALE> __device__ __forceinline__ void epi1_gate(AccRef acc, bf16* P, const float* bgate, const LAS float* rs, int pm, int t, int wr, int wc, int fr, int fq) {
    const int row0 = pm * 256 + wr * 64 + fr, cw = t * 128 + wc * 32 + 8 * fq;
    float rsv[2][4];
#pragma unroll
    for (int ai = 0; ai < 2; ++ai)
#pragma unroll
        for (int m = 0; m < 4; ++m) rsv[ai][m] = SCALE ? rs[wr * 64 + fr + ai * 128 + m * 16] : 1.0f;
    f32x4 ba[2], bb[2];
#pragma unroll
    for (int n = 0; n < 2; ++n) { ba[n] = *(const f32x4*)(bgate + cw + 4 * n) * -1.4426950408889634f; bb[n] = *(const f32x4*)(bgate + DM + cw + 4 * n) * -1.4426950408889634f; }
#pragma unroll
    for (int ai = 0; ai < 2; ++ai)
#pragma unroll
        for (int m = 0; m < 4; ++m) {
            const int row = row0 + ai * 128 + m * 16; bf16* rowp = P + (size_t)row * LDP + cw;
            float orr[8], og[8];
#pragma unroll
            for (int n = 0; n < 2; ++n)
#pragma unroll
                for (int j = 0; j < 4; ++j) { const float xa = SCALE ? acc[ai][0][m][n][j] * rsv[ai][m] : acc[ai][0][m][n][j], xb = SCALE ? acc[ai][1][m][n][j] * rsv[ai][m] : acc[ai][1][m][n][j];
                    const float da = 1.0f + __builtin_amdgcn_exp2f(fmaf(xa, -1.4426950408889634f, ba[n][j]));
                    const float db = 1.0f + __builtin_amdgcn_exp2f(fminf(fmaf(xb, -1.4426950408889634f, bb[n][j]), 64.0f));
                    og[4 * n + j] = __builtin_amdgcn_rcpf(db); orr[4 * n + j] = db * __builtin_amdgcn_rcpf(da); }
            v4u w; w.x = cvt_pk_bf16(orr[0], orr[1]); w.y = cvt_pk_bf16(orr[2], orr[3]); w.z = cvt_pk_bf16(orr[4], orr[5]); w.w = cvt_pk_bf16(orr[6], orr[7]);
            *(v4u*)(rowp + C_GA) = w;
            v4u g; g.x = cvt_pk_bf16(og[0], og[1]); g.y = cvt_pk_bf16(og[2], og[3]); g.z = cvt_pk_bf16(og[4], og[5]); g.w = cvt_pk_bf16(og[6], og[7]);
            *(v4u*)(rowp + C_GB) = g;
        }
}
template <int MODE, bool STATS, bool SCALE> __device__ __forceinline__ void epi1_body(AccRef acc, bf16* P, const float* bgate, f32x2* part, const LAS float* rs, int pm, int pn, int wr, int wc, int fr, int fq) {
    const int row0 = pm * 256 + wr * 64 + fr, col0 = pn * 256 + wc * 32 + 8 * fq;
    float rsv[2][4];
#pragma unroll
    for (int ai = 0; ai < 2; ++ai)
#pragma unroll
        for (int m = 0; m < 4; ++m) rsv[ai][m] = SCALE ? rs[wr * 64 + fr + ai * 128 + m * 16] : 1.0f;
    f32x4 bv[2][2];
    if (MODE == 3) {
#pragma unroll
        for (int bj = 0; bj < 2; ++bj)
#pragma unroll
            for (int n = 0; n < 2; ++n) bv[bj][n] = *(const f32x4*)(bgate + (col0 - C_GA) + bj * 128 + 4 * n) * -1.4426950408889634f;
    }
#pragma unroll
    for (int ai = 0; ai < 2; ++ai)
#pragma unroll
        for (int m = 0; m < 4; ++m) {
            const int row = row0 + ai * 128 + m * 16; bf16* rowp = P + (size_t)row * LDP + col0; float rs = 0.f, rq = 0.f;
#pragma unroll
            for (int bj = 0; bj < 2; ++bj) {
                float o[8];
#pragma unroll
                for (int n = 0; n < 2; ++n)
#pragma unroll
                    for (int j = 0; j < 4; ++j) { const float x = SCALE ? acc[ai][bj][m][n][j] * rsv[ai][m] : acc[ai][bj][m][n][j]; float r;
                        if (MODE == 0) { const float t = x * fmaf(-0.10294324576f, x * x, -2.3022081985f); r = x * __builtin_amdgcn_rcpf(1.0f + __builtin_amdgcn_exp2f(t)); }
                        else if (MODE == 1) { r = x * __builtin_amdgcn_rcpf(1.0f + __builtin_amdgcn_exp2f(x * -1.4426950408889634f)); }
                        else if (MODE == 2) { r = x; }
                        else { r = __builtin_amdgcn_rcpf(1.0f + __builtin_amdgcn_exp2f(fmaf(x, -1.4426950408889634f, bv[bj][n][j]))); }
                        o[4 * n + j] = r; if (STATS) { rs += r; rq += r * r; } }
                v4u w; w.x = cvt_pk_bf16(o[0], o[1]); w.y = cvt_pk_bf16(o[2], o[3]); w.z = cvt_pk_bf16(o[4], o[5]); w.w = cvt_pk_bf16(o[6], o[7]);
                *(v4u*)(rowp + bj * 128) = w;
            }
            if (STATS) { rs += __shfl_xor(rs, 16); rs += __shfl_xor(rs, 32); rq += __shfl_xor(rq, 16); rq += __shfl_xor(rq, 32);
                if (fq == 0) part[(size_t)((pn - 8) * 4 + wc) * MTOT + row] = (f32x2){rs, rq}; }
        }
}
template <bool SCALE> struct Epi1 {
    static constexpr bool PERM = true; static constexpr bool KEEP = false; static constexpr bool CARRY = SCALE;
    bf16* P; const float* bgate; f32x2* part; const float* rs; LAS float* rsl;
    __device__ __forceinline__ float pre(const Unit& u, int tid) const { return rs[u.pm * 256 + (tid & 255)]; }
    __device__ __forceinline__ void body(AccRef acc, const Unit& u, int wr, int wc, int fr, int fq) const {
        const int pn = u.pn;
        if (pn < 8) epi1_body<0, false, SCALE>(acc, P, bgate, part, rsl, u.pm, pn, wr, wc, fr, fq);
        else if (pn < 16) epi1_body<0, true, SCALE>(acc, P, bgate, part, rsl, u.pm, pn, wr, wc, fr, fq);
        else if (pn >= 40) epi1_gate<SCALE>(acc, P, bgate, rsl, u.pm, pn - 40, wr, wc, fr, fq);
        else if (pn >= 24 && pn < 32) epi1_body<2, false, SCALE>(acc, P, bgate, part, rsl, u.pm, pn, wr, wc, fr, fq);
        else epi1_body<1, false, SCALE>(acc, P, bgate, part, rsl, u.pm, pn, wr, wc, fr, fq);
    }
    __device__ __forceinline__ void operator()(AccRef acc, const Unit& u, int wr, int wc, int fr, int fq) const { body(acc, u, wr, wc, fr, fq); }
    __device__ __forceinline__ void operator()(AccRef acc, const Unit& u, int wr, int wc, int fr, int fq, float carry, int tid) const {
        if (tid < 256) rsl[tid] = carry;
        asm volatile("s_waitcnt lgkmcnt(0)" ::: "memory"); __builtin_amdgcn_s_barrier();
        body(acc, u, wr, wc, fr, fq);
    }
};
struct EpiD1 {
    static constexpr bool PERM = true; static constexpr bool KEEP = false; static constexpr bool CARRY = false;
    bf16* YT;
    __device__ __forceinline__ void operator()(AccRef acc, const Unit& u, int wr, int wc, int fr, int fq) const {
        bf16* o0 = YT + ((size_t)u.pn * 2048 + (size_t)(u.aux * 256 + wr * 64 + fr)) * 512 + u.pm * 256 + wc * 32 + 8 * fq;
#pragma unroll
        for (int ai = 0; ai < 2; ++ai)
#pragma unroll
            for (int m = 0; m < 4; ++m) { bf16* rowp = o0 + (size_t)(ai * 128 + m * 16) * 512;
#pragma unroll
                for (int bj = 0; bj < 2; ++bj) { const f32x4 v0 = acc[ai][bj][m][0] * 0.0625f, v1 = acc[ai][bj][m][1] * 0.0625f;
                    v4u w; w.x = cvt_pk_bf16(v0[0], v0[1]); w.y = cvt_pk_bf16(v0[2], v0[3]); w.z = cvt_pk_bf16(v1[0], v1[1]); w.w = cvt_pk_bf16(v1[2], v1[3]);
                    *(v4u*)(rowp + bj * 128) = w; } }
    }
};
struct EpiD2 {
    static constexpr bool PERM = true; static constexpr bool KEEP = false; static constexpr bool CARRY = false;
    bf16* P;
    __device__ __forceinline__ void operator()(AccRef acc, const Unit& u, int wr, int wc, int fr, int fq) const {
        const int rt = u.aux; int tok0, N1;
        if (rt < 64) { N1 = 8; tok0 = (rt >> 3) * 2048 + (rt & 7); } else { N1 = 16; tok0 = MPR + ((rt - 64) >> 4) * 4096 + ((rt - 64) & 15); }
        const float scale = 0.0625f;
        const size_t rstride = (size_t)N1 * LDP;
        const bf16* Pb = P + (size_t)(tok0 + N1 * (wr * 64 + fr)) * LDP + C_ZB + u.pn * 256 + wc * 32 + 8 * fq;
        v4u z[2][4][2];
#pragma unroll
        for (int ai = 0; ai < 2; ++ai)
#pragma unroll
            for (int m = 0; m < 4; ++m)
#pragma unroll
                for (int bj = 0; bj < 2; ++bj) z[ai][m][bj] = *(const v4u*)(Pb + (size_t)(ai * 128 + m * 16) * rstride + bj * 128);
        asm volatile("" ::: "memory");
#pragma unroll
        for (int ai = 0; ai < 2; ++ai)
#pragma unroll
            for (int m = 0; m < 4; ++m) { bf16* rowp = (bf16*)Pb + (size_t)(ai * 128 + m * 16) * rstride;
#pragma unroll
                for (int bj = 0; bj < 2; ++bj) { const v4u zz = z[ai][m][bj]; const f32x4 v0 = acc[ai][bj][m][0] * scale, v1 = acc[ai][bj][m][1] * scale;
                    v4u w; w.x = cvt_pk_bf16(v0[0] * bf_lo(zz.x), v0[1] * bf_hi(zz.x)); w.y = cvt_pk_bf16(v0[2] * bf_lo(zz.y), v0[3] * bf_hi(zz.y));
                    w.z = cvt_pk_bf16(v1[0] * bf_lo(zz.z), v1[1] * bf_hi(zz.z)); w.w = cvt_pk_bf16(v1[2] * bf_lo(zz.w), v1[3] * bf_hi(zz.w));
                    *(v4u*)(rowp + bj * 128) = w; } }
        asm volatile("" ::: "memory");
    }
};
struct OrderG2 {
    pg8::OrderMN o; const char* A2; const char* B2;
    __device__ __forceinline__ bool next(int i, Unit& u) const {
        if (!o.next(i >> 1, u)) return false;
        u.aux = i & 1; if (u.aux) { u.a = A2 + (size_t)u.pm * o.tA; u.b = B2 + (size_t)u.pn * o.tB; } return true; }
    __device__ __forceinline__ void a_ready(const Unit&) const {}
    __device__ __forceinline__ void done(const Unit&) const {}
};
struct Epi2G {
    static constexpr bool PERM = true; static constexpr bool KEEP = true; static constexpr bool CARRY = false;
    const bf16* P; bf16* Mb;
    __device__ __forceinline__ bool keep(const Unit& u) const { return u.aux == 0; }
    __device__ __forceinline__ void operator()(AccMut acc, const Unit& u, int wr, int wc, int fr, int fq) const {
        const int row0 = u.pm * 256 + wr * 64 + fr, col0 = u.pn * 256 + wc * 32 + 8 * fq;
        const bf16* gp = P + (size_t)row0 * LDP + (u.aux ? C_GB : C_GA) + col0;
        v4u g[2][4][2];
#pragma unroll
        for (int ai = 0; ai < 2; ++ai)
#pragma unroll
            for (int m = 0; m < 4; ++m)
#pragma unroll
                for (int bj = 0; bj < 2; ++bj) g[ai][m][bj] = *(const v4u*)(gp + (size_t)(ai * 128 + m * 16) * LDP + bj * 128);
        asm volatile("" ::: "memory");
        if (u.aux == 0) {
#pragma unroll
            for (int ai = 0; ai < 2; ++ai)
#pragma unroll
                for (int m = 0; m < 4; ++m)
#pragma unroll
                    for (int bj = 0; bj < 2; ++bj) { v4u gg = g[ai][m][bj]; asm volatile("" : "+v"(gg.x), "+v"(gg.y), "+v"(gg.z), "+v"(gg.w));
                        acc[ai][bj][m][0] *= (f32x4){bf_lo(gg.x), bf_hi(gg.x), bf_lo(gg.y), bf_hi(gg.y)}; acc[ai][bj][m][1] *= (f32x4){bf_lo(gg.z), bf_hi(gg.z), bf_lo(gg.w), bf_hi(gg.w)}; }
        } else {
#pragma unroll
            for (int ai = 0; ai < 2; ++ai)
#pragma unroll
                for (int m = 0; m < 4; ++m) { bf16* op = Mb + (size_t)(row0 + ai * 128 + m * 16) * DM + col0;
#pragma unroll
                    for (int bj = 0; bj < 2; ++bj) { v4u gg = g[ai][m][bj]; asm volatile("" : "+v"(gg.x), "+v"(gg.y), "+v"(gg.z), "+v"(gg.w)); const f32x4 a0 = acc[ai][bj][m][0], a1 = acc[ai][bj][m][1];
                        v4u w; w.x = cvt_pk_bf16(a0[0] * bf_lo(gg.x), a0[1] * bf_hi(gg.x)); w.y = cvt_pk_bf16(a0[2] * bf_lo(gg.y), a0[3] * bf_hi(gg.y));
                        w.z = cvt_pk_bf16(a1[0] * bf_lo(gg.z), a1[1] * bf_hi(gg.z)); w.w = cvt_pk_bf16(a1[2] * bf_lo(gg.w), a1[3] * bf_hi(gg.w));
                        *(v4u*)(op + bj * 128) = w; } }
            asm volatile("" ::: "memory");
        }
    }
};
struct Epi3 {
    static constexpr bool PERM = true; static constexpr bool KEEP = false; static constexpr bool CARRY = false;
    bf16* x1; float* ss;
    __device__ __forceinline__ void operator()(AccRef acc, const Unit& u, int wr, int wc, int fr, int fq) const {
        const int rt = u.pm * 256;
        const int r0 = wr * 64 + fr, col0 = u.pn * 256 + wc * 32 + 8 * fq;
        bf16* xh = x1 + (size_t)rt * DM;
        const bool want = (ss != nullptr);
        v4u xw[2][4][2];
#pragma unroll
        for (int ai = 0; ai < 2; ++ai)
#pragma unroll
            for (int m = 0; m < 4; ++m)
#pragma unroll
                for (int bj = 0; bj < 2; ++bj) xw[ai][m][bj] = *(const v4u*)(xh + (size_t)(r0 + ai * 128 + m * 16) * DM + col0 + bj * 128);
        asm volatile("" ::: "memory");
#pragma unroll
        for (int ai = 0; ai < 2; ++ai)
#pragma unroll
            for (int m = 0; m < 4; ++m) { float q = 0.f; int rr = r0 + ai * 128 + m * 16; asm volatile("" : "+v"(rr));
#pragma unroll
                for (int bj = 0; bj < 2; ++bj) { v4u w = xw[ai][m][bj]; asm volatile("" : "+v"(w.x), "+v"(w.y), "+v"(w.z), "+v"(w.w));
                    const f32x4 v0 = (f32x4){bf_lo(w.x), bf_hi(w.x), bf_lo(w.y), bf_hi(w.y)} + acc[ai][bj][m][0], v1 = (f32x4){bf_lo(w.z), bf_hi(w.z), bf_lo(w.w), bf_hi(w.w)} + acc[ai][bj][m][1];
                    q += (v0.x * v0.x + v0.y * v0.y) + (v0.z * v0.z + v0.w * v0.w) + (v1.x * v1.x + v1.y * v1.y) + (v1.z * v1.z + v1.w * v1.w);
                    v4u o; o.x = cvt_pk_bf16(v0.x, v0.y); o.y = cvt_pk_bf16(v0.z, v0.w); o.z = cvt_pk_bf16(v1.x, v1.y); o.w = cvt_pk_bf16(v1.z, v1.w);
                    *(v4u*)(xh + (size_t)rr * DM + col0 + bj * 128) = o; }
                if (want) { q += __shfl_xor(q, 16); q += __shfl_xor(q, 32); if (fq == 0) ss[(size_t)(u.pn * 4 + wc) * MTOT + rt + rr] = q; } }
        asm volatile("" ::: "memory");
    }
};

struct OrderD1 {
    int G, c; const char* D; const char* Z;
    __device__ __forceinline__ bool next(int i, Unit& u) const {
        const int L = i * G + c; if (L >= 2048) return false;
        u.pn = L >> 4; u.aux = (L >> 1) & 7; u.pm = L & 1;
        u.a = D + (size_t)u.pm * (256 * 512 * 2); u.b = Z + ((size_t)u.pn * 256 * 4096 + (size_t)u.aux * 512) * 2; return true; }
    __device__ __forceinline__ void a_ready(const Unit&) const {}
    __device__ __forceinline__ void done(const Unit&) const {}
};
struct OrderD2 {
    int G, c; const char* T; const char* YT;
    __device__ __forceinline__ bool next(int i, Unit& u) const {
        const int L = i * G + c; if (L >= 1024) return false;
        u.aux = L >> 3; u.pn = L & 7; u.pm = 0;
        u.a = T; u.b = YT + ((size_t)u.aux * 2048 + (size_t)u.pn * 256) * 512 * 2; return true; }
    __device__ __forceinline__ void a_ready(const Unit&) const {}
    __device__ __forceinline__ void done(const Unit&) const {}
};

__device__ constexpr float C16[16] = {1.0f, 0.9238795325112867f, 0.7071067811865476f, 0.3826834323650898f, 0.0f, -0.3826834323650898f, -0.7071067811865476f, -0.9238795325112867f,
                                      -1.0f, -0.9238795325112867f, -0.7071067811865476f, -0.3826834323650898f, 0.0f, 0.3826834323650898f, 0.7071067811865476f, 0.9238795325112867f};
__device__ constexpr float S16[16] = {0.0f, 0.3826834323650898f, 0.7071067811865476f, 0.9238795325112867f, 1.0f, 0.9238795325112867f, 0.7071067811865476f, 0.3826834323650898f,
                                      0.0f, -0.3826834323650898f, -0.7071067811865476f, -0.9238795325112867f, -1.0f, -0.9238795325112867f, -0.7071067811865476f, -0.3826834323650898f};
template <int N1> __device__ __forceinline__ void s1_items(const bf16* P, bf16* Z, const f32x2* TW, int row_base, int nb, int gt, int NGT) {
    constexpr int S = 256 * N1;
    const int nitems = nb * 256 * 512;
    for (int it = gt; it < nitems; it += NGT) {
        const int cg = it & 511, bn = it >> 9, n2 = bn & 255, b = bn >> 8, ch = cg * 4, g = ch >> 8, c = ch & 255;
        const bf16* src = P + (size_t)(row_base + b * S + n2) * LDP + C_XB + ch;
        float x[N1][4];
#pragma unroll
        for (int n1 = 0; n1 < N1; ++n1) { const v2u w = *(const v2u*)(src + (size_t)n1 * 256 * LDP); x[n1][0] = bf_lo(w.x); x[n1][1] = bf_hi(w.x); x[n1][2] = bf_lo(w.y); x[n1][3] = bf_hi(w.y); }
        bf16* dst = Z + (size_t)(row_base + b * S + n2) * 4096 + g * 512 + c;
#pragma unroll
        for (int k1 = 0; k1 <= N1 / 2; ++k1) {
            float re[4] = {0.f, 0.f, 0.f, 0.f}, im[4] = {0.f, 0.f, 0.f, 0.f};
#pragma unroll
            for (int n1 = 0; n1 < N1; ++n1) { const float cs = C16[((n1 * k1) % N1) * (16 / N1)], sn = S16[((n1 * k1) % N1) * (16 / N1)];
#pragma unroll
                for (int j = 0; j < 4; ++j) { re[j] = fmaf(x[n1][j], cs, re[j]); im[j] = fmaf(x[n1][j], -sn, im[j]); } }
#pragma unroll
            for (int mir = 0; mir < 2; ++mir) {
                if (mir == 1 && (k1 == 0 || k1 == N1 / 2)) continue;
                const int kk = mir ? N1 - k1 : k1;
                float imm[4];
#pragma unroll
                for (int j = 0; j < 4; ++j) imm[j] = mir ? -im[j] : im[j];
                const f32x2 tw = TW[(n2 * kk) & (S - 1)]; const float ct = tw.x, st = tw.y;
                v2u wr_, wi_;
                wr_.x = cvt_pk_bf16(re[0] * ct + imm[0] * st, re[1] * ct + imm[1] * st); wr_.y = cvt_pk_bf16(re[2] * ct + imm[2] * st, re[3] * ct + imm[3] * st);
                wi_.x = cvt_pk_bf16(imm[0] * ct - re[0] * st, imm[1] * ct - re[1] * st); wi_.y = cvt_pk_bf16(imm[2] * ct - re[2] * st, imm[3] * ct - re[3] * st);
                *(v2u*)(dst + (size_t)kk * 256 * 4096) = wr_; *(v2u*)(dst + (size_t)kk * 256 * 4096 + 256) = wi_;
            }
        }
    }
}

#define XB_TMO      128
#define XB_XCNT(j)  (256  + 64 * (j))
#define XB_XSUB(j)  (1280 + 64 * (j))
#define XB_XGEN(j)  (2304 + 64 * (j))
#define XB_TOP      3328
#define XB_TOPGEN   3392
#define XCD_BAR_WORDS 3456
#define XB_SPIN_CAP (1u << 18)
__device__ __forceinline__ unsigned xb_ld(unsigned* p)              { return __hip_atomic_load(p, __ATOMIC_RELAXED, __HIP_MEMORY_SCOPE_AGENT); }
__device__ __forceinline__ unsigned xb_add(unsigned* p, unsigned v) { return __hip_atomic_fetch_add(p, v, __ATOMIC_RELAXED, __HIP_MEMORY_SCOPE_AGENT); }
__device__ __forceinline__ unsigned xb_xcc_id() { return (unsigned)__builtin_amdgcn_s_getreg((3 << 11) | 20) & 0xFu; }
#define XB_SPIN(cond, bar) do { unsigned _sp = 0; while (cond) { __builtin_amdgcn_s_sleep(1); \
    if ((++_sp & 255u) == 0u) { if (xb_ld(&(bar)[XB_TMO])) break; if (_sp > XB_SPIN_CAP) { atomicAdd(&(bar)[XB_TMO], 1u); break; } } } } while (0)
struct XcdBarrier { unsigned* bar; unsigned x; volatile LAS unsigned* st; };
__device__ __forceinline__ XcdBarrier xcd_barrier_post(unsigned* bar, volatile LAS unsigned* st, bool leader) {
    XcdBarrier b; b.bar = bar; b.x = xb_xcc_id(); b.st = st;
    if (leader) (void)xb_add(&bar[XB_XCNT(b.x)], 1u);
    return b;
}
__device__ __forceinline__ void xcd_barrier_complete(unsigned* bar, unsigned x, unsigned& nloc, unsigned& nx) {
    const unsigned G = gridDim.x * gridDim.y * gridDim.z;
    unsigned sum, cnt, mine, sp = 0u;
    for (;;) {
        sum = 0u; cnt = 0u; mine = 0u;
#pragma unroll
        for (unsigned j = 0; j < 16; ++j) { const unsigned c = xb_ld(&bar[XB_XCNT(j)]); sum += c; cnt += (c > 0u) ? 1u : 0u; mine = (j == x) ? c : mine; }
        if (sum == G) break;
        __builtin_amdgcn_s_sleep(1);
        if ((++sp & 255u) == 0u) { if (xb_ld(&bar[XB_TMO])) break; if (sp > XB_SPIN_CAP) { atomicAdd(&bar[XB_TMO], 1u); break; } }
    }
    nloc = mine > 0u ? mine : 1u; nx = cnt > 0u ? cnt : 1u;
}
__device__ __forceinline__ void xcd_barrier(const XcdBarrier& b, bool leader) {
    asm volatile("s_waitcnt vmcnt(0)" ::: "memory");
    __syncthreads();
    if (leader) {
        unsigned* bar = b.bar;
        __builtin_amdgcn_s_waitcnt(0);
        unsigned nloc = b.st[0], nx = b.st[1];
        if (nloc == 0u) { xcd_barrier_complete(bar, b.x, nloc, nx); b.st[0] = nloc; b.st[1] = nx; }
        const unsigned old = xb_add(&bar[XB_XSUB(b.x)], 1u);
        const unsigned gen = old / nloc;
        if (old + 1u == (gen + 1u) * nloc) {
            __builtin_amdgcn_fence(__ATOMIC_RELEASE, "agent");
            asm volatile("s_waitcnt vmcnt(0)" ::: "memory");
            const unsigned og = xb_add(&bar[XB_TOP], 1u);
            const unsigned tg = og / nx;
            if (og + 1u == (tg + 1u) * nx) xb_add(&bar[XB_TOPGEN], 1u);
            else XB_SPIN(xb_ld(&bar[XB_TOPGEN]) == tg, bar);
            __builtin_amdgcn_fence(__ATOMIC_ACQUIRE, "agent");
            xb_add(&bar[XB_XGEN(b.x)], 1u);
            asm volatile("s_waitcnt vmcnt(0)" ::: "memory");
        } else {
            XB_SPIN(xb_ld(&bar[XB_XGEN(b.x)]) == gen, bar);
            __builtin_amdgcn_fence(__ATOMIC_ACQUIRE, "agent");
            asm volatile("s_waitcnt vmcnt(0)" ::: "memory");
        }
    }
    __syncthreads();
}

__device__ __forceinline__ float wave_sum(float v) {
#pragma unroll
    for (int o = 1; o < 64; o <<= 1) v += __shfl_xor(v, o);
    return v;
}
__device__ __forceinline__ void p0_transpose_item(const float* W, int K, int N, bf16* WT, LAS float* scr, int item, int lane, bool deal = false, const float* gk = nullptr) {
    const int nblk = N / 32, kb = item / nblk, nb = item % nblk, k0 = 64 * kb, n0 = 32 * nb;
    float wv[32];
#pragma unroll
    for (int i = 0; i < 32; ++i) wv[i] = W[(size_t)(k0 + 2 * i + (lane >> 5)) * N + n0 + (lane & 31)];
#pragma unroll
    for (int i = 0; i < 32; ++i) scr[(2 * i + (lane >> 5)) * 33 + (lane & 31)] = wv[i];
    LDS_WAIT(); asm volatile("" ::: "memory");
    const int c = lane & 7;
    f32x4 ga = {1.f, 1.f, 1.f, 1.f}, gb = {1.f, 1.f, 1.f, 1.f};
    if (gk) { ga = *(const f32x4*)(gk + k0 + 8 * c); gb = *(const f32x4*)(gk + k0 + 8 * c + 4); }
    int nd = n0;
    if (deal && n0 >= C_GA) { const int g = n0 - C_GA, hb = (g >= DM) ? 1 : 0, gg = g - hb * DM; nd = C_GA + ((gg >> 7) << 8) + hb * 128 + (gg & 127); }
#pragma unroll
    for (int j = 0; j < 4; ++j) { const int n = (lane >> 3) + 8 * j; const LAS float* s = scr + (8 * c) * 33 + n;
        v4u o; o.x = pk2(s[0 * 33] * ga.x, s[1 * 33] * ga.y); o.y = pk2(s[2 * 33] * ga.z, s[3 * 33] * ga.w); o.z = pk2(s[4 * 33] * gb.x, s[5 * 33] * gb.y); o.w = pk2(s[6 * 33] * gb.z, s[7 * 33] * gb.w);
        *(GAS v4u*)(WT + (size_t)(nd + n) * K + k0 + 8 * c) = o; }
    LDS_WAIT(); asm volatile("" ::: "memory");
}
__device__ __forceinline__ void x_row_to_bf16(const float* xrow, bf16* orow, float* rs, int lane) {
    const GAS f32x4* xr = (const GAS f32x4*)xrow + lane;
    f32x4 v[16]; float s = 0.f;
#pragma unroll
    for (int j = 0; j < 16; ++j) { v[j] = xr[64 * j]; s += (v[j].x * v[j].x + v[j].y * v[j].y) + (v[j].z * v[j].z + v[j].w * v[j].w); }
    const float rstd = 1.0f / sqrtf(wave_sum(s) * (1.0f / DM) + EPS);
    GAS v2u* o8 = (GAS v2u*)orow + lane;
#pragma unroll
    for (int j = 0; j < 16; ++j) { v2u w; w.x = cvt_pk_bf16(v[j].x, v[j].y); w.y = cvt_pk_bf16(v[j].z, v[j].w); o8[64 * j] = w; }
    if (lane == 0) *rs = rstd;
}
__device__ __forceinline__ void rms_row_bf16_to_f32(const bf16* xrow, const f32x4 (&g8)[8][2], float* orow, int lane) {
    const GAS v4u* xr = (const GAS v4u*)xrow + lane;
    v4u w[8]; float s = 0.f;
#pragma unroll
    for (int j = 0; j < 8; ++j) w[j] = xr[64 * j];
#pragma unroll
    for (int j = 0; j < 8; ++j) { const float a0 = bf_lo(w[j].x), a1 = bf_hi(w[j].x), a2 = bf_lo(w[j].y), a3 = bf_hi(w[j].y), a4 = bf_lo(w[j].z), a5 = bf_hi(w[j].z), a6 = bf_lo(w[j].w), a7 = bf_hi(w[j].w);
        s += (a0 * a0 + a1 * a1) + (a2 * a2 + a3 * a3) + (a4 * a4 + a5 * a5) + (a6 * a6 + a7 * a7); }
    const float rstd = 1.0f / sqrtf(wave_sum(s) * (1.0f / DM) + EPS);
    GAS f32x4* o = (GAS f32x4*)orow + 2 * lane;
#pragma unroll
    for (int j = 0; j < 8; ++j) { const f32x4 ga = g8[j][0] * rstd, gb = g8[j][1] * rstd;
        o[128 * j] = (f32x4){bf_lo(w[j].x) * ga.x, bf_hi(w[j].x) * ga.y, bf_lo(w[j].y) * ga.z, bf_hi(w[j].y) * ga.w};
        o[128 * j + 1] = (f32x4){bf_lo(w[j].z) * gb.x, bf_hi(w[j].z) * gb.y, bf_lo(w[j].w) * gb.z, bf_hi(w[j].w) * gb.w}; }
}

struct Args { const float* in[13]; float* out; unsigned char* ws; int ph_lo, ph_hi, li, pad; };
typedef __attribute__((address_space(4))) const Args CArgs;
#define PHASE_BEGIN() \
    unsigned oz_ = 0u; asm volatile("" : "+s"(oz_));              \
    CArgs* AP = (CArgs*)((__attribute__((address_space(4))) const char*)__builtin_amdgcn_kernarg_segment_ptr() + oz_); \
    int t_ = (wave0 << 6) | (int)__builtin_amdgcn_mbcnt_hi(~0u, __builtin_amdgcn_mbcnt_lo(~0u, oz_)); asm volatile("" : "+v"(t_));       \
    const int tid = t_, lane = tid & 63, wave = __builtin_amdgcn_readfirstlane(tid >> 6); \
    int G = G0, vcu = vcu0, bx = bx0; asm volatile("" : "+s"(G), "+s"(vcu), "+s"(bx)); (void)bx; \
    unsigned char* ws = AP->ws; float* out = AP->out; (void)lane; (void)wave; (void)out; \
    const int gw = vcu * NWAVES + wave, NGW = G * NWAVES, gt = vcu * (NWAVES * 64) + tid, NGT = G * NWAVES * 64; (void)gw; (void)NGW; (void)gt; (void)NGT

__global__ void __launch_bounds__(NWAVES * 64, 2) trunk_fwd(Args args) {
    extern __shared__ __attribute__((aligned(16))) unsigned char lds_raw[];
    LAS unsigned char* lds = (LAS unsigned char*)lds_raw;
    const int G0 = gridDim.x, bx0 = blockIdx.x; const int vcu0 = (G0 % 8 == 0) ? (bx0 % 8) * (G0 / 8) + bx0 / 8 : bx0;
    const int wave0 = __builtin_amdgcn_readfirstlane(threadIdx.x >> 6);
    for (int u = threadIdx.x; u < (LDS_BYTES - LDSCTL_OFF) / 4; u += NWAVES * 64) ((LAS unsigned*)(lds + LDSCTL_OFF))[u] = 0u;
    __syncthreads();
#if !MK_PER_PHASE
    (void)xcd_barrier_post((unsigned*)(args.ws + WS_CTL) + CW_BAR, (volatile LAS unsigned*)(lds + MISC_OFF) + 8, threadIdx.x == 0);
#define GRID_BAR() do { unsigned ozb_ = 0u; asm volatile("" : "+s"(ozb_)); \
        CArgs* AB_ = (CArgs*)((__attribute__((address_space(4))) const char*)__builtin_amdgcn_kernarg_segment_ptr() + ozb_); \
        XcdBarrier b_; b_.bar = (unsigned*)(AB_->ws + WS_CTL) + CW_BAR; b_.x = xb_xcc_id(); b_.st = (volatile LAS unsigned*)(lds + MISC_OFF) + 8; xcd_barrier(b_, wave0 == 0 && lane_id() == 0); } while (0)
#else
#define GRID_BAR() do { } while (0)
#endif
    const int lo = args.ph_lo, hi = args.ph_hi;
#define IN(k) (lo <= (k) && (k) < hi)
#define BOTH(k) (IN(k) && IN((k) + 1))

    if (IN(0)) {
        PHASE_BEGIN();
            bf16* DC = (bf16*)(ws + WS_DC); bf16* TT = (bf16*)(ws + WS_T);
            for (int e = gt; e < 512 * 512 / 8; e += NGT) { const int r = e >> 6, q0 = (e & 63) * 8; const int po = r >> 8, m = r & 255, pi = q0 >> 8, c0 = q0 & 255; float v[8];
#pragma unroll
                for (int j = 0; j < 8; ++j) { const float ph = (float)((m * (c0 + j)) & 255) * (1.0f / 128.0f); v[j] = (po == pi) ? cospif(ph) : ((po == 0) ? sinpif(ph) : -sinpif(ph)); }
                v4u w; w.x = pk2(v[0], v[1]); w.y = pk2(v[2], v[3]); w.z = pk2(v[4], v[5]); w.w = pk2(v[6], v[7]); *(GAS v4u*)(DC + (size_t)e * 8) = w; }
            for (int e = gt; e < 256 * 512 / 8; e += NGT) { const int k2 = e >> 6, q0 = (e & 63) * 8; const int pi = q0 >> 8, n0 = q0 & 255; float v[8];
#pragma unroll
                for (int j = 0; j < 8; ++j) { const float ph = (float)((k2 * (n0 + j)) & 255) * (1.0f / 128.0f); v[j] = pi ? sinpif(ph) : cospif(ph); }
                v4u w; w.x = pk2(v[0], v[1]); w.y = pk2(v[2], v[3]); w.z = pk2(v[4], v[5]); w.w = pk2(v[6], v[7]); *(GAS v4u*)(TT + (size_t)e * 8) = w; }

        { f32x2* TW = (f32x2*)(ws + WS_TW);
          for (int e = gt; e < 2048 + 4096; e += NGT) { const bool big = e >= 2048; const int j = big ? e - 2048 : e; const float ph = (float)j * (big ? (2.0f / 4096.0f) : (2.0f / 2048.0f)), sc = big ? 0.25f : 0.35355339059327373f;
              TW[e] = (f32x2){cospif(ph) * sc, sinpif(ph) * sc}; } }
    }

    for (int l = 0; l < 2; ++l) {
        const int pb = 7 * l;

        if (IN(pb + 0)) {
            PHASE_BEGIN();
            const float* norm_g = AP->in[2] + (size_t)l * DM;
            const float* w_in = AP->in[3] + (size_t)l * DM * DIN;
            const float* w_a = AP->in[8] + (size_t)l * DA * DM;
            const float* w_b = AP->in[9] + (size_t)l * DB * DM;
            const float* w_out = AP->in[11] + (size_t)l * DM * DM;
            bf16* W1T = (bf16*)(ws + WS_W1T); bf16* WAT = (bf16*)(ws + WS_WAT); bf16* WBT = (bf16*)(ws + WS_WBT); bf16* WOT = (bf16*)(ws + WS_WOT);
            LAS float* scr = (LAS float*)(lds + RING_OFF + wave * 16384);
            constexpr int I_1 = (DM / 64) * (DIN / 32), I_A = (DA / 64) * (DM / 32), I_O = (DM / 64) * (DM / 32);
            constexpr int NITEMS = I_1 + 2 * I_A + I_O;
            for (int it = gw; it < NITEMS; it += NGW) {
                int r = it;
                if (r < I_1) { p0_transpose_item(w_in, DM, DIN, W1T, scr, r, lane, true, norm_g); continue; } r -= I_1;
                if (r < I_A) { p0_transpose_item(w_a, DA, DM, WAT, scr, r, lane); continue; } r -= I_A;
                if (r < I_A) { p0_transpose_item(w_b, DB, DM, WBT, scr, r, lane); continue; } r -= I_A;
                p0_transpose_item(w_out, DM, DM, WOT, scr, r, lane);
            }
            if (l == 0) {
                const float* x_prompt = AP->in[0]; const float* x_sample = AP->in[1];
                bf16* X0 = (bf16*)(ws + WS_X1); float* RS0 = (float*)(ws + WS_RSTD);
                for (int m = gw; m < MTOT; m += NGW) {
                    const float* xrow = (m < MPR) ? x_prompt + (size_t)m * DM : x_sample + (size_t)(m - MPR) * DM;
                    x_row_to_bf16(xrow, X0 + (size_t)m * DM, RS0 + m, lane);
                }
            } else {
                float* RS = (float*)(ws + WS_RSTD); const float* SS = (const float*)(ws + WS_PART);
                for (int m = gt; m < MTOT; m += NGT) { float s = 0.f;
#pragma unroll 16
                    for (int j = 0; j < 64; ++j) s += SS[(size_t)j * MTOT + m];
                    RS[m] = 1.0f / sqrtf(s * (1.0f / DM) + EPS); }
            }
            VM_WAIT(); __syncthreads();
            if (BOTH(pb + 0)) GRID_BAR();
        }

        if (IN(pb + 1)) {
            PHASE_BEGIN();
            pg8::OrderMN S; S.init(MTOT / 256, DIN / 256, G, bx, ws + WS_X1, (size_t)256 * DM * 2, ws + WS_W1T, (size_t)256 * DM * 2);
            Epi1<true> E{(bf16*)(ws + WS_P), AP->in[10] + (size_t)l * 2 * DM, (f32x2*)(ws + WS_PART), (const float*)(ws + WS_RSTD), (LAS float*)(lds + RS_OFF)};
            pg8::gemm_phase<Epi1<true>, pg8::OrderMN, PG8_ALIGN, PG8_SP2>(wave0, lds + RING_OFF, DM, DM, DM, S, E);
            if (BOTH(pb + 1)) GRID_BAR();
        }

        if (IN(pb + 2)) {
            PHASE_BEGIN();
            const float* ln_g = AP->in[4] + (size_t)l * DA;
            const float* ln_b = AP->in[5] + (size_t)l * DA;
            const float* w_sp = AP->in[6] + (size_t)l * 16 * 128 * 128;
            const float* b_sp = AP->in[7] + (size_t)l * 16 * 128;
            bf16* P = (bf16*)(ws + WS_P); const f32x2* PART = (const f32x2*)(ws + WS_PART);
            LAS unsigned char* tile = lds + RING_OFF;
            LAS float* red = (LAS float*)(lds + RING_OFF + 65536);
            LAS float* st = (LAS float*)(lds + STAT_OFF);
            const int fr = lane & 15, g4 = lane >> 4, wp = wave >> 1, wcx = wave & 1;
            for (int chunk = vcu; chunk < 256; chunk += G) {
                const int r0 = chunk * 128;
                { const int row = tid & 127, grp = tid >> 7; float s = 0.f, q = 0.f;
#pragma unroll
                  for (int k = 0; k < 8; ++k) { const f32x2 p = PART[(size_t)(grp * 8 + k) * MTOT + r0 + row]; s += p.x; q += p.y; }
                  red[(grp * 128 + row) * 2] = s; red[(grp * 128 + row) * 2 + 1] = q; }
                __syncthreads();
                if (tid < 128) { float s = 0.f, q = 0.f;
#pragma unroll
                    for (int k = 0; k < 4; ++k) { s += red[(k * 128 + tid) * 2]; q += red[(k * 128 + tid) * 2 + 1]; }
                    const float mu = s * (1.0f / DA); const float var = q * (1.0f / DA) - mu * mu; st[tid] = mu; st[128 + tid] = 1.0f / sqrtf(var + EPS); }
                const int sq = tid >> 2, spart = tid & 3;
                const bf16* gsrc = P + (size_t)(r0 + sq) * LDP + C_GV + spart * 32;
                v4u gr[4];
#pragma unroll
                for (int j = 0; j < 4; ++j) gr[j] = *(const v4u*)(gsrc + 8 * j);
                for (int head = 0; head < 16; ++head) {
                    const int cc0 = head * 128;
                    int th_ = tid; asm volatile("" : "+v"(th_));
                    const int fr = th_ & 15, g4 = (th_ >> 4) & 3, sq = th_ >> 2, spart = th_ & 3;
                    const bf16* gsrc = P + (size_t)(r0 + sq) * LDP + C_GV + spart * 32;
                    __syncthreads();
#pragma unroll
                    for (int j = 0; j < 4; ++j) *(LAS v4u*)(tile + sq * 288 + spart * 64 + 16 * j) = gr[j];
                    __syncthreads();
                    if (head + 1 < 16) {
#pragma unroll
                        for (int j = 0; j < 4; ++j) gr[j] = *(const v4u*)(gsrc + (cc0 + 128) + 8 * j);
                    }
                    v2u uq[4][2], zq[4][2];
#pragma unroll
                    for (int ci = 0; ci < 4; ++ci) { const int c = 64 * wcx + 16 * ci + 4 * g4;
#pragma unroll
                        for (int pj = 0; pj < 2; ++pj) { const bf16* up = P + (size_t)(r0 + 32 * wp + 16 * pj + fr) * LDP + cc0 + c; uq[ci][pj] = *(const v2u*)(up + C_U); zq[ci][pj] = *(const v2u*)(up + C_ZA); } }
                    bf16x8 wf[2][4]; float av[2], w1v[2], bsv[2];
                    const float* wsrc = w_sp + (size_t)head * 128 * 128;
#pragma unroll
                    for (int pj = 0; pj < 2; ++pj) { const int p = 32 * wp + 16 * pj + fr; float ap = 0.f, w1 = 0.f;
#pragma unroll
                        for (int ks = 0; ks < 4; ++ks) { const int q0 = 32 * ks + 8 * g4;
                            const f32x4 wa = *(const f32x4*)(wsrc + p * 128 + q0), wb = *(const f32x4*)(wsrc + p * 128 + q0 + 4);
                            const f32x4 ra = *(const LAS f32x4*)(st + 128 + q0), rb = *(const LAS f32x4*)(st + 128 + q0 + 4);
                            const f32x4 ma = *(const LAS f32x4*)(st + q0), mb = *(const LAS f32x4*)(st + q0 + 4);
                            const f32x4 sa = wa * ra, sb = wb * rb;
                            ap += (sa.x * ma.x + sa.y * ma.y) + (sa.z * ma.z + sa.w * ma.w) + (sb.x * mb.x + sb.y * mb.y) + (sb.z * mb.z + sb.w * mb.w);
                            w1 += (wa.x + wa.y) + (wa.z + wa.w) + (wb.x + wb.y) + (wb.z + wb.w);
                            v4u pk; pk.x = cvt_pk_bf16(sa.x, sa.y); pk.y = cvt_pk_bf16(sa.z, sa.w); pk.z = cvt_pk_bf16(sb.x, sb.y); pk.w = cvt_pk_bf16(sb.z, sb.w);
                            wf[pj][ks] = __builtin_bit_cast(bf16x8, pk); }
                        ap += __shfl_xor(ap, 16); ap += __shfl_xor(ap, 32); w1 += __shfl_xor(w1, 16); w1 += __shfl_xor(w1, 32);
                        av[pj] = ap; w1v[pj] = w1; bsv[pj] = b_sp[head * 128 + p]; }
                    f32x4 acc[4][2];
#pragma unroll
                    for (int ci = 0; ci < 4; ++ci)
#pragma unroll
                        for (int pj = 0; pj < 2; ++pj) acc[ci][pj] = (f32x4){0.f, 0.f, 0.f, 0.f};
                    const int trq = fr >> 2, trp = fr & 3;
#pragma unroll
                    for (int ci = 0; ci < 4; ++ci)
#pragma unroll
                        for (int ks = 0; ks < 4; ++ks) {
                            typedef short v4s __attribute__((ext_vector_type(4)));
                            const LAS unsigned char* ta = tile + (32 * ks + 8 * g4 + trq) * 288 + (64 * wcx + 16 * ci) * 2 + 8 * trp;
                            const v4s t0 = __builtin_amdgcn_ds_read_tr16_b64_v4i16((LAS v4s*)ta);
                            const v4s t1 = __builtin_amdgcn_ds_read_tr16_b64_v4i16((LAS v4s*)(ta + 4 * 288));
                            const bf16x8 gf = {t0[0], t0[1], t0[2], t0[3], t1[0], t1[1], t1[2], t1[3]};
#pragma unroll
                            for (int pj = 0; pj < 2; ++pj) acc[ci][pj] = __builtin_amdgcn_mfma_f32_16x16x32_bf16(gf, wf[pj][ks], acc[ci][pj], 0, 0, 0);
                        }
#pragma unroll
                    for (int ci = 0; ci < 4; ++ci) { const int c = 64 * wcx + 16 * ci + 4 * g4;
                        const f32x4 gam = *(const f32x4*)(ln_g + cc0 + c), bet = *(const f32x4*)(ln_b + cc0 + c);
#pragma unroll
                        for (int pj = 0; pj < 2; ++pj) { const int p = 32 * wp + 16 * pj + fr; bf16* up = P + (size_t)(r0 + p) * LDP + cc0 + c;
                            const v2u u4 = uq[ci][pj], z4 = zq[ci][pj];
                            const f32x4 mx = gam * (acc[ci][pj] - av[pj]) + bet * w1v[pj] + bsv[pj];
                            v2u o; o.x = cvt_pk_bf16(bf_lo(u4.x) * mx.x * bf_lo(z4.x), bf_hi(u4.x) * mx.y * bf_hi(z4.x)); o.y = cvt_pk_bf16(bf_lo(u4.y) * mx.z * bf_lo(z4.y), bf_hi(u4.y) * mx.w * bf_hi(z4.y));
                            *(v2u*)(up + C_U) = o; } }
                }
                __syncthreads();
            }
            { int gt1 = gt; asm volatile("" : "+v"(gt1));
              s1_items<8>(P, (bf16*)(ws + WS_Z), (const f32x2*)(ws + WS_TW), 0, 8, gt1, NGT);
              int gt2 = gt; asm volatile("" : "+v"(gt2));
              s1_items<16>(P, (bf16*)(ws + WS_Z), (const f32x2*)(ws + WS_TW) + 2048, MPR, 4, gt2, NGT); }
            VM_WAIT(); __syncthreads();
            if (BOTH(pb + 2)) GRID_BAR();
        }

        if (IN(pb + 3)) {
            PHASE_BEGIN();
            OrderD1 S{G, vcu, (const char*)(ws + WS_DC), (const char*)(ws + WS_Z)};
            EpiD1 E{(bf16*)(ws + WS_H)};
            pg8::gemm_phase<EpiD1, OrderD1, PG8_ALIGN, PG8_SP2>(wave0, lds + RING_OFF, 512, 4096, 512, S, E);
            if (BOTH(pb + 3)) GRID_BAR();
        }

        if (IN(pb + 4)) {
            PHASE_BEGIN();
            OrderD2 S{G, vcu, (const char*)(ws + WS_T), (const char*)(ws + WS_H)};
            EpiD2 E{(bf16*)(ws + WS_P)};
            pg8::gemm_phase<EpiD2, OrderD2, PG8_ALIGN, PG8_SP2>(wave0, lds + RING_OFF, 512, 512, 512, S, E);
            if (BOTH(pb + 4)) GRID_BAR();
        }

        if (IN(pb + 5)) {
            PHASE_BEGIN();
            OrderG2 S; S.o.init(MTOT / 256, DM / 256, G, bx, ws + WS_P + (size_t)C_U * 2, (size_t)256 * LDP * 2, ws + WS_WAT, (size_t)256 * DA * 2);
            S.A2 = (const char*)(ws + WS_P + (size_t)C_ZB * 2); S.B2 = (const char*)(ws + WS_WBT);
            Epi2G E{(const bf16*)(ws + WS_P), (bf16*)(ws + WS_H)};
            pg8::gemm_phase<Epi2G, OrderG2, PG8_ALIGN, PG8_SP2>(wave0, lds + RING_OFF, LDP, DA, DA, S, E);
            if (BOTH(pb + 5)) GRID_BAR();
        }

        if (IN(pb + 6)) {
            PHASE_BEGIN();
            pg8::OrderMN S; S.init(MTOT / 256, DM / 256, G, bx, ws + WS_H, (size_t)256 * DM * 2, ws + WS_WOT, (size_t)256 * DM * 2);
            Epi3 E{(bf16*)(ws + WS_X1), (l == 0) ? (float*)(ws + WS_PART) : (float*)nullptr};
            pg8::gemm_phase<Epi3, pg8::OrderMN, PG8_ALIGN, PG8_SP2>(wave0, lds + RING_OFF, DM, DM, DM, S, E);
            if (BOTH(pb + 6)) GRID_BAR();
        }
    }

    if (IN(14)) {
        PHASE_BEGIN();
        const float* final_g = AP->in[12];
        const bf16* X2 = (const bf16*)(ws + WS_X1);
        f32x4 g8[8][2];
#pragma unroll
        for (int j = 0; j < 8; ++j) { g8[j][0] = ((const GAS f32x4*)final_g)[2 * (lane + 64 * j)]; g8[j][1] = ((const GAS f32x4*)final_g)[2 * (lane + 64 * j) + 1]; }
        for (int m = gw; m < MTOT; m += NGW) rms_row_bf16_to_f32(X2 + (size_t)m * DM, g8, out + (size_t)m * DM, lane);
    }
#undef IN
#undef BOTH
}

extern "C" void kernel_launch(void* const* d_in, const int* in_sizes, int n_in, void* d_out, int out_size, void* d_ws, size_t ws_size, hipStream_t stream) {
    static int grid = 0;
    if (grid == 0) {
        if (n_in != 13 || out_size != MTOT * DM || ws_size < WS_END) { fprintf(stderr, "kernel_launch: unexpected shapes (n_in %d out %d ws %zu); nothing launched\n", n_in, out_size, ws_size); grid = -1; return; }
        int dev = 0, cus = 0, per_cu = 0;
        if (hipGetDevice(&dev) != hipSuccess || hipDeviceGetAttribute(&cus, hipDeviceAttributeMultiprocessorCount, dev) != hipSuccess) { grid = -1; return; }
        if (hipFuncSetAttribute((const void*)trunk_fwd, hipFuncAttributeMaxDynamicSharedMemorySize, LDS_BYTES) != hipSuccess) { fprintf(stderr, "kernel_launch: hipFuncSetAttribute failed\n"); grid = -1; return; }
        if (hipOccupancyMaxActiveBlocksPerMultiprocessor(&per_cu, (const void*)trunk_fwd, NWAVES * 64, LDS_BYTES) != hipSuccess || per_cu < 1)
            fprintf(stderr, "kernel_launch: note: occupancy query reports %d workgroups per CU\n", per_cu);
        (void)hipGetLastError();
        grid = cus;
    }
    if (grid < 0) return;
    if (hipMemsetAsync((char*)d_ws + WS_CTL, 0, CTL_ZERO_BYTES, stream) != hipSuccess) return;
    Args a{};
    for (int i = 0; i < 13; ++i) a.in[i] = (const float*)d_in[i];
    a.out = (float*)d_out; a.ws = (unsigned char*)d_ws;
#if MK_PER_PHASE
    for (int p = 0; p < N_PHASES; ++p) { a.ph_lo = p; a.ph_hi = p + 1; a.li = p;
        hipLaunchKernelGGL(trunk_fwd, dim3(grid), dim3(NWAVES * 64), LDS_BYTES, stream, a); }
#else
    a.ph_lo = 0; a.ph_hi = N_PHASES; a.li = 0;
    hipLaunchKernelGGL(trunk_fwd, dim3(grid), dim3(NWAVES * 64), LDS_BYTES, stream, a);
#endif
}
```

```cpp
#include <hip/hip_runtime.h>
#include <cstdio>
#include <cstdint>

#ifndef MK_PER_PHASE
#define MK_PER_PHASE 0
#endif

#define GAS __attribute__((address_space(1)))
#define LAS __attribute__((address_space(3)))
typedef unsigned short bf16;
typedef unsigned v4u __attribute__((ext_vector_type(4)));
typedef unsigned v2u __attribute__((ext_vector_type(2)));
typedef float f32x4 __attribute__((ext_vector_type(4)));
typedef float f32x2 __attribute__((ext_vector_type(2)));
typedef short bf16x8 __attribute__((ext_vector_type(8)));
typedef GAS unsigned gu32;

constexpr int DM = 4096, DIN = 18432, DA = 2048, DB = 2048;
constexpr int MPR = 16384;
constexpr int MTOT = 32768;
constexpr int LDP = DIN;
constexpr int C_U = 0, C_GV = 2048, C_ZA = 4096, C_XB = 6144, C_ZB = 8192, C_GA = 10240, C_GB = 14336;
constexpr float EPS = 1e-6f;
constexpr int NWAVES = 8;
constexpr int N_PHASES = 15;

constexpr size_t MiB = 1u << 20;
constexpr size_t WS_CTL = 0, CTL_ZERO_BYTES = 32768;
constexpr size_t WS_W1T = 1 * MiB;
constexpr size_t WS_WAT = 145 * MiB;
constexpr size_t WS_WBT = 161 * MiB;
constexpr size_t WS_WOT = 177 * MiB;
constexpr size_t WS_DC = 210 * MiB;
constexpr size_t WS_TW = 212 * MiB;
constexpr size_t WS_T = 211 * MiB;
constexpr size_t WS_RSTD = 213 * MiB;
constexpr size_t WS_PART = 291 * MiB;
constexpr size_t WS_H = 300 * MiB;
constexpr size_t WS_P = 556 * MiB;
constexpr size_t WS_Z = 1708 * MiB;
constexpr size_t WS_X1 = 1964 * MiB;
constexpr size_t WS_END = 2220 * MiB;
constexpr int CW_BAR = 4096;

constexpr int RING_OFF = 0, RING_BYTES = 131072;
constexpr int LDSCTL_OFF = RING_BYTES, MISC_OFF = LDSCTL_OFF + 320;
constexpr int STAT_OFF = RING_BYTES + 1024;
constexpr int RS_OFF = RING_BYTES + 4096;
constexpr int LDS_BYTES = 147456;

#define RLX_AGENT __ATOMIC_RELAXED, __HIP_MEMORY_SCOPE_AGENT
#define LDS_WAIT() asm volatile("s_waitcnt lgkmcnt(0)" ::: "memory")
#define VM_WAIT() asm volatile("s_waitcnt vmcnt(0)" ::: "memory")

typedef __bf16 bf16x2_t __attribute__((ext_vector_type(2)));
__device__ __forceinline__ unsigned cvt_pk_bf16(float lo, float hi) { const f32x2 v = {lo, hi}; const bf16x2_t b = __builtin_convertvector(v, bf16x2_t); return __builtin_bit_cast(unsigned, b); }
__device__ __forceinline__ int lane_id() { return (int)__builtin_amdgcn_mbcnt_hi(~0u, __builtin_amdgcn_mbcnt_lo(~0u, 0u)); }
__device__ __forceinline__ float bf_lo(unsigned w) { return __builtin_bit_cast(float, w << 16); }
__device__ __forceinline__ float bf_hi(unsigned w) { return __builtin_bit_cast(float, w & 0xffff0000u); }
__device__ __forceinline__ float bf2f(bf16 b) { return __builtin_bit_cast(float, ((unsigned)b) << 16); }
__device__ __forceinline__ unsigned f2bf(float f) { unsigned u = __builtin_bit_cast(unsigned, f); return (u + 0x7fffu + ((u >> 16) & 1u)) >> 16; }
__device__ __forceinline__ unsigned pk2(float lo, float hi) { return f2bf(lo) | (f2bf(hi) << 16); }

namespace pg8 {
constexpr int BM = 256, BK = 64, HALF = 128, HTB = HALF * BK * 2, STAGE_BYTES = 8 * HTB, NXCD = 8, WGM = 8;
__host__ __device__ __forceinline__ int lds_byte(int r, int c) { const int st = (r >> 4) * 2 + (c >> 5), rr = r & 15, cc = c & 31, ob = rr * 64 + cc * 2; return st * 1024 + (ob ^ (((ob >> 9) & 1) << 5)); }
__host__ __device__ __forceinline__ void stage_rc(int b, int& R, int& C) { const int st = b / 1024, sb = b % 1024, swz = sb ^ (((sb >> 9) & 1) << 5); R = (st >> 1) * 16 + swz / 64; C = (st & 1) * 32 + (swz % 64) / 2; }
__host__ __device__ __forceinline__ int perm32(int rho) { const int n = rho >> 4, i = rho & 15; return 8 * (i >> 2) + 4 * n + (i & 3); }

struct Unit { const char* a; const char* b; int pm, pn, aux; };

struct OrderMN {
    int nM, nN, nwg, G, c; const char* A; const char* B; size_t tA, tB;
    __device__ __forceinline__ void init(int nM_, int nN_, int G_, int c_, const void* A_, size_t tA_, const void* B_, size_t tB_) { nM = nM_; nN = nN_; nwg = nM * nN; G = G_; c = c_; A = (const char*)A_; B = (const char*)B_; tA = tA_; tB = tB_; }
    __device__ __forceinline__ bool next(int i, Unit& u) const {
        const long L = (long)i * G + c; if (L >= nwg) return false;
        int wgid = (int)L; { const int q = nwg / NXCD, r = nwg % NXCD, xcd = wgid % NXCD, off = wgid / NXCD; wgid = (xcd < r ? xcd * (q + 1) : r * (q + 1) + (xcd - r) * q) + off; }
        const int nig = WGM * nN, gid = wgid / nig, fm = gid * WGM, gsz = (nM - fm) < WGM ? (nM - fm) : WGM;
        u.pm = fm + ((wgid % nig) % gsz); u.pn = (wgid % nig) / gsz; u.aux = 0;
        u.a = A + (size_t)u.pm * tA; u.b = B + (size_t)u.pn * tB; return true;
    }
    __device__ __forceinline__ void a_ready(const Unit&) const {}
    __device__ __forceinline__ void done(const Unit&) const {}
};

template <class Epi, class Sched, bool ALIGN_EPI, bool SP2>
__device__ __forceinline__ void gemm_phase(const int ws_, LAS unsigned char* lds, const int lda, const int ldb, const int K, const Sched& S, const Epi& E) {
    int tid_ = (ws_ << 6) | lane_id(); asm volatile("" : "+v"(tid_));
    const int tid = tid_, wid = __builtin_amdgcn_readfirstlane(tid >> 6), lane = tid & 63, wr = wid >> 2, wc = wid & 3, fr = lane & 15, fq = lane >> 4;
    const int nt = K / BK;
    unsigned voffA[2], voffB[2];
#pragma unroll
    for (int i = 0; i < 2; ++i) { int R, C; stage_rc(tid * 16 + i * 8192, R, C); const int Rb = Epi::PERM ? ((R & ~31) + perm32(R & 31)) : R;
        voffA[i] = (unsigned)(R * lda + C) * 2u; voffB[i] = (unsigned)(Rb * ldb + C) * 2u; }
    const size_t kstep = (size_t)(BK * 2);
    const size_t hstepA = (size_t)HALF * lda * 2, hstepB = (size_t)HALF * ldb * 2;
    const unsigned ldsw = (unsigned)wid * 1024u;
    const int aoff = lds_byte(wr * 64 + fr, fq * 8), boff = lds_byte(wc * 32 + fr, fq * 8);
#define PG8_SA(b, h) (((b) * 2 + (h)) * HTB)
#define PG8_SB(b, h) ((4 + (b) * 2 + (h)) * HTB)
#define PG8_STAGE(bufoff, gbase, voff) do { _Pragma("unroll") for (int _i = 0; _i < 2; ++_i) \
        __builtin_amdgcn_global_load_lds((const unsigned*)((const char*)(gbase) + (voff)[_i]), (LAS unsigned*)(lds + (bufoff) + ldsw + _i * 8192), 16, 0, 0); } while (0)
#define PG8_LDA(dst, b, h) do { _Pragma("unroll") for (int m = 0; m < 4; ++m) _Pragma("unroll") for (int k = 0; k < 2; ++k) dst[m][k] = *(const LAS bf16x8*)(lds + PG8_SA(b, h) + aoff + m * 2048 + k * 1024); } while (0)
#define PG8_LDB(dst, b, h) do { _Pragma("unroll") for (int n = 0; n < 2; ++n) _Pragma("unroll") for (int k = 0; k < 2; ++k) dst[n][k] = *(const LAS bf16x8*)(lds + PG8_SB(b, h) + boff + n * 2048 + k * 1024); } while (0)
#define PG8_MMA(ai, bj, At, Bt) do { __builtin_amdgcn_s_setprio(1); _Pragma("unroll") for (int m = 0; m < 4; ++m) _Pragma("unroll") for (int n = 0; n < 2; ++n) _Pragma("unroll") for (int k = 0; k < 2; ++k) \
        acc[ai][bj][m][n] = __builtin_amdgcn_mfma_f32_16x16x32_bf16(Bt[n][k], At[m][k], acc[ai][bj][m][n], 0, 0, 0); __builtin_amdgcn_s_setprio(0); } while (0)
#define PG8_WAIT_V(n) asm volatile("s_waitcnt vmcnt(" #n ")" ::: "memory")
#define PG8_WAIT_L(n) asm volatile("s_waitcnt lgkmcnt(" #n ")" ::: "memory")
#define PG8_BAR __builtin_amdgcn_s_barrier()
#define PG8_SCHED __builtin_amdgcn_sched_barrier(0)
    Unit cur, nxt; int ui = 0;
    if (!S.next(0, cur)) return;
    float carry = 0.f;
    if constexpr (Epi::CARRY) carry = E.pre(cur, tid);
    f32x4 acc[2][2][4][2];
#pragma unroll
    for (int a = 0; a < 2; ++a)
#pragma unroll
        for (int b = 0; b < 2; ++b)
#pragma unroll
            for (int m = 0; m < 4; ++m)
#pragma unroll
                for (int n = 0; n < 2; ++n) acc[a][b][m][n] = (f32x4){0.f, 0.f, 0.f, 0.f};
    bf16x8 At[4][2], B0[2][2], B1[2][2];
    const char* cA = cur.a; const char* cB = cur.b;
    S.a_ready(cur);
    if constexpr (SP2) {
        PG8_STAGE(PG8_SB(0, 0), cB, voffB); PG8_STAGE(PG8_SB(0, 1), cB + hstepB, voffB); PG8_STAGE(PG8_SA(0, 0), cA, voffA); PG8_STAGE(PG8_SA(0, 1), cA + hstepA, voffA);
        if (wr == 1) PG8_BAR;
        PG8_WAIT_V(2); PG8_BAR;
        PG8_STAGE(PG8_SB(1, 0), cB + kstep, voffB); PG8_STAGE(PG8_SA(1, 0), cA + kstep, voffA); PG8_STAGE(PG8_SB(1, 1), cB + hstepB + kstep, voffB);
        PG8_WAIT_V(6); PG8_BAR;
    } else {
        PG8_STAGE(PG8_SB(0, 0), cB, voffB); PG8_STAGE(PG8_SA(0, 0), cA, voffA); PG8_STAGE(PG8_SB(0, 1), cB + hstepB, voffB); PG8_STAGE(PG8_SA(0, 1), cA + hstepA, voffA);
        if (wr == 1) PG8_BAR;
        PG8_WAIT_V(4); PG8_BAR;
        PG8_STAGE(PG8_SB(1, 0), cB + kstep, voffB); PG8_STAGE(PG8_SA(1, 0), cA + kstep, voffA); PG8_STAGE(PG8_SB(1, 1), cB + hstepB + kstep, voffB);
        PG8_WAIT_V(6); PG8_BAR;
    }
    for (;;) {
        const bool has_next = S.next(ui + 1, nxt);
        const char* nA = has_next ? nxt.a : cA; const char* nB = has_next ? nxt.b : cB;
        asm volatile(".p2align 8" ::: "memory");
        for (int t = 0; t < nt; t += 2) {
            const bool last = (t == nt - 2);
            const char* a1 = cA + (size_t)(t + 1) * kstep;
            const char* a2 = last ? nA : cA + (size_t)(t + 2) * kstep; const char* b2 = last ? nB : cB + (size_t)(t + 2) * kstep;
            const char* a3 = a2 + kstep; const char* b3 = b2 + kstep;
            if (last && has_next) S.a_ready(nxt);
            if constexpr (SP2) {
            PG8_LDB(B0, 0, 0); PG8_LDB(B1, 0, 1); PG8_SCHED; PG8_LDA(At, 0, 0); PG8_STAGE(PG8_SA(1, 1), a1 + hstepA, voffA);
            PG8_WAIT_V(8); PG8_WAIT_L(0); PG8_BAR; PG8_MMA(0, 0, At, B0); PG8_MMA(0, 1, At, B1); PG8_BAR; PG8_SCHED;
            PG8_LDA(At, 0, 1); PG8_STAGE(PG8_SB(0, 0), b2, voffB); PG8_STAGE(PG8_SB(0, 1), b2 + hstepB, voffB); PG8_STAGE(PG8_SA(0, 0), a2, voffA);
            PG8_WAIT_V(8); PG8_WAIT_L(0); PG8_BAR; PG8_MMA(1, 0, At, B0); PG8_MMA(1, 1, At, B1); PG8_BAR; PG8_SCHED;
            PG8_LDB(B0, 1, 0); PG8_LDB(B1, 1, 1); PG8_SCHED; PG8_LDA(At, 1, 0); PG8_STAGE(PG8_SA(0, 1), a2 + hstepA, voffA);
            PG8_WAIT_V(8); PG8_WAIT_L(0); PG8_BAR; PG8_MMA(0, 0, At, B0); PG8_MMA(0, 1, At, B1); PG8_BAR; PG8_SCHED;
            PG8_LDA(At, 1, 1); PG8_STAGE(PG8_SB(1, 0), b3, voffB); PG8_STAGE(PG8_SB(1, 1), b3 + hstepB, voffB); PG8_STAGE(PG8_SA(1, 0), a3, voffA);
            PG8_WAIT_V(8); PG8_WAIT_L(0); PG8_BAR; PG8_MMA(1, 0, At, B0); PG8_MMA(1, 1, At, B1); PG8_BAR; PG8_SCHED;
            } else {
            PG8_LDB(B0, 0, 0); PG8_SCHED; PG8_LDA(At, 0, 0); PG8_STAGE(PG8_SA(1, 1), a1 + hstepA, voffA);
            PG8_WAIT_L(8); PG8_BAR; PG8_WAIT_L(0); PG8_MMA(0, 0, At, B0); PG8_BAR; PG8_SCHED;
            PG8_LDB(B1, 0, 1); PG8_STAGE(PG8_SB(0, 0), b2, voffB);
            PG8_BAR; PG8_WAIT_L(0); PG8_MMA(0, 1, At, B1); PG8_BAR;
            PG8_LDA(At, 0, 1); PG8_STAGE(PG8_SA(0, 0), a2, voffA);
            PG8_BAR; PG8_WAIT_L(0); PG8_MMA(1, 0, At, B0); PG8_BAR; PG8_SCHED;
            PG8_STAGE(PG8_SB(0, 1), b2 + hstepB, voffB);
            PG8_WAIT_V(6); PG8_BAR; PG8_MMA(1, 1, At, B1); PG8_BAR;
            PG8_LDB(B0, 1, 0); PG8_SCHED; PG8_LDA(At, 1, 0); PG8_STAGE(PG8_SA(0, 1), a2 + hstepA, voffA);
            PG8_WAIT_L(8); PG8_BAR; PG8_WAIT_L(0); PG8_MMA(0, 0, At, B0); PG8_BAR; PG8_SCHED;
            PG8_LDB(B1, 1, 1); PG8_STAGE(PG8_SB(1, 0), b3, voffB);
            PG8_BAR; PG8_WAIT_L(0); PG8_MMA(0, 1, At, B1); PG8_BAR;
            PG8_LDA(At, 1, 1); PG8_STAGE(PG8_SA(1, 0), a3, voffA);
            PG8_BAR; PG8_WAIT_L(0); PG8_MMA(1, 0, At, B0); PG8_BAR; PG8_SCHED;
            PG8_STAGE(PG8_SB(1, 1), b3 + hstepB, voffB);
            PG8_WAIT_V(6); PG8_BAR; PG8_MMA(1, 1, At, B1); PG8_BAR;
            }
        }
        if constexpr (ALIGN_EPI) { if (wr == 0) PG8_BAR; }
        { int l2 = lane_id(); asm volatile("" : "+v"(l2));
          if constexpr (Epi::CARRY) { E(acc, cur, wr, wc, l2 & 15, l2 >> 4, carry, (wid << 6) | l2); if (has_next) carry = E.pre(nxt, (wid << 6) | l2); }
          else E(acc, cur, wr, wc, l2 & 15, l2 >> 4); }
        S.done(cur);
        if (!has_next) break;
        bool zero_acc = true;
        if constexpr (Epi::KEEP) zero_acc = !E.keep(cur);
        if (zero_acc) {
#pragma unroll
        for (int a = 0; a < 2; ++a)
#pragma unroll
            for (int b = 0; b < 2; ++b)
#pragma unroll
                for (int m = 0; m < 4; ++m)
#pragma unroll
                    for (int n = 0; n < 2; ++n) acc[a][b][m][n] = (f32x4){0.f, 0.f, 0.f, 0.f};
        }
        cur = nxt; cA = nA; cB = nB; ++ui;
        if constexpr (ALIGN_EPI) { if (wr == 1) PG8_BAR; }
    }
    PG8_WAIT_V(0);
    if constexpr (!ALIGN_EPI) { if (wr == 0) PG8_BAR; }
    PG8_BAR;
#undef PG8_SA
#undef PG8_SB
#undef PG8_STAGE
#undef PG8_LDA
#undef PG8_LDB
#undef PG8_MMA
#undef PG8_WAIT_V
#undef PG8_WAIT_L
#undef PG8_BAR
#undef PG8_SCHED
}
}

#ifndef PG8_SP2
#define PG8_SP2 true
#endif
#ifndef PG8_ALIGN
#define PG8_ALIGN true
#endif
using pg8::Unit;
typedef const f32x4 (&AccRef)[2][2][4][2];
typedef f32x4 (&AccMut)[2][2][4][2];

__device__ __forceinline__ float act_one(float x, float c1, float c3, float off, bool mulx) {
    const float t = fmaf(x, fmaf(c3, x * x, c1), off);
    const float e = __builtin_amdgcn_exp2f(t * -1.4426950408889634f);
    const float sg = __builtin_amdgcn_rcpf(1.0f + e);
    return (mulx ? x : 1.0f) * sg;
}
template <bool SCALE> __device__ __forceinline__ void epi1_gate(AccRef acc, bf16* P, const float* bgate, const LAS float* rs, int pm, int t, int wr, int wc, int fr, int fq) {
    const int row0 = pm * 256 + wr * 64 + fr, cw = t * 128 + wc * 32 + 8 * fq;
    float rsv[2][4];
#pragma unroll
    for (int ai = 0; ai < 2; ++ai)
#pragma unroll
        for (int m = 0; m < 4; ++m) rsv[ai][m] = SCALE ? rs[wr * 64 + fr + ai * 128 + m * 16] : 1.0f;
    f32x4 ba[2], bb[2];
#pragma unroll
    for (int n = 0; n < 2; ++n) { ba[n] = *(const f32x4*)(bgate + cw + 4 * n) * -1.4426950408889634f; bb[n] = *(const f32x4*)(bgate + DM + cw + 4 * n) * -1.4426950408889634f; }
#pragma unroll
    for (int ai = 0; ai < 2; ++ai)
#pragma unroll
        for (int m = 0; m < 4; ++m) {
            const int row = row0 + ai * 128 + m * 16; bf16* rowp = P + (size_t)row * LDP + cw;
            float orr[8], og[8];
#pragma unroll
            for (int n = 0; n < 2; ++n)
#pragma unroll
                for (int j = 0; j < 4; ++j) { const float xa = SCALE ? acc[ai][0][m][n][j] * rsv[ai][m] : acc[ai][0][m][n][j], xb = SCALE ? acc[ai][1][m][n][j] * rsv[ai][m] : acc[ai][1][m][n][j];
                    const float da = 1.0f + __builtin_amdgcn_exp2f(fmaf(xa, -1.4426950408889634f, ba[n][j]));
                    const float db = 1.0f + __builtin_amdgcn_exp2f(fminf(fmaf(xb, -1.4426950408889634f, bb[n][j]), 64.0f));
                    og[4 * n + j] = __builtin_amdgcn_rcpf(db); orr[4 * n + j] = db * __builtin_amdgcn_rcpf(da); }
            v4u w; w.x = cvt_pk_bf16(orr[0], orr[1]); w.y = cvt_pk_bf16(orr[2], orr[3]); w.z = cvt_pk_bf16(orr[4], orr[5]); w.w = cvt_pk_bf16(orr[6], orr[7]);
            *(v4u*)(rowp + C_GA) = w;
            v4u g; g.x = cvt_pk_bf16(og[0], og[1]); g.y = cvt_pk_bf16(og[2], og[3]); g.z = cvt_pk_bf16(og[4], og[5]); g.w = cvt_pk_bf16(og[6], og[7]);
            *(v4u*)(rowp + C_GB) = g;
        }
}
template <int MODE, bool STATS, bool SCALE> __device__ __forceinline__ void epi1_body(AccRef acc, bf16* P, const float* bgate, f32x2* part, const LAS float* rs, int pm, int pn, int wr, int wc, int fr, int fq) {
    const int row0 = pm * 256 + wr * 64 + fr, col0 = pn * 256 + wc * 32 + 8 * fq;
    float rsv[2][4];
#pragma unroll
    for (int ai = 0; ai < 2; ++ai)
#pragma unroll
        for (int m = 0; m < 4; ++m) rsv[ai][m] = SCALE ? rs[wr * 64 + fr + ai * 128 + m * 16] : 1.0f;
    f32x4 bv[2][2];
    if (MODE == 3) {
#pragma unroll
        for (int bj = 0; bj < 2; ++bj)
#pragma unroll
            for (int n = 0; n < 2; ++n) bv[bj][n] = *(const f32x4*)(bgate + (col0 - C_GA) + bj * 128 + 4 * n) * -1.4426950408889634f;
    }
#pragma unroll
    for (int ai = 0; ai < 2; ++ai)
#pragma unroll
        for (int m = 0; m < 4; ++m) {
            const int row = row0 + ai * 128 + m * 16; bf16* rowp = P + (size_t)row * LDP + col0; float rs = 0.f, rq = 0.f;
#pragma unroll
            for (int bj = 0; bj < 2; ++bj) {
                float o[8];
#pragma unroll
                for (int n = 0; n < 2; ++n)
#pragma unroll
                    for (int j = 0; j < 4; ++j) { const float x = SCALE ? acc[ai][bj][m][n][j] * rsv[ai][m] : acc[ai][bj][m][n][j]; float r;
                        if (MODE == 0) { const float t = x * fmaf(-0.10294324576f, x * x, -2.3022081985f); r = x * __builtin_amdgcn_rcpf(1.0f + __builtin_amdgcn_exp2f(t)); }
                        else if (MODE == 1) { r = x * __builtin_amdgcn_rcpf(1.0f + __builtin_amdgcn_exp2f(x * -1.4426950408889634f)); }
                        else if (MODE == 2) { r = x; }
                        else { r = __builtin_amdgcn_rcpf(1.0f + __builtin_amdgcn_exp2f(fmaf(x, -1.4426950408889634f, bv[bj][n][j]))); }
                        o[4 * n + j] = r; if (STATS) { rs += r; rq += r * r; } }
                v4u w; w.x = cvt_pk_bf16(o[0], o[1]); w.y = cvt_pk_bf16(o[2], o[3]); w.z = cvt_pk_bf16(o[4], o[5]); w.w = cvt_pk_bf16(o[6], o[7]);
                *(v4u*)(rowp + bj * 128) = w;
            }
            if (STATS) { rs += __shfl_xor(rs, 16); rs += __shfl_xor(rs, 32); rq += __shfl_xor(rq, 16); rq += __shfl_xor(rq, 32);
                if (fq == 0) part[(size_t)((pn - 8) * 4 + wc) * MTOT + row] = (f32x2){rs, rq}; }
        }
}
template <bool SCALE> struct Epi1 {
    static constexpr bool PERM = true; static constexpr bool KEEP = false; static constexpr bool CARRY = SCALE;
    bf16* P; const float* bgate; f32x2* part; const float* rs; LAS float* rsl;
    __device__ __forceinline__ float pre(const Unit& u, int tid) const { return rs[u.pm * 256 + (tid & 255)]; }
    __device__ __forceinline__ void body(AccRef acc, const Unit& u, int wr, int wc, int fr, int fq) const {
        const int pn = u.pn;
        if (pn < 8) epi1_body<0, false, SCALE>(acc, P, bgate, part, rsl, u.pm, pn, wr, wc, fr, fq);
        else if (pn < 16) epi1_body<0, true, SCALE>(acc, P, bgate, part, rsl, u.pm, pn, wr, wc, fr, fq);
        else if (pn >= 40) epi1_gate<SCALE>(acc, P, bgate, rsl, u.pm, pn - 40, wr, wc, fr, fq);
        else if (pn >= 24 && pn < 32) epi1_body<2, false, SCALE>(acc, P, bgate, part, rsl, u.pm, pn, wr, wc, fr, fq);
        else epi1_body<1, false, SCALE>(acc, P, bgate, part, rsl, u.pm, pn, wr, wc, fr, fq);
    }
    __device__ __forceinline__ void operator()(AccRef acc, const Unit& u, int wr, int wc, int fr, int fq) const { body(acc, u, wr, wc, fr, fq); }
    __device__ __forceinline__ void operator()(AccRef acc, const Unit& u, int wr, int wc, int fr, int fq, float carry, int tid) const {
        if (tid < 256) rsl[tid] = carry;
        asm volatile("s_waitcnt lgkmcnt(0)" ::: "memory"); __builtin_amdgcn_s_barrier();
        body(acc, u, wr, wc, fr, fq);
    }
};
struct EpiD1 {
    static constexpr bool PERM = true; static constexpr bool KEEP = false; static constexpr bool CARRY = false;
    bf16* YT;
    __device__ __forceinline__ void operator()(AccRef acc, const Unit& u, int wr, int wc, int fr, int fq) const {
        bf16* o0 = YT + ((size_t)u.pn * 2048 + (size_t)(u.aux * 256 + wr * 64 + fr)) * 512 + u.pm * 256 + wc * 32 + 8 * fq;
#pragma unroll
        for (int ai = 0; ai < 2; ++ai)
#pragma unroll
            for (int m = 0; m < 4; ++m) { bf16* rowp = o0 + (size_t)(ai * 128 + m * 16) * 512;
#pragma unroll
                for (int bj = 0; bj < 2; ++bj) { const f32x4 v0 = acc[ai][bj][m][0] * 0.0625f, v1 = acc[ai][bj][m][1] * 0.0625f;
                    v4u w; w.x = cvt_pk_bf16(v0[0], v0[1]); w.y = cvt_pk_bf16(v0[2], v0[3]); w.z = cvt_pk_bf16(v1[0], v1[1]); w.w = cvt_pk_bf16(v1[2], v1[3]);
                    *(v4u*)(rowp + bj * 128) = w; } }
    }
};
struct EpiD2 {
    static constexpr bool PERM = true; static constexpr bool KEEP = false; static constexpr bool CARRY = false;
    bf16* P;
    __device__ __forceinline__ void operator()(AccRef acc, const Unit& u, int wr, int wc, int fr, int fq) const {
        const int rt = u.aux; int tok0, N1;
        if (rt < 64) { N1 = 8; tok0 = (rt >> 3) * 2048 + (rt & 7); } else { N1 = 16; tok0 = MPR + ((rt - 64) >> 4) * 4096 + ((rt - 64) & 15); }
        const float scale = 0.0625f;
        const size_t rstride = (size_t)N1 * LDP;
        const bf16* Pb = P + (size_t)(tok0 + N1 * (wr * 64 + fr)) * LDP + C_ZB + u.pn * 256 + wc * 32 + 8 * fq;
        v4u z[2][4][2];
#pragma unroll
        for (int ai = 0; ai < 2; ++ai)
#pragma unroll
            for (int m = 0; m < 4; ++m)
#pragma unroll
                for (int bj = 0; bj < 2; ++bj) z[ai][m][bj] = *(const v4u*)(Pb + (size_t)(ai * 128 + m * 16) * rstride + bj * 128);
        asm volatile("" ::: "memory");
#pragma unroll
        for (int ai = 0; ai < 2; ++ai)
#pragma unroll
            for (int m = 0; m < 4; ++m) { bf16* rowp = (bf16*)Pb + (size_t)(ai * 128 + m * 16) * rstride;
#pragma unroll
                for (int bj = 0; bj < 2; ++bj) { const v4u zz = z[ai][m][bj]; const f32x4 v0 = acc[ai][bj][m][0] * scale, v1 = acc[ai][bj][m][1] * scale;
                    v4u w; w.x = cvt_pk_bf16(v0[0] * bf_lo(zz.x), v0[1] * bf_hi(zz.x)); w.y = cvt_pk_bf16(v0[2] * bf_lo(zz.y), v0[3] * bf_hi(zz.y));
                    w.z = cvt_pk_bf16(v1[0] * bf_lo(zz.z), v1[1] * bf_hi(zz.z)); w.w = cvt_pk_bf16(v1[2] * bf_lo(zz.w), v1[3] * bf_hi(zz.w));
                    *(v4u*)(rowp + bj * 128) = w; } }
        asm volatile("" ::: "memory");
    }
};
struct OrderG2 {
    pg8::OrderMN o; const char* A2; const char* B2;
    __device__ __forceinline__ bool next(int i, Unit& u) const {
        if (!o.next(i >> 1, u)) return false;
        u.aux = i & 1; if (u.aux) { u.a = A2 + (size_t)u.pm * o.tA; u.b = B2 + (size_t)u.pn * o.tB; } return true; }
    __device__ __forceinline__ void a_ready(const Unit&) const {}
    __device__ __forceinline__ void done(const Unit&) const {}
};
struct Epi2G {
    static constexpr bool PERM = true; static constexpr bool KEEP = true; static constexpr bool CARRY = false;
    const bf16* P; bf16* Mb;
    __device__ __forceinline__ bool keep(const Unit& u) const { return u.aux == 0; }
    __device__ __forceinline__ void operator()(AccMut acc, const Unit& u, int wr, int wc, int fr, int fq) const {
        const int row0 = u.pm * 256 + wr * 64 + fr, col0 = u.pn * 256 + wc * 32 + 8 * fq;
        const bf16* gp = P + (size_t)row0 * LDP + (u.aux ? C_GB : C_GA) + col0;
        v4u g[2][4][2];
#pragma unroll
        for (int ai = 0; ai < 2; ++ai)
#pragma unroll
            for (int m = 0; m < 4; ++m)
#pragma unroll
                for (int bj = 0; bj < 2; ++bj) g[ai][m][bj] = *(const v4u*)(gp + (size_t)(ai * 128 + m * 16) * LDP + bj * 128);
        asm volatile("" ::: "memory");
        if (u.aux == 0) {
#pragma unroll
            for (int ai = 0; ai < 2; ++ai)
#pragma unroll
                for (int m = 0; m < 4; ++m)
#pragma unroll
                    for (int bj = 0; bj < 2; ++bj) { v4u gg = g[ai][m][bj]; asm volatile("" : "+v"(gg.x), "+v"(gg.y), "+v"(gg.z), "+v"(gg.w));
                        acc[ai][bj][m][0] *= (f32x4){bf_lo(gg.x), bf_hi(gg.x), bf_lo(gg.y), bf_hi(gg.y)}; acc[ai][bj][m][1] *= (f32x4){bf_lo(gg.z), bf_hi(gg.z), bf_lo(gg.w), bf_hi(gg.w)}; }
        } else {
#pragma unroll
            for (int ai = 0; ai < 2; ++ai)
#pragma unroll
                for (int m = 0; m < 4; ++m) { bf16* op = Mb + (size_t)(row0 + ai * 128 + m * 16) * DM + col0;
#pragma unroll
                    for (int bj = 0; bj < 2; ++bj) { v4u gg = g[ai][m][bj]; asm volatile("" : "+v"(gg.x), "+v"(gg.y), "+v"(gg.z), "+v"(gg.w)); const f32x4 a0 = acc[ai][bj][m][0], a1 = acc[ai][bj][m][1];
                        v4u w; w.x = cvt_pk_bf16(a0[0] * bf_lo(gg.x), a0[1] * bf_hi(gg.x)); w.y = cvt_pk_bf16(a0[2] * bf_lo(gg.y), a0[3] * bf_hi(gg.y));
                        w.z = cvt_pk_bf16(a1[0] * bf_lo(gg.z), a1[1] * bf_hi(gg.z)); w.w = cvt_pk_bf16(a1[2] * bf_lo(gg.w), a1[3] * bf_hi(gg.w));
                        *(v4u*)(op + bj * 128) = w; } }
            asm volatile("" ::: "memory");
        }
    }
};
struct Epi3 {
    static constexpr bool PERM = true; static constexpr bool KEEP = false; static constexpr bool CARRY = false;
    bf16* x1; float* ss;
    __device__ __forceinline__ void operator()(AccRef acc, const Unit& u, int wr, int wc, int fr, int fq) const {
        const int rt = u.pm * 256;
        const int r0 = wr * 64 + fr, col0 = u.pn * 256 + wc * 32 + 8 * fq;
        bf16* xh = x1 + (size_t)rt * DM;
        const bool want = (ss != nullptr);
        v4u xw[2][4][2];
#pragma unroll
        for (int ai = 0; ai < 2; ++ai)
#pragma unroll
            for (int m = 0; m < 4; ++m)
#pragma unroll
                for (int bj = 0; bj < 2; ++bj) xw[ai][m][bj] = *(const v4u*)(xh + (size_t)(r0 + ai * 128 + m * 16) * DM + col0 + bj * 128);
        asm volatile("" ::: "memory");
#pragma unroll
        for (int ai = 0; ai < 2; ++ai)
#pragma unroll
            for (int m = 0; m < 4; ++m) { float q = 0.f; int rr = r0 + ai * 128 + m * 16; asm volatile("" : "+v"(rr));
#pragma unroll
                for (int bj = 0; bj < 2; ++bj) { v4u w = xw[ai][m][bj]; asm volatile("" : "+v"(w.x), "+v"(w.y), "+v"(w.z), "+v"(w.w));
                    const f32x4 v0 = (f32x4){bf_lo(w.x), bf_hi(w.x), bf_lo(w.y), bf_hi(w.y)} + acc[ai][bj][m][0], v1 = (f32x4){bf_lo(w.z), bf_hi(w.z), bf_lo(w.w), bf_hi(w.w)} + acc[ai][bj][m][1];
                    q += (v0.x * v0.x + v0.y * v0.y) + (v0.z * v0.z + v0.w * v0.w) + (v1.x * v1.x + v1.y * v1.y) + (v1.z * v1.z + v1.w * v1.w);
                    v4u o; o.x = cvt_pk_bf16(v0.x, v0.y); o.y = cvt_pk_bf16(v0.z, v0.w); o.z = cvt_pk_bf16(v1.x, v1.y); o.w = cvt_pk_bf16(v1.z, v1.w);
                    *(v4u*)(xh + (size_t)rr * DM + col0 + bj * 128) = o; }
                if (want) { q += __shfl_xor(q, 16); q += __shfl_xor(q, 32); if (fq == 0) ss[(size_t)(u.pn * 4 + wc) * MTOT + rt + rr] = q; } }
        asm volatile("" ::: "memory");
    }
};

struct OrderD1 {
    int G, c; const char* D; const char* Z;
    __device__ __forceinline__ bool next(int i, Unit& u) const {
        const int L = i * G + c; if (L >= 2048) return false;
        u.pn = L >> 4; u.aux = (L >> 1) & 7; u.pm = L & 1;
        u.a = D + (size_t)u.pm * (256 * 512 * 2); u.b = Z + ((size_t)u.pn * 256 * 4096 + (size_t)u.aux * 512) * 2; return true; }
    __device__ __forceinline__ void a_ready(const Unit&) const {}
    __device__ __forceinline__ void done(const Unit&) const {}
};
struct OrderD2 {
    int G, c; const char* T; const char* YT;
    __device__ __forceinline__ bool next(int i, Unit& u) const {
        const int L = i * G + c; if (L >= 1024) return false;
        u.aux = L >> 3; u.pn = L & 7; u.pm = 0;
        u.a = T; u.b = YT + ((size_t)u.aux * 2048 + (size_t)u.pn * 256) * 512 * 2; return true; }
    __device__ __forceinline__ void a_ready(const Unit&) const {}
    __device__ __forceinline__ void done(const Unit&) const {}
};

__device__ constexpr float C16[16] = {1.0f, 0.9238795325112867f, 0.7071067811865476f, 0.3826834323650898f, 0.0f, -0.3826834323650898f, -0.7071067811865476f, -0.9238795325112867f,
                                      -1.0f, -0.9238795325112867f, -0.7071067811865476f, -0.3826834323650898f, 0.0f, 0.3826834323650898f, 0.7071067811865476f, 0.9238795325112867f};
__device__ constexpr float S16[16] = {0.0f, 0.3826834323650898f, 0.7071067811865476f, 0.9238795325112867f, 1.0f, 0.9238795325112867f, 0.7071067811865476f, 0.3826834323650898f,
                                      0.0f, -0.3826834323650898f, -0.7071067811865476f, -0.9238795325112867f, -1.0f, -0.9238795325112867f, -0.7071067811865476f, -0.3826834323650898f};
template <int N1> __device__ __forceinline__ void s1_items(const bf16* P, bf16* Z, const f32x2* TW, int row_base, int nb, int gt, int NGT) {
    constexpr int S = 256 * N1;
    const int nitems = nb * 256 * 512;
    for (int it = gt; it < nitems; it += NGT) {
        const int cg = it & 511, bn = it >> 9, n2 = bn & 255, b = bn >> 8, ch = cg * 4, g = ch >> 8, c = ch & 255;
        const bf16* src = P + (size_t)(row_base + b * S + n2) * LDP + C_XB + ch;
        float x[N1][4];
#pragma unroll
        for (int n1 = 0; n1 < N1; ++n1) { const v2u w = *(const v2u*)(src + (size_t)n1 * 256 * LDP); x[n1][0] = bf_lo(w.x); x[n1][1] = bf_hi(w.x); x[n1][2] = bf_lo(w.y); x[n1][3] = bf_hi(w.y); }
        bf16* dst = Z + (size_t)(row_base + b * S + n2) * 4096 + g * 512 + c;
#pragma unroll
        for (int k1 = 0; k1 <= N1 / 2; ++k1) {
            float re[4] = {0.f, 0.f, 0.f, 0.f}, im[4] = {0.f, 0.f, 0.f, 0.f};
#pragma unroll
            for (int n1 = 0; n1 < N1; ++n1) { const float cs = C16[((n1 * k1) % N1) * (16 / N1)], sn = S16[((n1 * k1) % N1) * (16 / N1)];
#pragma unroll
                for (int j = 0; j < 4; ++j) { re[j] = fmaf(x[n1][j], cs, re[j]); im[j] = fmaf(x[n1][j], -sn, im[j]); } }
#pragma unroll
            for (int mir = 0; mir < 2; ++mir) {
                if (mir == 1 && (k1 == 0 || k1 == N1 / 2)) continue;
                const int kk = mir ? N1 - k1 : k1;
                float imm[4];
#pragma unroll
                for (int j = 0; j < 4; ++j) imm[j] = mir ? -im[j] : im[j];
                const f32x2 tw = TW[(n2 * kk) & (S - 1)]; const float ct = tw.x, st = tw.y;
                v2u wr_, wi_;
                wr_.x = cvt_pk_bf16(re[0] * ct + imm[0] * st, re[1] * ct + imm[1] * st); wr_.y = cvt_pk_bf16(re[2] * ct + imm[2] * st, re[3] * ct + imm[3] * st);
                wi_.x = cvt_pk_bf16(imm[0] * ct - re[0] * st, imm[1] * ct - re[1] * st); wi_.y = cvt_pk_bf16(imm[2] * ct - re[2] * st, imm[3] * ct - re[3] * st);
                *(v2u*)(dst + (size_t)kk * 256 * 4096) = wr_; *(v2u*)(dst + (size_t)kk * 256 * 4096 + 256) = wi_;
            }
        }
    }
}

#define XB_TMO      128
#define XB_XCNT(j)  (256  + 64 * (j))
#define XB_XSUB(j)  (1280 + 64 * (j))
#define XB_XGEN(j)  (2304 + 64 * (j))
#define XB_TOP      3328
#define XB_TOPGEN   3392
#define XCD_BAR_WORDS 3456
#define XB_SPIN_CAP (1u << 18)
__device__ __forceinline__ unsigned xb_ld(unsigned* p)              { return __hip_atomic_load(p, __ATOMIC_RELAXED, __HIP_MEMORY_SCOPE_AGENT); }
__device__ __forceinline__ unsigned xb_add(unsigned* p, unsigned v) { return __hip_atomic_fetch_add(p, v, __ATOMIC_RELAXED, __HIP_MEMORY_SCOPE_AGENT); }
__device__ __forceinline__ unsigned xb_xcc_id() { return (unsigned)__builtin_amdgcn_s_getreg((3 << 11) | 20) & 0xFu; }
#define XB_SPIN(cond, bar) do { unsigned _sp = 0; while (cond) { __builtin_amdgcn_s_sleep(1); \
    if ((++_sp & 255u) == 0u) { if (xb_ld(&(bar)[XB_TMO])) break; if (_sp > XB_SPIN_CAP) { atomicAdd(&(bar)[XB_TMO], 1u); break; } } } } while (0)
struct XcdBarrier { unsigned* bar; unsigned x; volatile LAS unsigned* st; };
__device__ __forceinline__ XcdBarrier xcd_barrier_post(unsigned* bar, volatile LAS unsigned* st, bool leader) {
    XcdBarrier b; b.bar = bar; b.x = xb_xcc_id(); b.st = st;
    if (leader) (void)xb_add(&bar[XB_XCNT(b.x)], 1u);
    return b;
}
__device__ __forceinline__ void xcd_barrier_complete(unsigned* bar, unsigned x, unsigned& nloc, unsigned& nx) {
    const unsigned G = gridDim.x * gridDim.y * gridDim.z;
    unsigned sum, cnt, mine, sp = 0u;
    for (;;) {
        sum = 0u; cnt = 0u; mine = 0u;
#pragma unroll
        for (unsigned j = 0; j < 16; ++j) { const unsigned c = xb_ld(&bar[XB_XCNT(j)]); sum += c; cnt += (c > 0u) ? 1u : 0u; mine = (j == x) ? c : mine; }
        if (sum == G) break;
        __builtin_amdgcn_s_sleep(1);
        if ((++sp & 255u) == 0u) { if (xb_ld(&bar[XB_TMO])) break; if (sp > XB_SPIN_CAP) { atomicAdd(&bar[XB_TMO], 1u); break; } }
    }
    nloc = mine > 0u ? mine : 1u; nx = cnt > 0u ? cnt : 1u;
}
__device__ __forceinline__ void xcd_barrier(const XcdBarrier& b, bool leader) {
    asm volatile("s_waitcnt vmcnt(0)" ::: "memory");
    __syncthreads();
    if (leader) {
        unsigned* bar = b.bar;
        __builtin_amdgcn_s_waitcnt(0);
        unsigned nloc = b.st[0], nx = b.st[1];
        if (nloc == 0u) { xcd_barrier_complete(bar, b.x, nloc, nx); b.st[0] = nloc; b.st[1] = nx; }
        const unsigned old = xb_add(&bar[XB_XSUB(b.x)], 1u);
        const unsigned gen = old / nloc;
        if (old + 1u == (gen + 1u) * nloc) {
            __builtin_amdgcn_fence(__ATOMIC_RELEASE, "agent");
            asm volatile("s_waitcnt vmcnt(0)" ::: "memory");
            const unsigned og = xb_add(&bar[XB_TOP], 1u);
            const unsigned tg = og / nx;
            if (og + 1u == (tg + 1u) * nx) xb_add(&bar[XB_TOPGEN], 1u);
            else XB_SPIN(xb_ld(&bar[XB_TOPGEN]) == tg, bar);
            __builtin_amdgcn_fence(__ATOMIC_ACQUIRE, "agent");
            xb_add(&bar[XB_XGEN(b.x)], 1u);
            asm volatile("s_waitcnt vmcnt(0)" ::: "memory");
        } else {
            XB_SPIN(xb_ld(&bar[XB_XGEN(b.x)]) == gen, bar);
            __builtin_amdgcn_fence(__ATOMIC_ACQUIRE, "agent");
            asm volatile("s_waitcnt vmcnt(0)" ::: "memory");
        }
    }
    __syncthreads();
}

__device__ __forceinline__ float wave_sum(float v) {
#pragma unroll
    for (int o = 1; o < 64; o <<= 1) v += __shfl_xor(v, o);
    return v;
}
__device__ __forceinline__ void p0_transpose_item(const float* W, int K, int N, bf16* WT, LAS float* scr, int item, int lane, bool deal = false, const float* gk = nullptr) {
    const int nblk = N / 32, kb = item / nblk, nb = item % nblk, k0 = 64 * kb, n0 = 32 * nb;
    f32x4 wv[8];
#pragma unroll
    for (int i = 0; i < 8; ++i) wv[i] = *(const f32x4*)(W + (size_t)(k0 + 8 * i + (lane >> 3)) * N + n0 + 4 * (lane & 7));
#pragma unroll
    for (int i = 0; i < 8; ++i) { LAS float* d = scr + (8 * i + (lane >> 3)) * 33 + 4 * (lane & 7); d[0] = wv[i].x; d[1] = wv[i].y; d[2] = wv[i].z; d[3] = wv[i].w; }
    LDS_WAIT(); asm volatile("" ::: "memory");
    const int c = lane & 7;
    f32x4 ga = {1.f, 1.f, 1.f, 1.f}, gb = {1.f, 1.f, 1.f, 1.f};
    if (gk) { ga = *(const f32x4*)(gk + k0 + 8 * c); gb = *(const f32x4*)(gk + k0 + 8 * c + 4); }
    int nd = n0;
    if (deal && n0 >= C_GA) { const int g = n0 - C_GA, hb = (g >= DM) ? 1 : 0, gg = g - hb * DM; nd = C_GA + ((gg >> 7) << 8) + hb * 128 + (gg & 127); }
#pragma unroll
    for (int j = 0; j < 4; ++j) { const int n = (lane >> 3) + 8 * j; const LAS float* s = scr + (8 * c) * 33 + n;
        v4u o; o.x = pk2(s[0 * 33] * ga.x, s[1 * 33] * ga.y); o.y = pk2(s[2 * 33] * ga.z, s[3 * 33] * ga.w); o.z = pk2(s[4 * 33] * gb.x, s[5 * 33] * gb.y); o.w = pk2(s[6 * 33] * gb.z, s[7 * 33] * gb.w);
        *(GAS v4u*)(WT + (size_t)(nd + n) * K + k0 + 8 * c) = o; }
    LDS_WAIT(); asm volatile("" ::: "memory");
}
__device__ __forceinline__ void x_row_to_bf16(const float* xrow, bf16* orow, float* rs, int lane) {
    const GAS f32x4* xr = (const GAS f32x4*)xrow + lane;
    f32x4 v[16]; float s = 0.f;
#pragma unroll
    for (int j = 0; j < 16; ++j) { v[j] = xr[64 * j]; s += (v[j].x * v[j].x + v[j].y * v[j].y) + (v[j].z * v[j].z + v[j].w * v[j].w); }
    const float rstd = 1.0f / sqrtf(wave_sum(s) * (1.0f / DM) + EPS);
    GAS v2u* o8 = (GAS v2u*)orow + lane;
#pragma unroll
    for (int j = 0; j < 16; ++j) { v2u w; w.x = cvt_pk_bf16(v[j].x, v[j].y); w.y = cvt_pk_bf16(v[j].z, v[j].w); o8[64 * j] = w; }
    if (lane == 0) *rs = rstd;
}
__device__ __forceinline__ void rms_row_bf16_to_f32(const bf16* xrow, const f32x4 (&g8)[8][2], float* orow, int lane) {
    const GAS v4u* xr = (const GAS v4u*)xrow + lane;
    v4u w[8]; float s = 0.f;
#pragma unroll
    for (int j = 0; j < 8; ++j) w[j] = xr[64 * j];
#pragma unroll
    for (int j = 0; j < 8; ++j) { const float a0 = bf_lo(w[j].x), a1 = bf_hi(w[j].x), a2 = bf_lo(w[j].y), a3 = bf_hi(w[j].y), a4 = bf_lo(w[j].z), a5 = bf_hi(w[j].z), a6 = bf_lo(w[j].w), a7 = bf_hi(w[j].w);
        s += (a0 * a0 + a1 * a1) + (a2 * a2 + a3 * a3) + (a4 * a4 + a5 * a5) + (a6 * a6 + a7 * a7); }
    const float rstd = 1.0f / sqrtf(wave_sum(s) * (1.0f / DM) + EPS);
    GAS f32x4* o = (GAS f32x4*)orow + 2 * lane;
#pragma unroll
    for (int j = 0; j < 8; ++j) { const f32x4 ga = g8[j][0] * rstd, gb = g8[j][1] * rstd;
        o[128 * j] = (f32x4){bf_lo(w[j].x) * ga.x, bf_hi(w[j].x) * ga.y, bf_lo(w[j].y) * ga.z, bf_hi(w[j].y) * ga.w};
        o[128 * j + 1] = (f32x4){bf_lo(w[j].z) * gb.x, bf_hi(w[j].z) * gb.y, bf_lo(w[j].w) * gb.z, bf_hi(w[j].w) * gb.w}; }
}

struct Args { const float* in[13]; float* out; unsigned char* ws; int ph_lo, ph_hi, li, pad; };
typedef __attribute__((address_space(4))) const Args CArgs;
#define PHASE_BEGIN() \
    unsigned oz_ = 0u; asm volatile("" : "+s"(oz_));              \
    CArgs* AP = (CArgs*)((__attribute__((address_space(4))) const char*)__builtin_amdgcn_kernarg_segment_ptr() + oz_); \
    int t_ = (wave0 << 6) | (int)__builtin_amdgcn_mbcnt_hi(~0u, __builtin_amdgcn_mbcnt_lo(~0u, oz_)); asm volatile("" : "+v"(t_));       \
    const int tid = t_, lane = tid & 63, wave = __builtin_amdgcn_readfirstlane(tid >> 6); \
    int G = G0, vcu = vcu0, bx = bx0; asm volatile("" : "+s"(G), "+s"(vcu), "+s"(bx)); (void)bx; \
    unsigned char* ws = AP->ws; float* out = AP->out; (void)lane; (void)wave; (void)out; \
    const int gw = vcu * NWAVES + wave, NGW = G * NWAVES, gt = vcu * (NWAVES * 64) + tid, NGT = G * NWAVES * 64; (void)gw; (void)NGW; (void)gt; (void)NGT

__global__ void __launch_bounds__(NWAVES * 64, 2) trunk_fwd(Args args) {
    extern __shared__ __attribute__((aligned(16))) unsigned char lds_raw[];
    LAS unsigned char* lds = (LAS unsigned char*)lds_raw;
    const int G0 = gridDim.x, bx0 = blockIdx.x; const int vcu0 = (G0 % 8 == 0) ? (bx0 % 8) * (G0 / 8) + bx0 / 8 : bx0;
    const int wave0 = __builtin_amdgcn_readfirstlane(threadIdx.x >> 6);
    for (int u = threadIdx.x; u < (LDS_BYTES - LDSCTL_OFF) / 4; u += NWAVES * 64) ((LAS unsigned*)(lds + LDSCTL_OFF))[u] = 0u;
    __syncthreads();
#if !MK_PER_PHASE
    (void)xcd_barrier_post((unsigned*)(args.ws + WS_CTL) + CW_BAR, (volatile LAS unsigned*)(lds + MISC_OFF) + 8, threadIdx.x == 0);
#define GRID_BAR() do { unsigned ozb_ = 0u; asm volatile("" : "+s"(ozb_)); \
        CArgs* AB_ = (CArgs*)((__attribute__((address_space(4))) const char*)__builtin_amdgcn_kernarg_segment_ptr() + ozb_); \
        XcdBarrier b_; b_.bar = (unsigned*)(AB_->ws + WS_CTL) + CW_BAR; b_.x = xb_xcc_id(); b_.st = (volatile LAS unsigned*)(lds + MISC_OFF) + 8; xcd_barrier(b_, wave0 == 0 && lane_id() == 0); } while (0)
#else
#define GRID_BAR() do { } while (0)
#endif
    const int lo = args.ph_lo, hi = args.ph_hi;
#define IN(k) (lo <= (k) && (k) < hi)
#define BOTH(k) (IN(k) && IN((k) + 1))

    if (IN(0)) {
        PHASE_BEGIN();
            bf16* DC = (bf16*)(ws + WS_DC); bf16* TT = (bf16*)(ws + WS_T);
            for (int e = gt; e < 512 * 512 / 8; e += NGT) { const int r = e >> 6, q0 = (e & 63) * 8; const int po = r >> 8, m = r & 255, pi = q0 >> 8, c0 = q0 & 255; float v[8];
#pragma unroll
                for (int j = 0; j < 8; ++j) { const float ph = (float)((m * (c0 + j)) & 255) * (1.0f / 128.0f); v[j] = (po == pi) ? cospif(ph) : ((po == 0) ? sinpif(ph) : -sinpif(ph)); }
                v4u w; w.x = pk2(v[0], v[1]); w.y = pk2(v[2], v[3]); w.z = pk2(v[4], v[5]); w.w = pk2(v[6], v[7]); *(GAS v4u*)(DC + (size_t)e * 8) = w; }
            for (int e = gt; e < 256 * 512 / 8; e += NGT) { const int k2 = e >> 6, q0 = (e & 63) * 8; const int pi = q0 >> 8, n0 = q0 & 255; float v[8];
#pragma unroll
                for (int j = 0; j < 8; ++j) { const float ph = (float)((k2 * (n0 + j)) & 255) * (1.0f / 128.0f); v[j] = pi ? sinpif(ph) : cospif(ph); }
                v4u w; w.x = pk2(v[0], v[1]); w.y = pk2(v[2], v[3]); w.z = pk2(v[4], v[5]); w.w = pk2(v[6], v[7]); *(GAS v4u*)(TT + (size_t)e * 8) = w; }

        { f32x2* TW = (f32x2*)(ws + WS_TW);
          for (int e = gt; e < 2048 + 4096; e += NGT) { const bool big = e >= 2048; const int j = big ? e - 2048 : e; const float ph = (float)j * (big ? (2.0f / 4096.0f) : (2.0f / 2048.0f)), sc = big ? 0.25f : 0.35355339059327373f;
              TW[e] = (f32x2){cospif(ph) * sc, sinpif(ph) * sc}; } }
    }

    for (int l = 0; l < 2; ++l) {
        const int pb = 7 * l;

        if (IN(pb + 0)) {
            PHASE_BEGIN();
            const float* norm_g = AP->in[2] + (size_t)l * DM;
            const float* w_in = AP->in[3] + (size_t)l * DM * DIN;
            const float* w_a = AP->in[8] + (size_t)l * DA * DM;
            const float* w_b = AP->in[9] + (size_t)l * DB * DM;
            const float* w_out = AP->in[11] + (size_t)l * DM * DM;
            bf16* W1T = (bf16*)(ws + WS_W1T); bf16* WAT = (bf16*)(ws + WS_WAT); bf16* WBT = (bf16*)(ws + WS_WBT); bf16* WOT = (bf16*)(ws + WS_WOT);
            LAS float* scr = (LAS float*)(lds + RING_OFF + wave * 16384);
            constexpr int I_1 = (DM / 64) * (DIN / 32), I_A = (DA / 64) * (DM / 32), I_O = (DM / 64) * (DM / 32);
            constexpr int NITEMS = I_1 + 2 * I_A + I_O;
            for (int it = gw; it < NITEMS; it += NGW) {
                int r = it;
                if (r < I_1) { p0_transpose_item(w_in, DM, DIN, W1T, scr, r, lane, true, norm_g); continue; } r -= I_1;
                if (r < I_A) { p0_transpose_item(w_a, DA, DM, WAT, scr, r, lane); continue; } r -= I_A;
                if (r < I_A) { p0_transpose_item(w_b, DB, DM, WBT, scr, r, lane); continue; } r -= I_A;
                p0_transpose_item(w_out, DM, DM, WOT, scr, r, lane);
            }
            if (l == 0) {
                const float* x_prompt = AP->in[0]; const float* x_sample = AP->in[1];
                bf16* X0 = (bf16*)(ws + WS_X1); float* RS0 = (float*)(ws + WS_RSTD);
                for (int m = gw; m < MTOT; m += NGW) {
                    const float* xrow = (m < MPR) ? x_prompt + (size_t)m * DM : x_sample + (size_t)(m - MPR) * DM;
                    x_row_to_bf16(xrow, X0 + (size_t)m * DM, RS0 + m, lane);
                }
            } else {
                float* RS = (float*)(ws + WS_RSTD); const float* SS = (const float*)(ws + WS_PART);
                for (int m = gt; m < MTOT; m += NGT) { float s = 0.f;
#pragma unroll 16
                    for (int j = 0; j < 64; ++j) s += SS[(size_t)j * MTOT + m];
                    RS[m] = 1.0f / sqrtf(s * (1.0f / DM) + EPS); }
            }
            VM_WAIT(); __syncthreads();
            if (BOTH(pb + 0)) GRID_BAR();
        }

        if (IN(pb + 1)) {
            PHASE_BEGIN();
            pg8::OrderMN S; S.init(MTOT / 256, DIN / 256, G, bx, ws + WS_X1, (size_t)256 * DM * 2, ws + WS_W1T, (size_t)256 * DM * 2);
            Epi1<true> E{(bf16*)(ws + WS_P), AP->in[10] + (size_t)l * 2 * DM, (f32x2*)(ws + WS_PART), (const float*)(ws + WS_RSTD), (LAS float*)(lds + RS_OFF)};
            pg8::gemm_phase<Epi1<true>, pg8::OrderMN, PG8_ALIGN, PG8_SP2>(wave0, lds + RING_OFF, DM, DM, DM, S, E);
            if (BOTH(pb + 1)) GRID_BAR();
        }

        if (IN(pb + 2)) {
            PHASE_BEGIN();
            const float* ln_g = AP->in[4] + (size_t)l * DA;
            const float* ln_b = AP->in[5] + (size_t)l * DA;
            const float* w_sp = AP->in[6] + (size_t)l * 16 * 128 * 128;
            const float* b_sp = AP->in[7] + (size_t)l * 16 * 128;
            bf16* P = (bf16*)(ws + WS_P); const f32x2* PART = (const f32x2*)(ws + WS_PART);
            LAS unsigned char* tile = lds + RING_OFF;
            LAS float* red = (LAS float*)(lds + RING_OFF + 65536);
            LAS float* st = (LAS float*)(lds + STAT_OFF);
            const int fr = lane & 15, g4 = lane >> 4, wp = wave >> 1, wcx = wave & 1;
            for (int chunk = vcu; chunk < 256; chunk += G) {
                const int r0 = chunk * 128;
                { const int row = tid & 127, grp = tid >> 7; float s = 0.f, q = 0.f;
#pragma unroll
                  for (int k = 0; k < 8; ++k) { const f32x2 p = PART[(size_t)(grp * 8 + k) * MTOT + r0 + row]; s += p.x; q += p.y; }
                  red[(grp * 128 + row) * 2] = s; red[(grp * 128 + row) * 2 + 1] = q; }
                __syncthreads();
                if (tid < 128) { float s = 0.f, q = 0.f;
#pragma unroll
                    for (int k = 0; k < 4; ++k) { s += red[(k * 128 + tid) * 2]; q += red[(k * 128 + tid) * 2 + 1]; }
                    const float mu = s * (1.0f / DA); const float var = q * (1.0f / DA) - mu * mu; st[tid] = mu; st[128 + tid] = 1.0f / sqrtf(var + EPS); }
                const int sq = tid >> 2, spart = tid & 3;
                const bf16* gsrc = P + (size_t)(r0 + sq) * LDP + C_GV + spart * 32;
                v4u gr[4];
#pragma unroll
                for (int j = 0; j < 4; ++j) gr[j] = *(const v4u*)(gsrc + 8 * j);
                for (int head = 0; head < 16; ++head) {
                    const int cc0 = head * 128;
                    int th_ = tid; asm volatile("" : "+v"(th_));
                    const int fr = th_ & 15, g4 = (th_ >> 4) & 3, sq = th_ >> 2, spart = th_ & 3;
                    const bf16* gsrc = P + (size_t)(r0 + sq) * LDP + C_GV + spart * 32;
                    __syncthreads();
#pragma unroll
                    for (int j = 0; j < 4; ++j) *(LAS v4u*)(tile + sq * 288 + spart * 64 + 16 * j) = gr[j];
                    __syncthreads();
                    if (head + 1 < 16) {
#pragma unroll
                        for (int j = 0; j < 4; ++j) gr[j] = *(const v4u*)(gsrc + (cc0 + 128) + 8 * j);
                    }
                    v2u uq[4][2], zq[4][2];
#pragma unroll
                    for (int ci = 0; ci < 4; ++ci) { const int c = 64 * wcx + 16 * ci + 4 * g4;
#pragma unroll
                        for (int pj = 0; pj < 2; ++pj) { const bf16* up = P + (size_t)(r0 + 32 * wp + 16 * pj + fr) * LDP + cc0 + c; uq[ci][pj] = *(const v2u*)(up + C_U); zq[ci][pj] = *(const v2u*)(up + C_ZA); } }
                    bf16x8 wf[2][4]; float av[2], w1v[2], bsv[2];
                    const float* wsrc = w_sp + (size_t)head * 128 * 128;
#pragma unroll
                    for (int pj = 0; pj < 2; ++pj) { const int p = 32 * wp + 16 * pj + fr; float ap = 0.f, w1 = 0.f;
#pragma unroll
                        for (int ks = 0; ks < 4; ++ks) { const int q0 = 32 * ks + 8 * g4;
                            const f32x4 wa = *(const f32x4*)(wsrc + p * 128 + q0), wb = *(const f32x4*)(wsrc + p * 128 + q0 + 4);
                            const f32x4 ra = *(const LAS f32x4*)(st + 128 + q0), rb = *(const LAS f32x4*)(st + 128 + q0 + 4);
                            const f32x4 ma = *(const LAS f32x4*)(st + q0), mb = *(const LAS f32x4*)(st + q0 + 4);
                            const f32x4 sa = wa * ra, sb = wb * rb;
                            ap += (sa.x * ma.x + sa.y * ma.y) + (sa.z * ma.z + sa.w * ma.w) + (sb.x * mb.x + sb.y * mb.y) + (sb.z * mb.z + sb.w * mb.w);
                            w1 += (wa.x + wa.y) + (wa.z + wa.w) + (wb.x + wb.y) + (wb.z + wb.w);
                            v4u pk; pk.x = cvt_pk_bf16(sa.x, sa.y); pk.y = cvt_pk_bf16(sa.z, sa.w); pk.z = cvt_pk_bf16(sb.x, sb.y); pk.w = cvt_pk_bf16(sb.z, sb.w);
                            wf[pj][ks] = __builtin_bit_cast(bf16x8, pk); }
                        ap += __shfl_xor(ap, 16); ap += __shfl_xor(ap, 32); w1 += __shfl_xor(w1, 16); w1 += __shfl_xor(w1, 32);
                        av[pj] = ap; w1v[pj] = w1; bsv[pj] = b_sp[head * 128 + p]; }
                    f32x4 acc[4][2];
#pragma unroll
                    for (int ci = 0; ci < 4; ++ci)
#pragma unroll
                        for (int pj = 0; pj < 2; ++pj) acc[ci][pj] = (f32x4){0.f, 0.f, 0.f, 0.f};
                    const int trq = fr >> 2, trp = fr & 3;
#pragma unroll
                    for (int ci = 0; ci < 4; ++ci)
#pragma unroll
                        for (int ks = 0; ks < 4; ++ks) {
                            typedef short v4s __attribute__((ext_vector_type(4)));
                            const LAS unsigned char* ta = tile + (32 * ks + 8 * g4 + trq) * 288 + (64 * wcx + 16 * ci) * 2 + 8 * trp;
                            const v4s t0 = __builtin_amdgcn_ds_read_tr16_b64_v4i16((LAS v4s*)ta);
                            const v4s t1 = __builtin_amdgcn_ds_read_tr16_b64_v4i16((LAS v4s*)(ta + 4 * 288));
                            const bf16x8 gf = {t0[0], t0[1], t0[2], t0[3], t1[0], t1[1], t1[2], t1[3]};
#pragma unroll
                            for (int pj = 0; pj < 2; ++pj) acc[ci][pj] = __builtin_amdgcn_mfma_f32_16x16x32_bf16(gf, wf[pj][ks], acc[ci][pj], 0, 0, 0);
                        }
#pragma unroll
                    for (int ci = 0; ci < 4; ++ci) { const int c = 64 * wcx + 16 * ci + 4 * g4;
                        const f32x4 gam = *(const f32x4*)(ln_g + cc0 + c), bet = *(const f32x4*)(ln_b + cc0 + c);
#pragma unroll
                        for (int pj = 0; pj < 2; ++pj) { const int p = 32 * wp + 16 * pj + fr; bf16* up = P + (size_t)(r0 + p) * LDP + cc0 + c;
                            const v2u u4 = uq[ci][pj], z4 = zq[ci][pj];
                            const f32x4 mx = gam * (acc[ci][pj] - av[pj]) + bet * w1v[pj] + bsv[pj];
                            v2u o; o.x = cvt_pk_bf16(bf_lo(u4.x) * mx.x * bf_lo(z4.x), bf_hi(u4.x) * mx.y * bf_hi(z4.x)); o.y = cvt_pk_bf16(bf_lo(u4.y) * mx.z * bf_lo(z4.y), bf_hi(u4.y) * mx.w * bf_hi(z4.y));
                            *(v2u*)(up + C_U) = o; } }
                }
                __syncthreads();
            }
            { int gt1 = gt; asm volatile("" : "+v"(gt1));
              s1_items<8>(P, (bf16*)(ws + WS_Z), (const f32x2*)(ws + WS_TW), 0, 8, gt1, NGT);
              int gt2 = gt; asm volatile("" : "+v"(gt2));
              s1_items<16>(P, (bf16*)(ws + WS_Z), (const f32x2*)(ws + WS_TW) + 2048, MPR, 4, gt2, NGT); }
            VM_WAIT(); __syncthreads();
            if (BOTH(pb + 2)) GRID_BAR();
        }

        if (IN(pb + 3)) {
            PHASE_BEGIN();
            OrderD1 S{G, vcu, (const char*)(ws + WS_DC), (const char*)(ws + WS_Z)};
            EpiD1 E{(bf16*)(ws + WS_H)};
            pg8::gemm_phase<EpiD1, OrderD1, PG8_ALIGN, PG8_SP2>(wave0, lds + RING_OFF, 512, 4096, 512, S, E);
            if (BOTH(pb + 3)) GRID_BAR();
        }

        if (IN(pb + 4)) {
            PHASE_BEGIN();
            OrderD2 S{G, vcu, (const char*)(ws + WS_T), (const char*)(ws + WS_H)};
            EpiD2 E{(bf16*)(ws + WS_P)};
            pg8::gemm_phase<EpiD2, OrderD2, PG8_ALIGN, PG8_SP2>(wave0, lds + RING_OFF, 512, 512, 512, S, E);
            if (BOTH(pb + 4)) GRID_BAR();
        }

        if (IN(pb + 5)) {
            PHASE_BEGIN();
            OrderG2 S; S.o.init(MTOT / 256, DM / 256, G, bx, ws + WS_P + (size_t)C_U * 2, (size_t)256 * LDP * 2, ws + WS_WAT, (size_t)256 * DA * 2);
            S.A2 = (const char*)(ws + WS_P + (size_t)C_ZB * 2); S.B2 = (const char*)(ws + WS_WBT);
            Epi2G E{(const bf16*)(ws + WS_P), (bf16*)(ws + WS_H)};
            pg8::gemm_phase<Epi2G, OrderG2, PG8_ALIGN, PG8_SP2>(wave0, lds + RING_OFF, LDP, DA, DA, S, E);
            if (BOTH(pb + 5)) GRID_BAR();
        }

        if (IN(pb + 6)) {
            PHASE_BEGIN();
            pg8::OrderMN S; S.init(MTOT / 256, DM / 256, G, bx, ws + WS_H, (size_t)256 * DM * 2, ws + WS_WOT, (size_t)256 * DM * 2);
            Epi3 E{(bf16*)(ws + WS_X1), (l == 0) ? (float*)(ws + WS_PART) : (float*)nullptr};
            pg8::gemm_phase<Epi3, pg8::OrderMN, PG8_ALIGN, PG8_SP2>(wave0, lds + RING_OFF, DM, DM, DM, S, E);
            if (BOTH(pb + 6)) GRID_BAR();
        }
    }

    if (IN(14)) {
        PHASE_BEGIN();
        const float* final_g = AP->in[12];
        const bf16* X2 = (const bf16*)(ws + WS_X1);
        f32x4 g8[8][2];
#pragma unroll
        for (int j = 0; j < 8; ++j) { g8[j][0] = ((const GAS f32x4*)final_g)[2 * (lane + 64 * j)]; g8[j][1] = ((const GAS f32x4*)final_g)[2 * (lane + 64 * j) + 1]; }
        for (int m = gw; m < MTOT; m += NGW) rms_row_bf16_to_f32(X2 + (size_t)m * DM, g8, out + (size_t)m * DM, lane);
    }
#undef IN
#undef BOTH
}

extern "C" void kernel_launch(void* const* d_in, const int* in_sizes, int n_in, void* d_out, int out_size, void* d_ws, size_t ws_size, hipStream_t stream) {
    static int grid = 0;
    if (grid == 0) {
        if (n_in != 13 || out_size != MTOT * DM || ws_size < WS_END) { fprintf(stderr, "kernel_launch: unexpected shapes (n_in %d out %d ws %zu); nothing launched\n", n_in, out_size, ws_size); grid = -1; return; }
        int dev = 0, cus = 0, per_cu = 0;
        if (hipGetDevice(&dev) != hipSuccess || hipDeviceGetAttribute(&cus, hipDeviceAttributeMultiprocessorCount, dev) != hipSuccess) { grid = -1; return; }
        if (hipFuncSetAttribute((const void*)trunk_fwd, hipFuncAttributeMaxDynamicSharedMemorySize, LDS_BYTES) != hipSuccess) { fprintf(stderr, "kernel_launch: hipFuncSetAttribute failed\n"); grid = -1; return; }
        if (hipOccupancyMaxActiveBlocksPerMultiprocessor(&per_cu, (const void*)trunk_fwd, NWAVES * 64, LDS_BYTES) != hipSuccess || per_cu < 1)
            fprintf(stderr, "kernel_launch: note: occupancy query reports %d workgroups per CU\n", per_cu);
        (void)hipGetLastError();
        grid = cus;
    }
    if (grid < 0) return;
    if (hipMemsetAsync((char*)d_ws + WS_CTL, 0, CTL_ZERO_BYTES, stream) != hipSuccess) return;
    Args a{};
    for (int i = 0; i < 13; ++i) a.in[i] = (const float*)d_in[i];
    a.out = (float*)d_out; a.ws = (unsigned char*)d_ws;
#if MK_PER_PHASE
    for (int p = 0; p < N_PHASES; ++p) { a.ph_lo = p; a.ph_hi = p + 1; a.li = p;
        hipLaunchKernelGGL(trunk_fwd, dim3(grid), dim3(NWAVES * 64), LDS_BYTES, stream, a); }
#else
    a.ph_lo = 0; a.ph_hi = N_PHASES; a.li = 0;
    hipLaunchKernelGGL(trunk_fwd, dim3(grid), dim3(NWAVES * 64), LDS_BYTES, stream, a);
#endif
}
```

```cpp
#include <hip/hip_runtime.h>
#include <cstdio>
#include <cstdint>

#ifndef MK_PER_PHASE
#define MK_PER_PHASE 0
#endif

#define GAS __attribute__((address_space(1)))
#define LAS __attribute__((address_space(3)))
typedef unsigned short bf16;
typedef unsigned v4u __attribute__((ext_vector_type(4)));
typedef unsigned v2u __attribute__((ext_vector_type(2)));
typedef float f32x4 __attribute__((ext_vector_type(4)));
typedef float f32x2 __attribute__((ext_vector_type(2)));
typedef short bf16x8 __attribute__((ext_vector_type(8)));
typedef GAS unsigned gu32;

constexpr int DM = 4096, DIN = 18432, DA = 2048, DB = 2048;
constexpr int MPR = 16384;
constexpr int MTOT = 32768;
constexpr int LDP = DIN;
constexpr int C_U = 0, C_GV = 2048, C_ZA = 4096, C_XB = 6144, C_ZB = 8192, C_GA = 10240, C_GB = 14336;
constexpr float EPS = 1e-6f;
constexpr int NWAVES = 8;
constexpr int N_PHASES = 15;

constexpr size_t MiB = 1u << 20;
constexpr size_t WS_CTL = 0, CTL_ZERO_BYTES = 32768;
constexpr size_t WS_W1T = 1 * MiB;
constexpr size_t WS_WAT = 145 * MiB;
constexpr size_t WS_WBT = 161 * MiB;
constexpr size_t WS_WOT = 177 * MiB;
constexpr size_t WS_DC = 210 * MiB;
constexpr size_t WS_TW = 212 * MiB;
constexpr size_t WS_T = 211 * MiB;
constexpr size_t WS_RSTD = 213 * MiB;
constexpr size_t WS_PART = 291 * MiB;
constexpr size_t WS_H = 300 * MiB;
constexpr size_t WS_P = 556 * MiB;
constexpr size_t WS_Z = 1708 * MiB;
constexpr size_t WS_X1 = 1964 * MiB;
constexpr size_t WS_END = 2220 * MiB;
constexpr int CW_BAR = 4096;

constexpr int RING_OFF = 0, RING_BYTES = 131072;
constexpr int LDSCTL_OFF = RING_BYTES, MISC_OFF = LDSCTL_OFF + 320;
constexpr int STAT_OFF = RING_BYTES + 1024;
constexpr int RS_OFF = RING_BYTES + 4096;
constexpr int LDS_BYTES = 147456;

#define RLX_AGENT __ATOMIC_RELAXED, __HIP_MEMORY_SCOPE_AGENT
#define LDS_WAIT() asm volatile("s_waitcnt lgkmcnt(0)" ::: "memory")
#define VM_WAIT() asm volatile("s_waitcnt vmcnt(0)" ::: "memory")

typedef __bf16 bf16x2_t __attribute__((ext_vector_type(2)));
__device__ __forceinline__ unsigned cvt_pk_bf16(float lo, float hi) { const f32x2 v = {lo, hi}; const bf16x2_t b = __builtin_convertvector(v, bf16x2_t); return __builtin_bit_cast(unsigned, b); }
__device__ __forceinline__ int lane_id() { return (int)__builtin_amdgcn_mbcnt_hi(~0u, __builtin_amdgcn_mbcnt_lo(~0u, 0u)); }
__device__ __forceinline__ float bf_lo(unsigned w) { return __builtin_bit_cast(float, w << 16); }
__device__ __forceinline__ float bf_hi(unsigned w) { return __builtin_bit_cast(float, w & 0xffff0000u); }
__device__ __forceinline__ float bf2f(bf16 b) { return __builtin_bit_cast(float, ((unsigned)b) << 16); }
__device__ __forceinline__ unsigned f2bf(float f) { unsigned u = __builtin_bit_cast(unsigned, f); return (u + 0x7fffu + ((u >> 16) & 1u)) >> 16; }
__device__ __forceinline__ unsigned pk2(float lo, float hi) { return f2bf(lo) | (f2bf(hi) << 16); }

namespace pg8 {
constexpr int BM = 256, BK = 64, HALF = 128, HTB = HALF * BK * 2, STAGE_BYTES = 8 * HTB, NXCD = 8, WGM = 8;
__host__ __device__ __forceinline__ int lds_byte(int r, int c) { const int st = (r >> 4) * 2 + (c >> 5), rr = r & 15, cc = c & 31, ob = rr * 64 + cc * 2; return st * 1024 + (ob ^ (((ob >> 9) & 1) << 5)); }
__host__ __device__ __forceinline__ void stage_rc(int b, int& R, int& C) { const int st = b / 1024, sb = b % 1024, swz = sb ^ (((sb >> 9) & 1) << 5); R = (st >> 1) * 16 + swz / 64; C = (st & 1) * 32 + (swz % 64) / 2; }
__host__ __device__ __forceinline__ int perm32(int rho) { const int n = rho >> 4, i = rho & 15; return 8 * (i >> 2) + 4 * n + (i & 3); }

struct Unit { const char* a; const char* b; int pm, pn, aux; };

struct OrderMN {
    int nM, nN, nwg, G, c; const char* A; const char* B; size_t tA, tB;
    __device__ __forceinline__ void init(int nM_, int nN_, int G_, int c_, const void* A_, size_t tA_, const void* B_, size_t tB_) { nM = nM_; nN = nN_; nwg = nM * nN; G = G_; c = c_; A = (const char*)A_; B = (const char*)B_; tA = tA_; tB = tB_; }
    __device__ __forceinline__ bool next(int i, Unit& u) const {
        const long L = (long)i * G + c; if (L >= nwg) return false;
        int wgid = (int)L; { const int q = nwg / NXCD, r = nwg % NXCD, xcd = wgid % NXCD, off = wgid / NXCD; wgid = (xcd < r ? xcd * (q + 1) : r * (q + 1) + (xcd - r) * q) + off; }
        const int nig = WGM * nN, gid = wgid / nig, fm = gid * WGM, gsz = (nM - fm) < WGM ? (nM - fm) : WGM;
        u.pm = fm + ((wgid % nig) % gsz); u.pn = (wgid % nig) / gsz; u.aux = 0;
        u.a = A + (size_t)u.pm * tA; u.b = B + (size_t)u.pn * tB; return true;
    }
    __device__ __forceinline__ void a_ready(const Unit&) const {}
    __device__ __forceinline__ void done(const Unit&) const {}
};

template <class Epi, class Sched, bool ALIGN_EPI, bool SP2>
__device__ __forceinline__ void gemm_phase(const int ws_, LAS unsigned char* lds, const int lda, const int ldb, const int K, const Sched& S, const Epi& E) {
    int tid_ = (ws_ << 6) | lane_id(); asm volatile("" : "+v"(tid_));
    const int tid = tid_, wid = __builtin_amdgcn_readfirstlane(tid >> 6), lane = tid & 63, wr = wid >> 2, wc = wid & 3, fr = lane & 15, fq = lane >> 4;
    const int nt = K / BK;
    unsigned voffA[2], voffB[2];
#pragma unroll
    for (int i = 0; i < 2; ++i) { int R, C; stage_rc(tid * 16 + i * 8192, R, C); const int Rb = Epi::PERM ? ((R & ~31) + perm32(R & 31)) : R;
        voffA[i] = (unsigned)(R * lda + C) * 2u; voffB[i] = (unsigned)(Rb * ldb + C) * 2u; }
    const size_t kstep = (size_t)(BK * 2);
    const size_t hstepA = (size_t)HALF * lda * 2, hstepB = (size_t)HALF * ldb * 2;
    const unsigned ldsw = (unsigned)wid * 1024u;
    const int aoff = lds_byte(wr * 64 + fr, fq * 8), boff = lds_byte(wc * 32 + fr, fq * 8);
#define PG8_SA(b, h) (((b) * 2 + (h)) * HTB)
#define PG8_SB(b, h) ((4 + (b) * 2 + (h)) * HTB)
#define PG8_STAGE(bufoff, gbase, voff) do { _Pragma("unroll") for (int _i = 0; _i < 2; ++_i) \
        __builtin_amdgcn_global_load_lds((const unsigned*)((const char*)(gbase) + (voff)[_i]), (LAS unsigned*)(lds + (bufoff) + ldsw + _i * 8192), 16, 0, 0); } while (0)
#define PG8_LDA(dst, b, h) do { _Pragma("unroll") for (int m = 0; m < 4; ++m) _Pragma("unroll") for (int k = 0; k < 2; ++k) dst[m][k] = *(const LAS bf16x8*)(lds + PG8_SA(b, h) + aoff + m * 2048 + k * 1024); } while (0)
#define PG8_LDB(dst, b, h) do { _Pragma("unroll") for (int n = 0; n < 2; ++n) _Pragma("unroll") for (int k = 0; k < 2; ++k) dst[n][k] = *(const LAS bf16x8*)(lds + PG8_SB(b, h) + boff + n * 2048 + k * 1024); } while (0)
#define PG8_MMA(ai, bj, At, Bt) do { __builtin_amdgcn_s_setprio(1); _Pragma("unroll") for (int m = 0; m < 4; ++m) _Pragma("unroll") for (int n = 0; n < 2; ++n) _Pragma("unroll") for (int k = 0; k < 2; ++k) \
        acc[ai][bj][m][n] = __builtin_amdgcn_mfma_f32_16x16x32_bf16(Bt[n][k], At[m][k], acc[ai][bj][m][n], 0, 0, 0); __builtin_amdgcn_s_setprio(0); } while (0)
#define PG8_WAIT_V(n) asm volatile("s_waitcnt vmcnt(" #n ")" ::: "memory")
#define PG8_WAIT_L(n) asm volatile("s_waitcnt lgkmcnt(" #n ")" ::: "memory")
#define PG8_BAR __builtin_amdgcn_s_barrier()
#define PG8_SCHED __builtin_amdgcn_sched_barrier(0)
    Unit cur, nxt; int ui = 0;
    if (!S.next(0, cur)) return;
    float carry = 0.f;
    if constexpr (Epi::CARRY) carry = E.pre(cur, tid);
    f32x4 acc[2][2][4][2];
#pragma unroll
    for (int a = 0; a < 2; ++a)
#pragma unroll
        for (int b = 0; b < 2; ++b)
#pragma unroll
            for (int m = 0; m < 4; ++m)
#pragma unroll
                for (int n = 0; n < 2; ++n) acc[a][b][m][n] = (f32x4){0.f, 0.f, 0.f, 0.f};
    bf16x8 At[4][2], B0[2][2], B1[2][2];
    const char* cA = cur.a; const char* cB = cur.b;
    S.a_ready(cur);
    if constexpr (SP2) {
        PG8_STAGE(PG8_SB(0, 0), cB, voffB); PG8_STAGE(PG8_SB(0, 1), cB + hstepB, voffB); PG8_STAGE(PG8_SA(0, 0), cA, voffA); PG8_STAGE(PG8_SA(0, 1), cA + hstepA, voffA);
        if (wr == 1) PG8_BAR;
        PG8_WAIT_V(2); PG8_BAR;
        PG8_STAGE(PG8_SB(1, 0), cB + kstep, voffB); PG8_STAGE(PG8_SA(1, 0), cA + kstep, voffA); PG8_STAGE(PG8_SB(1, 1), cB + hstepB + kstep, voffB);
        PG8_WAIT_V(6); PG8_BAR;
    } else {
        PG8_STAGE(PG8_SB(0, 0), cB, voffB); PG8_STAGE(PG8_SA(0, 0), cA, voffA); PG8_STAGE(PG8_SB(0, 1), cB + hstepB, voffB); PG8_STAGE(PG8_SA(0, 1), cA + hstepA, voffA);
        if (wr == 1) PG8_BAR;
        PG8_WAIT_V(4); PG8_BAR;
        PG8_STAGE(PG8_SB(1, 0), cB + kstep, voffB); PG8_STAGE(PG8_SA(1, 0), cA + kstep, voffA); PG8_STAGE(PG8_SB(1, 1), cB + hstepB + kstep, voffB);
        PG8_WAIT_V(6); PG8_BAR;
    }
    for (;;) {
        const bool has_next = S.next(ui + 1, nxt);
        const char* nA = has_next ? nxt.a : cA; const char* nB = has_next ? nxt.b : cB;
        asm volatile(".p2align 8" ::: "memory");
        for (int t = 0; t < nt; t += 2) {
            const bool last = (t == nt - 2);
            const char* a1 = cA + (size_t)(t + 1) * kstep;
            const char* a2 = last ? nA : cA + (size_t)(t + 2) * kstep; const char* b2 = last ? nB : cB + (size_t)(t + 2) * kstep;
            const char* a3 = a2 + kstep; const char* b3 = b2 + kstep;
            if (last && has_next) S.a_ready(nxt);
            if constexpr (SP2) {
            PG8_LDB(B0, 0, 0); PG8_LDB(B1, 0, 1); PG8_SCHED; PG8_LDA(At, 0, 0); PG8_STAGE(PG8_SA(1, 1), a1 + hstepA, voffA);
            PG8_WAIT_V(8); PG8_WAIT_L(0); PG8_BAR; PG8_MMA(0, 0, At, B0); PG8_MMA(0, 1, At, B1); PG8_BAR; PG8_SCHED;
            PG8_LDA(At, 0, 1); PG8_STAGE(PG8_SB(0, 0), b2, voffB); PG8_STAGE(PG8_SB(0, 1), b2 + hstepB, voffB); PG8_STAGE(PG8_SA(0, 0), a2, voffA);
            PG8_WAIT_V(8); PG8_WAIT_L(0); PG8_BAR; PG8_MMA(1, 0, At, B0); PG8_MMA(1, 1, At, B1); PG8_BAR; PG8_SCHED;
            PG8_LDB(B0, 1, 0); PG8_LDB(B1, 1, 1); PG8_SCHED; PG8_LDA(At, 1, 0); PG8_STAGE(PG8_SA(0, 1), a2 + hstepA, voffA);
            PG8_WAIT_V(8); PG8_WAIT_L(0); PG8_BAR; PG8_MMA(0, 0, At, B0); PG8_MMA(0, 1, At, B1); PG8_BAR; PG8_SCHED;
            PG8_LDA(At, 1, 1); PG8_STAGE(PG8_SB(1, 0), b3, voffB); PG8_STAGE(PG8_SB(1, 1), b3 + hstepB, voffB); PG8_STAGE(PG8_SA(1, 0), a3, voffA);
            PG8_WAIT_V(8); PG8_WAIT_L(0); PG8_BAR; PG8_MMA(1, 0, At, B0); PG8_MMA(1, 1, At, B1); PG8_BAR; PG8_SCHED;
            } else {
            PG8_LDB(B0, 0, 0); PG8_SCHED; PG8_LDA(At, 0, 0); PG8_STAGE(PG8_SA(1, 1), a1 + hstepA, voffA);
            PG8_WAIT_L(8); PG8_BAR; PG8_WAIT_L(0); PG8_MMA(0, 0, At, B0); PG8_BAR; PG8_SCHED;
            PG8_LDB(B1, 0, 1); PG8_STAGE(PG8_SB(0, 0), b2, voffB);
            PG8_BAR; PG8_WAIT_L(0); PG8_MMA(0, 1, At, B1); PG8_BAR;
            PG8_LDA(At, 0, 1); PG8_STAGE(PG8_SA(0, 0), a2, voffA);
            PG8_BAR; PG8_WAIT_L(0); PG8_MMA(1, 0, At, B0); PG8_BAR; PG8_SCHED;
            PG8_STAGE(PG8_SB(0, 1), b2 + hstepB, voffB);
            PG8_WAIT_V(6); PG8_BAR; PG8_MMA(1, 1, At, B1); PG8_BAR;
            PG8_LDB(B0, 1, 0); PG8_SCHED; PG8_LDA(At, 1, 0); PG8_STAGE(PG8_SA(0, 1), a2 + hstepA, voffA);
            PG8_WAIT_L(8); PG8_BAR; PG8_WAIT_L(0); PG8_MMA(0, 0, At, B0); PG8_BAR; PG8_SCHED;
            PG8_LDB(B1, 1, 1); PG8_STAGE(PG8_SB(1, 0), b3, voffB);
            PG8_BAR; PG8_WAIT_L(0); PG8_MMA(0, 1, At, B1); PG8_BAR;
            PG8_LDA(At, 1, 1); PG8_STAGE(PG8_SA(1, 0), a3, voffA);
            PG8_BAR; PG8_WAIT_L(0); PG8_MMA(1, 0, At, B0); PG8_BAR; PG8_SCHED;
            PG8_STAGE(PG8_SB(1, 1), b3 + hstepB, voffB);
            PG8_WAIT_V(6); PG8_BAR; PG8_MMA(1, 1, At, B1); PG8_BAR;
            }
        }
        if constexpr (ALIGN_EPI) { if (wr == 0) PG8_BAR; }
        { int l2 = lane_id(); asm volatile("" : "+v"(l2));
          if constexpr (Epi::CARRY) { E(acc, cur, wr, wc, l2 & 15, l2 >> 4, carry, (wid << 6) | l2); if (has_next) carry = E.pre(nxt, (wid << 6) | l2); }
          else E(acc, cur, wr, wc, l2 & 15, l2 >> 4); }
        S.done(cur);
        if (!has_next) break;
        bool zero_acc = true;
        if constexpr (Epi::KEEP) zero_acc = !E.keep(cur);
        if (zero_acc) {
#pragma unroll
        for (int a = 0; a < 2; ++a)
#pragma unroll
            for (int b = 0; b < 2; ++b)
#pragma unroll
                for (int m = 0; m < 4; ++m)
#pragma unroll
                    for (int n = 0; n < 2; ++n) acc[a][b][m][n] = (f32x4){0.f, 0.f, 0.f, 0.f};
        }
        cur = nxt; cA = nA; cB = nB; ++ui;
        if constexpr (ALIGN_EPI) { if (wr == 1) PG8_BAR; }
    }
    PG8_WAIT_V(0);
    if constexpr (!ALIGN_EPI) { if (wr == 0) PG8_BAR; }
    PG8_BAR;
#undef PG8_SA
#undef PG8_SB
#undef PG8_STAGE
#undef PG8_LDA
#undef PG8_LDB
#undef PG8_MMA
#undef PG8_WAIT_V
#undef PG8_WAIT_L
#undef PG8_BAR
#undef PG8_SCHED
}
}

#ifndef PG8_SP2
#define PG8_SP2 true
#endif
#ifndef PG8_ALIGN
#define PG8_ALIGN true
#endif
using pg8::Unit;
typedef const f32x4 (&AccRef)[2][2][4][2];
typedef f32x4 (&AccMut)[2][2][4][2];

__device__ __forceinline__ float act_one(float x, float c1, float c3, float off, bool mulx) {
    const float t = fmaf(x, fmaf(c3, x * x, c1), off);
    const float e = __builtin_amdgcn_exp2f(t * -1.4426950408889634f);
    const float sg = __builtin_amdgcn_rcpf(1.0f + e);
    return (mulx ? x : 1.0f) * sg;
}
template <bool SCALE> __device__ __forceinline__ void epi1_gate(AccRef acc, bf16* P, const float* bgate, const LAS float* rs, int pm, int t, int wr, int wc, int fr, int fq) {
    const int row0 = pm * 256 + wr * 64 + fr, cw = t * 128 + wc * 32 + 8 * fq;
    float rsv[2][4];
#pragma unroll
    for (int ai = 0; ai < 2; ++ai)
#pragma unroll
        for (int m = 0; m < 4; ++m) rsv[ai][m] = SCALE ? rs[wr * 64 + fr + ai * 128 + m * 16] : 1.0f;
    f32x4 ba[2], bb[2];
#pragma unroll
    for (int n = 0; n < 2; ++n) { ba[n] = *(const f32x4*)(bgate + cw + 4 * n) * -1.4426950408889634f; bb[n] = *(const f32x4*)(bgate + DM + cw + 4 * n) * -1.4426950408889634f; }
#pragma unroll
    for (int ai = 0; ai < 2; ++ai)
#pragma unroll
        for (int m = 0; m < 4; ++m) {
            const int row = row0 + ai * 128 + m * 16; bf16* rowp = P + (size_t)row * LDP + cw;
            float orr[8], og[8];
#pragma unroll
            for (int n = 0; n < 2; ++n)
#pragma unroll
                for (int j = 0; j < 4; ++j) { const float xa = SCALE ? acc[ai][0][m][n][j] * rsv[ai][m] : acc[ai][0][m][n][j], xb = SCALE ? acc[ai][1][m][n][j] * rsv[ai][m] : acc[ai][1][m][n][j];
                    const float da = 1.0f + __builtin_amdgcn_exp2f(fmaf(xa, -1.4426950408889634f, ba[n][j]));
                    const float db = 1.0f + __builtin_amdgcn_exp2f(fminf(fmaf(xb, -1.4426950408889634f, bb[n][j]), 64.0f));
                    og[4 * n + j] = __builtin_amdgcn_rcpf(db); orr[4 * n + j] = db * __builtin_amdgcn_rcpf(da); }
            v4u w; w.x = cvt_pk_bf16(orr[0], orr[1]); w.y = cvt_pk_bf16(orr[2], orr[3]); w.z = cvt_pk_bf16(orr[4], orr[5]); w.w = cvt_pk_bf16(orr[6], orr[7]);
            *(v4u*)(rowp + C_GA) = w;
            v4u g; g.x = cvt_pk_bf16(og[0], og[1]); g.y = cvt_pk_bf16(og[2], og[3]); g.z = cvt_pk_bf16(og[4], og[5]); g.w = cvt_pk_bf16(og[6], og[7]);
            *(v4u*)(rowp + C_GB) = g;
        }
}
template <int MODE, bool STATS, bool SCALE> __device__ __forceinline__ void epi1_body(AccRef acc, bf16* P, const float* bgate, f32x2* part, const LAS float* rs, int pm, int pn, int wr, int wc, int fr, int fq) {
    const int row0 = pm * 256 + wr * 64 + fr, col0 = pn * 256 + wc * 32 + 8 * fq;
    float rsv[2][4];
#pragma unroll
    for (int ai = 0; ai < 2; ++ai)
#pragma unroll
        for (int m = 0; m < 4; ++m) rsv[ai][m] = SCALE ? rs[wr * 64 + fr + ai * 128 + m * 16] : 1.0f;
    f32x4 bv[2][2];
    if (MODE == 3) {
#pragma unroll
        for (int bj = 0; bj < 2; ++bj)
#pragma unroll
            for (int n = 0; n < 2; ++n) bv[bj][n] = *(const f32x4*)(bgate + (col0 - C_GA) + bj * 128 + 4 * n) * -1.4426950408889634f;
    }
#pragma unroll
    for (int ai = 0; ai < 2; ++ai)
#pragma unroll
        for (int m = 0; m < 4; ++m) {
            const int row = row0 + ai * 128 + m * 16; bf16* rowp = P + (size_t)row * LDP + col0; float rs = 0.f, rq = 0.f;
#pragma unroll
            for (int bj = 0; bj < 2; ++bj) {
                float o[8];
#pragma unroll
                for (int n = 0; n < 2; ++n)
#pragma unroll
                    for (int j = 0; j < 4; ++j) { const float x = SCALE ? acc[ai][bj][m][n][j] * rsv[ai][m] : acc[ai][bj][m][n][j]; float r;
                        if (MODE == 0) { const float t = x * fmaf(-0.10294324576f, x * x, -2.3022081985f); r = x * __builtin_amdgcn_rcpf(1.0f + __builtin_amdgcn_exp2f(t)); }
                        else if (MODE == 1) { r = x * __builtin_amdgcn_rcpf(1.0f + __builtin_amdgcn_exp2f(x * -1.4426950408889634f)); }
                        else if (MODE == 2) { r = x; }
                        else { r = __builtin_amdgcn_rcpf(1.0f + __builtin_amdgcn_exp2f(fmaf(x, -1.4426950408889634f, bv[bj][n][j]))); }
                        o[4 * n + j] = r; if (STATS) { rs += r; rq += r * r; } }
                v4u w; w.x = cvt_pk_bf16(o[0], o[1]); w.y = cvt_pk_bf16(o[2], o[3]); w.z = cvt_pk_bf16(o[4], o[5]); w.w = cvt_pk_bf16(o[6], o[7]);
                *(v4u*)(rowp + bj * 128) = w;
            }
            if (STATS) { rs += __shfl_xor(rs, 16); rs += __shfl_xor(rs, 32); rq += __shfl_xor(rq, 16); rq += __shfl_xor(rq, 32);
                if (fq == 0) part[(size_t)((pn - 8) * 4 + wc) * MTOT + row] = (f32x2){rs, rq}; }
        }
}
template <bool SCALE> struct Epi1 {
    static constexpr bool PERM = true; static constexpr bool KEEP = false; static constexpr bool CARRY = SCALE;
    bf16* P; const float* bgate; f32x2* part; const float* rs; LAS float* rsl;
    __device__ __forceinline__ float pre(const Unit& u, int tid) const { return rs[u.pm * 256 + (tid & 255)]; }
    __device__ __forceinline__ void body(AccRef acc, const Unit& u, int wr, int wc, int fr, int fq) const {
        const int pn = u.pn;
        if (pn < 8) epi1_body<0, false, SCALE>(acc, P, bgate, part, rsl, u.pm, pn, wr, wc, fr, fq);
        else if (pn < 16) epi1_body<0, true, SCALE>(acc, P, bgate, part, rsl, u.pm, pn, wr, wc, fr, fq);
        else if (pn >= 40) epi1_gate<SCALE>(acc, P, bgate, rsl, u.pm, pn - 40, wr, wc, fr, fq);
        else if (pn >= 24 && pn < 32) epi1_body<2, false, SCALE>(acc, P, bgate, part, rsl, u.pm, pn, wr, wc, fr, fq);
        else epi1_body<1, false, SCALE>(acc, P, bgate, part, rsl, u.pm, pn, wr, wc, fr, fq);
    }
    __device__ __forceinline__ void operator()(AccRef acc, const Unit& u, int wr, int wc, int fr, int fq) const { body(acc, u, wr, wc, fr, fq); }
    __device__ __forceinline__ void operator()(AccRef acc, const Unit& u, int wr, int wc, int fr, int fq, float carry, int tid) const {
        if (tid < 256) rsl[tid] = carry;
        asm volatile("s_waitcnt lgkmcnt(0)" ::: "memory"); __builtin_amdgcn_s_barrier();
        body(acc, u, wr, wc, fr, fq);
    }
};
struct EpiD1 {
    static constexpr bool PERM = true; static constexpr bool KEEP = false; static constexpr bool CARRY = false;
    bf16* YT;
    __device__ __forceinline__ void operator()(AccRef acc, const Unit& u, int wr, int wc, int fr, int fq) const {
        bf16* o0 = YT + ((size_t)u.pn * 2048 + (size_t)(u.aux * 256 + wr * 64 + fr)) * 512 + u.pm * 256 + wc * 32 + 8 * fq;
#pragma unroll
        for (int ai = 0; ai < 2; ++ai)
#pragma unroll
            for (int m = 0; m < 4; ++m) { bf16* rowp = o0 + (size_t)(ai * 128 + m * 16) * 512;
#pragma unroll
                for (int bj = 0; bj < 2; ++bj) { const f32x4 v0 = acc[ai][bj][m][0] * 0.0625f, v1 = acc[ai][bj][m][1] * 0.0625f;
                    v4u w; w.x = cvt_pk_bf16(v0[0], v0[1]); w.y = cvt_pk_bf16(v0[2], v0[3]); w.z = cvt_pk_bf16(v1[0], v1[1]); w.w = cvt_pk_bf16(v1[2], v1[3]);
                    *(v4u*)(rowp + bj * 128) = w; } }
    }
};
struct EpiD2 {
    static constexpr bool PERM = true; static constexpr bool KEEP = false; static constexpr bool CARRY = false;
    bf16* P;
    __device__ __forceinline__ void operator()(AccRef acc, const Unit& u, int wr, int wc, int fr, int fq) const {
        const int rt = u.aux; int tok0, N1;
        if (rt < 64) { N1 = 8; tok0 = (rt >> 3) * 2048 + (rt & 7); } else { N1 = 16; tok0 = MPR + ((rt - 64) >> 4) * 4096 + ((rt - 64) & 15); }
        const float scale = 0.0625f;
        const size_t rstride = (size_t)N1 * LDP;
        const bf16* Pb = P + (size_t)(tok0 + N1 * (wr * 64 + fr)) * LDP + C_ZB + u.pn * 256 + wc * 32 + 8 * fq;
        v4u z[2][4][2];
#pragma unroll
        for (int ai = 0; ai < 2; ++ai)
#pragma unroll
            for (int m = 0; m < 4; ++m)
#pragma unroll
                for (int bj = 0; bj < 2; ++bj) z[ai][m][bj] = *(const v4u*)(Pb + (size_t)(ai * 128 + m * 16) * rstride + bj * 128);
        asm volatile("" ::: "memory");
#pragma unroll
        for (int ai = 0; ai < 2; ++ai)
#pragma unroll
            for (int m = 0; m < 4; ++m) { bf16* rowp = (bf16*)Pb + (size_t)(ai * 128 + m * 16) * rstride;
#pragma unroll
                for (int bj = 0; bj < 2; ++bj) { const v4u zz = z[ai][m][bj]; const f32x4 v0 = acc[ai][bj][m][0] * scale, v1 = acc[ai][bj][m][1] * scale;
                    v4u w; w.x = cvt_pk_bf16(v0[0] * bf_lo(zz.x), v0[1] * bf_hi(zz.x)); w.y = cvt_pk_bf16(v0[2] * bf_lo(zz.y), v0[3] * bf_hi(zz.y));
                    w.z = cvt_pk_bf16(v1[0] * bf_lo(zz.z), v1[1] * bf_hi(zz.z)); w.w = cvt_pk_bf16(v1[2] * bf_lo(zz.w), v1[3] * bf_hi(zz.w));
                    *(v4u*)(rowp + bj * 128) = w; } }
        asm volatile("" ::: "memory");
    }
};
struct OrderG2 {
    pg8::OrderMN o; const char* A2; const char* B2;
    __device__ __forceinline__ bool next(int i, Unit& u) const {
        if (!o.next(i >> 1, u)) return false;
        u.aux = i & 1; if (u.aux) { u.a = A2 + (size_t)u.pm * o.tA; u.b = B2 + (size_t)u.pn * o.tB; } return true; }
    __device__ __forceinline__ void a_ready(const Unit&) const {}
    __device__ __forceinline__ void done(const Unit&) const {}
};
struct Epi2G {
    static constexpr bool PERM = true; static constexpr bool KEEP = true; static constexpr bool CARRY = false;
    const bf16* P; bf16* Mb;
    __device__ __forceinline__ bool keep(const Unit& u) const { return u.aux == 0; }
    __device__ __forceinline__ void operator()(AccMut acc, const Unit& u, int wr, int wc, int fr, int fq) const {
        const int row0 = u.pm * 256 + wr * 64 + fr, col0 = u.pn * 256 + wc * 32 + 8 * fq;
        const bf16* gp = P + (size_t)row0 * LDP + (u.aux ? C_GB : C_GA) + col0;
        v4u g[2][4][2];
#pragma unroll
        for (int ai = 0; ai < 2; ++ai)
#pragma unroll
            for (int m = 0; m < 4; ++m)
#pragma unroll
                for (int bj = 0; bj < 2; ++bj) g[ai][m][bj] = *(const v4u*)(gp + (size_t)(ai * 128 + m * 16) * LDP + bj * 128);
        asm volatile("" ::: "memory");
        if (u.aux == 0) {
#pragma unroll
            for (int ai = 0; ai < 2; ++ai)
#pragma unroll
                for (int m = 0; m < 4; ++m)
#pragma unroll
                    for (int bj = 0; bj < 2; ++bj) { v4u gg = g[ai][m][bj]; asm volatile("" : "+v"(gg.x), "+v"(gg.y), "+v"(gg.z), "+v"(gg.w));
                        acc[ai][bj][m][0] *= (f32x4){bf_lo(gg.x), bf_hi(gg.x), bf_lo(gg.y), bf_hi(gg.y)}; acc[ai][bj][m][1] *= (f32x4){bf_lo(gg.z), bf_hi(gg.z), bf_lo(gg.w), bf_hi(gg.w)}; }
        } else {
#pragma unroll
            for (int ai = 0; ai < 2; ++ai)
#pragma unroll
                for (int m = 0; m < 4; ++m) { bf16* op = Mb + (size_t)(row0 + ai * 128 + m * 16) * DM + col0;
#pragma unroll
                    for (int bj = 0; bj < 2; ++bj) { v4u gg = g[ai][m][bj]; asm volatile("" : "+v"(gg.x), "+v"(gg.y), "+v"(gg.z), "+v"(gg.w)); const f32x4 a0 = acc[ai][bj][m][0], a1 = acc[ai][bj][m][1];
                        v4u w; w.x = cvt_pk_bf16(a0[0] * bf_lo(gg.x), a0[1] * bf_hi(gg.x)); w.y = cvt_pk_bf16(a0[2] * bf_lo(gg.y), a0[3] * bf_hi(gg.y));
                        w.z = cvt_pk_bf16(a1[0] * bf_lo(gg.z), a1[1] * bf_hi(gg.z)); w.w = cvt_pk_bf16(a1[2] * bf_lo(gg.w), a1[3] * bf_hi(gg.w));
                        *(v4u*)(op + bj * 128) = w; } }
            asm volatile("" ::: "memory");
        }
    }
};
struct Epi3 {
    static constexpr bool PERM = true; static constexpr bool KEEP = false; static constexpr bool CARRY = false;
    bf16* x1; float* ss;
    __device__ __forceinline__ void operator()(AccRef acc, const Unit& u, int wr, int wc, int fr, int fq) const {
        const int rt = u.pm * 256;
        const int r0 = wr * 64 + fr, col0 = u.pn * 256 + wc * 32 + 8 * fq;
        bf16* xh = x1 + (size_t)rt * DM;
        const bool want = (ss != nullptr);
        v4u xw[2][4][2];
#pragma unroll
        for (int ai = 0; ai < 2; ++ai)
#pragma unroll
            for (int m = 0; m < 4; ++m)
#pragma unroll
                for (int bj = 0; bj < 2; ++bj) xw[ai][m][bj] = *(const v4u*)(xh + (size_t)(r0 + ai * 128 + m * 16) * DM + col0 + bj * 128);
        asm volatile("" ::: "memory");
#pragma unroll
        for (int ai = 0; ai < 2; ++ai)
#pragma unroll
            for (int m = 0; m < 4; ++m) { float q = 0.f; int rr = r0 + ai * 128 + m * 16; asm volatile("" : "+v"(rr));
#pragma unroll
                for (int bj = 0; bj < 2; ++bj) { v4u w = xw[ai][m][bj]; asm volatile("" : "+v"(w.x), "+v"(w.y), "+v"(w.z), "+v"(w.w));
                    const f32x4 v0 = (f32x4){bf_lo(w.x), bf_hi(w.x), bf_lo(w.y), bf_hi(w.y)} + acc[ai][bj][m][0], v1 = (f32x4){bf_lo(w.z), bf_hi(w.z), bf_lo(w.w), bf_hi(w.w)} + acc[ai][bj][m][1];
                    q += (v0.x * v0.x + v0.y * v0.y) + (v0.z * v0.z + v0.w * v0.w) + (v1.x * v1.x + v1.y * v1.y) + (v1.z * v1.z + v1.w * v1.w);
                    v4u o; o.x = cvt_pk_bf16(v0.x, v0.y); o.y = cvt_pk_bf16(v0.z, v0.w); o.z = cvt_pk_bf16(v1.x, v1.y); o.w = cvt_pk_bf16(v1.z, v1.w);
                    *(v4u*)(xh + (size_t)rr * DM + col0 + bj * 128) = o; }
                if (want) { q += __shfl_xor(q, 16); q += __shfl_xor(q, 32); if (fq == 0) ss[(size_t)(u.pn * 4 + wc) * MTOT + rt + rr] = q; } }
        asm volatile("" ::: "memory");
    }
};

struct OrderD1 {
    int G, c; const char* D; const char* Z;
    __device__ __forceinline__ bool next(int i, Unit& u) const {
        const int L = i * G + c; if (L >= 2048) return false;
        u.pn = L >> 4; u.aux = (L >> 1) & 7; u.pm = L & 1;
        u.a = D + (size_t)u.pm * (256 * 512 * 2); u.b = Z + ((size_t)u.pn * 256 * 4096 + (size_t)u.aux * 512) * 2; return true; }
    __device__ __forceinline__ void a_ready(const Unit&) const {}
    __device__ __forceinline__ void done(const Unit&) const {}
};
struct OrderD2 {
    int G, c; const char* T; const char* YT;
    __device__ __forceinline__ bool next(int i, Unit& u) const {
        const int L = i * G + c; if (L >= 1024) return false;
        u.aux = L >> 3; u.pn = L & 7; u.pm = 0;
        u.a = T; u.b = YT + ((size_t)u.aux * 2048 + (size_t)u.pn * 256) * 512 * 2; return true; }
    __device__ __forceinline__ void a_ready(const Unit&) const {}
    __device__ __forceinline__ void done(const Unit&) const {}
};

__device__ constexpr float C16[16] = {1.0f, 0.9238795325112867f, 0.7071067811865476f, 0.3826834323650898f, 0.0f, -0.3826834323650898f, -0.7071067811865476f, -0.9238795325112867f,
                                      -1.0f, -0.9238795325112867f, -0.7071067811865476f, -0.3826834323650898f, 0.0f, 0.3826834323650898f, 0.7071067811865476f, 0.9238795325112867f};
__device__ constexpr float S16[16] = {0.0f, 0.3826834323650898f, 0.7071067811865476f, 0.9238795325112867f, 1.0f, 0.9238795325112867f, 0.7071067811865476f, 0.3826834323650898f,
                                      0.0f, -0.3826834323650898f, -0.7071067811865476f, -0.9238795325112867f, -1.0f, -0.9238795325112867f, -0.7071067811865476f, -0.3826834323650898f};
template <int N1> __device__ __forceinline__ void s1_items(const bf16* P, bf16* Z, const f32x2* TW, int row_base, int nb, int gt, int NGT) {
    constexpr int S = 256 * N1;
    const int nitems = nb * 256 * 512;
    for (int it = gt; it < nitems; it += NGT) {
        const int cg = it & 511, bn = it >> 9, n2 = bn & 255, b = bn >> 8, ch = cg * 4, g = ch >> 8, c = ch & 255;
        const bf16* src = P + (size_t)(row_base + b * S + n2) * LDP + C_XB + ch;
        float x[N1][4];
#pragma unroll
        for (int n1 = 0; n1 < N1; ++n1) { const v2u w = *(const v2u*)(src + (size_t)n1 * 256 * LDP); x[n1][0] = bf_lo(w.x); x[n1][1] = bf_hi(w.x); x[n1][2] = bf_lo(w.y); x[n1][3] = bf_hi(w.y); }
        bf16* dst = Z + (size_t)(row_base + b * S + n2) * 4096 + g * 512 + c;
#pragma unroll
        for (int k1 = 0; k1 <= N1 / 2; ++k1) {
            float re[4] = {0.f, 0.f, 0.f, 0.f}, im[4] = {0.f, 0.f, 0.f, 0.f};
#pragma unroll
            for (int n1 = 0; n1 < N1; ++n1) { const float cs = C16[((n1 * k1) % N1) * (16 / N1)], sn = S16[((n1 * k1) % N1) * (16 / N1)];
#pragma unroll
                for (int j = 0; j < 4; ++j) { re[j] = fmaf(x[n1][j], cs, re[j]); im[j] = fmaf(x[n1][j], -sn, im[j]); } }
#pragma unroll
            for (int mir = 0; mir < 2; ++mir) {
                if (mir == 1 && (k1 == 0 || k1 == N1 / 2)) continue;
                const int kk = mir ? N1 - k1 : k1;
                float imm[4];
#pragma unroll
                for (int j = 0; j < 4; ++j) imm[j] = mir ? -im[j] : im[j];
                const f32x2 tw = TW[(n2 * kk) & (S - 1)]; const float ct = tw.x, st = tw.y;
                v2u wr_, wi_;
                wr_.x = cvt_pk_bf16(re[0] * ct + imm[0] * st, re[1] * ct + imm[1] * st); wr_.y = cvt_pk_bf16(re[2] * ct + imm[2] * st, re[3] * ct + imm[3] * st);
                wi_.x = cvt_pk_bf16(imm[0] * ct - re[0] * st, imm[1] * ct - re[1] * st); wi_.y = cvt_pk_bf16(imm[2] * ct - re[2] * st, imm[3] * ct - re[3] * st);
                *(v2u*)(dst + (size_t)kk * 256 * 4096) = wr_; *(v2u*)(dst + (size_t)kk * 256 * 4096 + 256) = wi_;
            }
        }
    }
}

#define XB_TMO      128
#define XB_XCNT(j)  (256  + 64 * (j))
#define XB_XSUB(j)  (1280 + 64 * (j))
#define XB_XGEN(j)  (2304 + 64 * (j))
#define XB_TOP      3328
#define XB_TOPGEN   3392
#define XCD_BAR_WORDS 3456
#define XB_SPIN_CAP (1u << 18)
__device__ __forceinline__ unsigned xb_ld(unsigned* p)              { return __hip_atomic_load(p, __ATOMIC_RELAXED, __HIP_MEMORY_SCOPE_AGENT); }
__device__ __forceinline__ unsigned xb_add(unsigned* p, unsigned v) { return __hip_atomic_fetch_add(p, v, __ATOMIC_RELAXED, __HIP_MEMORY_SCOPE_AGENT); }
__device__ __forceinline__ unsigned xb_xcc_id() { return (unsigned)__builtin_amdgcn_s_getreg((3 << 11) | 20) & 0xFu; }
#define XB_SPIN(cond, bar) do { unsigned _sp = 0; while (cond) { __builtin_amdgcn_s_sleep(1); \
    if ((++_sp & 255u) == 0u) { if (xb_ld(&(bar)[XB_TMO])) break; if (_sp > XB_SPIN_CAP) { atomicAdd(&(bar)[XB_TMO], 1u); break; } } } } while (0)
struct XcdBarrier { unsigned* bar; unsigned x; volatile LAS unsigned* st; };
__device__ __forceinline__ XcdBarrier xcd_barrier_post(unsigned* bar, volatile LAS unsigned* st, bool leader) {
    XcdBarrier b; b.bar = bar; b.x = xb_xcc_id(); b.st = st;
    if (leader) (void)xb_add(&bar[XB_XCNT(b.x)], 1u);
    return b;
}
__device__ __forceinline__ void xcd_barrier_complete(unsigned* bar, unsigned x, unsigned& nloc, unsigned& nx) {
    const unsigned G = gridDim.x * gridDim.y * gridDim.z;
    unsigned sum, cnt, mine, sp = 0u;
    for (;;) {
        sum = 0u; cnt = 0u; mine = 0u;
#pragma unroll
        for (unsigned j = 0; j < 16; ++j) { const unsigned c = xb_ld(&bar[XB_XCNT(j)]); sum += c; cnt += (c > 0u) ? 1u : 0u; mine = (j == x) ? c : mine; }
        if (sum == G) break;
        __builtin_amdgcn_s_sleep(1);
        if ((++sp & 255u) == 0u) { if (xb_ld(&bar[XB_TMO])) break; if (sp > XB_SPIN_CAP) { atomicAdd(&bar[XB_TMO], 1u); break; } }
    }
    nloc = mine > 0u ? mine : 1u; nx = cnt > 0u ? cnt : 1u;
}
__device__ __forceinline__ void xcd_barrier(const XcdBarrier& b, bool leader) {
    asm volatile("s_waitcnt vmcnt(0)" ::: "memory");
    __syncthreads();
    if (leader) {
        unsigned* bar = b.bar;
        __builtin_amdgcn_s_waitcnt(0);
        unsigned nloc = b.st[0], nx = b.st[1];
        if (nloc == 0u) { xcd_barrier_complete(bar, b.x, nloc, nx); b.st[0] = nloc; b.st[1] = nx; }
        const unsigned old = xb_add(&bar[XB_XSUB(b.x)], 1u);
        const unsigned gen = old / nloc;
        if (old + 1u == (gen + 1u) * nloc) {
            __builtin_amdgcn_fence(__ATOMIC_RELEASE, "agent");
            asm volatile("s_waitcnt vmcnt(0)" ::: "memory");
            const unsigned og = xb_add(&bar[XB_TOP], 1u);
            const unsigned tg = og / nx;
            if (og + 1u == (tg + 1u) * nx) xb_add(&bar[XB_TOPGEN], 1u);
            else XB_SPIN(xb_ld(&bar[XB_TOPGEN]) == tg, bar);
            __builtin_amdgcn_fence(__ATOMIC_ACQUIRE, "agent");
            xb_add(&bar[XB_XGEN(b.x)], 1u);
            asm volatile("s_waitcnt vmcnt(0)" ::: "memory");
        } else {
            XB_SPIN(xb_ld(&bar[XB_XGEN(b.x)]) == gen, bar);
            __builtin_amdgcn_fence(__ATOMIC_ACQUIRE, "agent");
            asm volatile("s_waitcnt vmcnt(0)" ::: "memory");
        }
    }
    __syncthreads();
}

__device__ __forceinline__ float wave_sum(float v) {
#pragma unroll
    for (int o = 1; o < 64; o <<= 1) v += __shfl_xor(v, o);
    return v;
}
__device__ __forceinline__ void p0_transpose_item(const float* W, int K, int N, bf16* WT, LAS float* scr, int item, int lane, bool deal = false, const float* gk = nullptr) {
    const int nblk = N / 32, kb = item / nblk, nb = item % nblk, k0 = 64 * kb, n0 = 32 * nb;
    f32x4 wv[8];
#pragma unroll
    for (int i = 0; i < 8; ++i) wv[i] = *(const f32x4*)(W + (size_t)(k0 + 8 * i + (lane >> 3)) * N + n0 + 4 * (lane & 7));
#pragma unroll
    for (int i = 0; i < 8; ++i) { LAS float* d = scr + (8 * i + (lane >> 3)) * 33 + 4 * (lane & 7); d[0] = wv[i].x; d[1] = wv[i].y; d[2] = wv[i].z; d[3] = wv[i].w; }
    LDS_WAIT(); asm volatile("" ::: "memory");
    const int c = lane & 7;
    f32x4 ga = {1.f, 1.f, 1.f, 1.f}, gb = {1.f, 1.f, 1.f, 1.f};
    if (gk) { ga = *(const f32x4*)(gk + k0 + 8 * c); gb = *(const f32x4*)(gk + k0 + 8 * c + 4); }
    int nd = n0;
    if (deal && n0 >= C_GA) { const int g = n0 - C_GA, hb = (g >= DM) ? 1 : 0, gg = g - hb * DM; nd = C_GA + ((gg >> 7) << 8) + hb * 128 + (gg & 127); }
#pragma unroll
    for (int j = 0; j < 4; ++j) { const int n = (lane >> 3) + 8 * j; const LAS float* s = scr + (8 * c) * 33 + n;
        v4u o; o.x = pk2(s[0 * 33] * ga.x, s[1 * 33] * ga.y); o.y = pk2(s[2 * 33] * ga.z, s[3 * 33] * ga.w); o.z = pk2(s[4 * 33] * gb.x, s[5 * 33] * gb.y); o.w = pk2(s[6 * 33] * gb.z, s[7 * 33] * gb.w);
        *(GAS v4u*)(WT + (size_t)(nd + n) * K + k0 + 8 * c) = o; }
    LDS_WAIT(); asm volatile("" ::: "memory");
}
__device__ __forceinline__ void x_row_to_bf16(const float* xrow, bf16* orow, float* rs, int lane) {
    const GAS f32x4* xr = (const GAS f32x4*)xrow + lane;
    f32x4 v[16]; float s = 0.f;
#pragma unroll
    for (int j = 0; j < 16; ++j) { v[j] = xr[64 * j]; s += (v[j].x * v[j].x + v[j].y * v[j].y) + (v[j].z * v[j].z + v[j].w * v[j].w); }
    const float rstd = 1.0f / sqrtf(wave_sum(s) * (1.0f / DM) + EPS);
    GAS v2u* o8 = (GAS v2u*)orow + lane;
#pragma unroll
    for (int j = 0; j < 16; ++j) { v2u w; w.x = cvt_pk_bf16(v[j].x, v[j].y); w.y = cvt_pk_bf16(v[j].z, v[j].w); o8[64 * j] = w; }
    if (lane == 0) *rs = rstd;
}
__device__ __forceinline__ void rms_row_bf16_to_f32(const bf16* xrow, const f32x4 (&g8)[8][2], float* orow, int lane) {
    const GAS v4u* xr = (const GAS v4u*)xrow + lane;
    v4u w[8]; float s = 0.f;
#pragma unroll
    for (int j = 0; j < 8; ++j) w[j] = xr[64 * j];
#pragma unroll
    for (int j = 0; j < 8; ++j) { const float a0 = bf_lo(w[j].x), a1 = bf_hi(w[j].x), a2 = bf_lo(w[j].y), a3 = bf_hi(w[j].y), a4 = bf_lo(w[j].z), a5 = bf_hi(w[j].z), a6 = bf_lo(w[j].w), a7 = bf_hi(w[j].w);
        s += (a0 * a0 + a1 * a1) + (a2 * a2 + a3 * a3) + (a4 * a4 + a5 * a5) + (a6 * a6 + a7 * a7); }
    const float rstd = 1.0f / sqrtf(wave_sum(s) * (1.0f / DM) + EPS);
    GAS f32x4* o = (GAS f32x4*)orow + 2 * lane;
#pragma unroll
    for (int j = 0; j < 8; ++j) { const f32x4 ga = g8[j][0] * rstd, gb = g8[j][1] * rstd;
        o[128 * j] = (f32x4){bf_lo(w[j].x) * ga.x, bf_hi(w[j].x) * ga.y, bf_lo(w[j].y) * ga.z, bf_hi(w[j].y) * ga.w};
        o[128 * j + 1] = (f32x4){bf_lo(w[j].z) * gb.x, bf_hi(w[j].z) * gb.y, bf_lo(w[j].w) * gb.z, bf_hi(w[j].w) * gb.w}; }
}

struct Args { const float* in[13]; float* out; unsigned char* ws; int ph_lo, ph_hi, li, pad; };
typedef __attribute__((address_space(4))) const Args CArgs;
#define PHASE_BEGIN() \
    unsigned oz_ = 0u; asm volatile("" : "+s"(oz_));              \
    CArgs* AP = (CArgs*)((__attribute__((address_space(4))) const char*)__builtin_amdgcn_kernarg_segment_ptr() + oz_); \
    int t_ = (wave0 << 6) | (int)__builtin_amdgcn_mbcnt_hi(~0u, __builtin_amdgcn_mbcnt_lo(~0u, oz_)); asm volatile("" : "+v"(t_));       \
    const int tid = t_, lane = tid & 63, wave = __builtin_amdgcn_readfirstlane(tid >> 6); \
    int G = G0, vcu = vcu0, bx = bx0; asm volatile("" : "+s"(G), "+s"(vcu), "+s"(bx)); (void)bx; \
    unsigned char* ws = AP->ws; float* out = AP->out; (void)lane; (void)wave; (void)out; \
    const int gw = vcu * NWAVES + wave, NGW = G * NWAVES, gt = vcu * (NWAVES * 64) + tid, NGT = G * NWAVES * 64; (void)gw; (void)NGW; (void)gt; (void)NGT

__global__ void __launch_bounds__(NWAVES * 64, 2) trunk_fwd(Args args) {
    extern __shared__ __attribute__((aligned(16))) unsigned char lds_raw[];
    LAS unsigned char* lds = (LAS unsigned char*)lds_raw;
    const int G0 = gridDim.x, bx0 = blockIdx.x; const int vcu0 = (G0 % 8 == 0) ? (bx0 % 8) * (G0 / 8) + bx0 / 8 : bx0;
    const int wave0 = __builtin_amdgcn_readfirstlane(threadIdx.x >> 6);
    for (int u = threadIdx.x; u < (LDS_BYTES - LDSCTL_OFF) / 4; u += NWAVES * 64) ((LAS unsigned*)(lds + LDSCTL_OFF))[u] = 0u;
    __syncthreads();
#if !MK_PER_PHASE
    (void)xcd_barrier_post((unsigned*)(args.ws + WS_CTL) + CW_BAR, (volatile LAS unsigned*)(lds + MISC_OFF) + 8, threadIdx.x == 0);
#define GRID_BAR() do { unsigned ozb_ = 0u; asm volatile("" : "+s"(ozb_)); \
        CArgs* AB_ = (CArgs*)((__attribute__((address_space(4))) const char*)__builtin_amdgcn_kernarg_segment_ptr() + ozb_); \
        XcdBarrier b_; b_.bar = (unsigned*)(AB_->ws + WS_CTL) + CW_BAR; b_.x = xb_xcc_id(); b_.st = (volatile LAS unsigned*)(lds + MISC_OFF) + 8; xcd_barrier(b_, wave0 == 0 && lane_id() == 0); } while (0)
#else
#define GRID_BAR() do { } while (0)
#endif
    const int lo = args.ph_lo, hi = args.ph_hi;
#define IN(k) (lo <= (k) && (k) < hi)
#define BOTH(k) (IN(k) && IN((k) + 1))

    if (IN(0)) {
        PHASE_BEGIN();
            bf16* DC = (bf16*)(ws + WS_DC); bf16* TT = (bf16*)(ws + WS_T);
            for (int e = gt; e < 512 * 512 / 8; e += NGT) { const int r = e >> 6, q0 = (e & 63) * 8; const int po = r >> 8, m = r & 255, pi = q0 >> 8, c0 = q0 & 255; float v[8];
#pragma unroll
                for (int j = 0; j < 8; ++j) { const float ph = (float)((m * (c0 + j)) & 255) * (1.0f / 128.0f); v[j] = (po == pi) ? cospif(ph) : ((po == 0) ? sinpif(ph) : -sinpif(ph)); }
                v4u w; w.x = pk2(v[0], v[1]); w.y = pk2(v[2], v[3]); w.z = pk2(v[4], v[5]); w.w = pk2(v[6], v[7]); *(GAS v4u*)(DC + (size_t)e * 8) = w; }
            for (int e = gt; e < 256 * 512 / 8; e += NGT) { const int k2 = e >> 6, q0 = (e & 63) * 8; const int pi = q0 >> 8, n0 = q0 & 255; float v[8];
#pragma unroll
                for (int j = 0; j < 8; ++j) { const float ph = (float)((k2 * (n0 + j)) & 255) * (1.0f / 128.0f); v[j] = pi ? sinpif(ph) : cospif(ph); }
                v4u w; w.x = pk2(v[0], v[1]); w.y = pk2(v[2], v[3]); w.z = pk2(v[4], v[5]); w.w = pk2(v[6], v[7]); *(GAS v4u*)(TT + (size_t)e * 8) = w; }

        { f32x2* TW = (f32x2*)(ws + WS_TW);
          for (int e = gt; e < 2048 + 4096; e += NGT) { const bool big = e >= 2048; const int j = big ? e - 2048 : e; const float ph = (float)j * (big ? (2.0f / 4096.0f) : (2.0f / 2048.0f)), sc = big ? 0.25f : 0.35355339059327373f;
              TW[e] = (f32x2){cospif(ph) * sc, sinpif(ph) * sc}; } }
    }

    for (int l = 0; l < 2; ++l) {
        const int pb = 7 * l;

        if (IN(pb + 0)) {
            PHASE_BEGIN();
            const float* norm_g = AP->in[2] + (size_t)l * DM;
            const float* w_in = AP->in[3] + (size_t)l * DM * DIN;
            const float* w_a = AP->in[8] + (size_t)l * DA * DM;
            const float* w_b = AP->in[9] + (size_t)l * DB * DM;
            const float* w_out = AP->in[11] + (size_t)l * DM * DM;
            bf16* W1T = (bf16*)(ws + WS_W1T); bf16* WAT = (bf16*)(ws + WS_WAT); bf16* WBT = (bf16*)(ws + WS_WBT); bf16* WOT = (bf16*)(ws + WS_WOT);
            LAS float* scr = (LAS float*)(lds + RING_OFF + wave * 16384);
            constexpr int I_1 = (DM / 64) * (DIN / 32), I_A = (DA / 64) * (DM / 32), I_O = (DM / 64) * (DM / 32);
            constexpr int NITEMS = I_1 + 2 * I_A + I_O;
            for (int it = gw; it < NITEMS; it += NGW) {
                int r = it;
                if (r < I_1) { p0_transpose_item(w_in, DM, DIN, W1T, scr, r, lane, true, norm_g); continue; } r -= I_1;
                if (r < I_A) { p0_transpose_item(w_a, DA, DM, WAT, scr, r, lane); continue; } r -= I_A;
                if (r < I_A) { p0_transpose_item(w_b, DB, DM, WBT, scr, r, lane); continue; } r -= I_A;
                p0_transpose_item(w_out, DM, DM, WOT, scr, r, lane);
            }
            if (l == 0) {
                const float* x_prompt = AP->in[0]; const float* x_sample = AP->in[1];
                bf16* X0 = (bf16*)(ws + WS_X1); float* RS0 = (float*)(ws + WS_RSTD);
                for (int m = gw; m < MTOT; m += NGW) {
                    const float* xrow = (m < MPR) ? x_prompt + (size_t)m * DM : x_sample + (size_t)(m - MPR) * DM;
                    x_row_to_bf16(xrow, X0 + (size_t)m * DM, RS0 + m, lane);
                }
            } else {
                float* RS = (float*)(ws + WS_RSTD); const float* SS = (const float*)(ws + WS_PART);
                for (int m = gt; m < MTOT; m += NGT) { float s = 0.f;
#pragma unroll 16
                    for (int j = 0; j < 64; ++j) s += SS[(size_t)j * MTOT + m];
                    RS[m] = 1.0f / sqrtf(s * (1.0f / DM) + EPS); }
            }
            VM_WAIT(); __syncthreads();
            if (BOTH(pb + 0)) GRID_BAR();
        }

        if (IN(pb + 1)) {
            PHASE_BEGIN();
            pg8::OrderMN S; S.init(MTOT / 256, DIN / 256, G, bx, ws + WS_X1, (size_t)256 * DM * 2, ws + WS_W1T, (size_t)256 * DM * 2);
            Epi1<true> E{(bf16*)(ws + WS_P), AP->in[10] + (size_t)l * 2 * DM, (f32x2*)(ws + WS_PART), (const float*)(ws + WS_RSTD), (LAS float*)(lds + RS_OFF)};
            pg8::gemm_phase<Epi1<true>, pg8::OrderMN, PG8_ALIGN, PG8_SP2>(wave0, lds + RING_OFF, DM, DM, DM, S, E);
            if (BOTH(pb + 1)) GRID_BAR();
        }

        if (IN(pb + 2)) {
            PHASE_BEGIN();
            const float* ln_g = AP->in[4] + (size_t)l * DA;
            const float* ln_b = AP->in[5] + (size_t)l * DA;
            const float* w_sp = AP->in[6] + (size_t)l * 16 * 128 * 128;
            const float* b_sp = AP->in[7] + (size_t)l * 16 * 128;
            bf16* P = (bf16*)(ws + WS_P); const f32x2* PART = (const f32x2*)(ws + WS_PART);
            LAS unsigned char* tile = lds + RING_OFF;
            LAS float* red = (LAS float*)(lds + RING_OFF + 65536);
            LAS float* st = (LAS float*)(lds + STAT_OFF);
            const int fr = lane & 15, g4 = lane >> 4, wp = wave >> 1, wcx = wave & 1;
            for (int chunk = vcu; chunk < 256; chunk += G) {
                const int r0 = chunk * 128;
                { const int row = tid & 127, grp = tid >> 7; float s = 0.f, q = 0.f;
#pragma unroll
                  for (int k = 0; k < 8; ++k) { const f32x2 p = PART[(size_t)(grp * 8 + k) * MTOT + r0 + row]; s += p.x; q += p.y; }
                  red[(grp * 128 + row) * 2] = s; red[(grp * 128 + row) * 2 + 1] = q; }
                __syncthreads();
                if (tid < 128) { float s = 0.f, q = 0.f;
#pragma unroll
                    for (int k = 0; k < 4; ++k) { s += red[(k * 128 + tid) * 2]; q += red[(k * 128 + tid) * 2 + 1]; }
                    const float mu = s * (1.0f / DA); const float var = q * (1.0f / DA) - mu * mu; st[tid] = mu; st[128 + tid] = 1.0f / sqrtf(var + EPS); }
                const int sq = tid >> 2, spart = tid & 3;
                const bf16* gsrc = P + (size_t)(r0 + sq) * LDP + C_GV + spart * 32;
                v4u gr[4];
#pragma unroll
                for (int j = 0; j < 4; ++j) gr[j] = *(const v4u*)(gsrc + 8 * j);
                for (int head = 0; head < 16; ++head) {
                    const int cc0 = head * 128;
                    int th_ = tid; asm volatile("" : "+v"(th_));
                    const int fr = th_ & 15, g4 = (th_ >> 4) & 3, sq = th_ >> 2, spart = th_ & 3;
                    const bf16* gsrc = P + (size_t)(r0 + sq) * LDP + C_GV + spart * 32;
                    __syncthreads();
#pragma unroll
                    for (int j = 0; j < 4; ++j) *(LAS v4u*)(tile + sq * 288 + spart * 64 + 16 * j) = gr[j];
                    __syncthreads();
                    if (head + 1 < 16) {
#pragma unroll
                        for (int j = 0; j < 4; ++j) gr[j] = *(const v4u*)(gsrc + (cc0 + 128) + 8 * j);
                    }
                    v4u uq[2][2], zq[2][2];
#pragma unroll
                    for (int a2 = 0; a2 < 2; ++a2) { const int c = 64 * wcx + 32 * a2 + 8 * g4;
#pragma unroll
                        for (int pj = 0; pj < 2; ++pj) { const bf16* up = P + (size_t)(r0 + 32 * wp + 16 * pj + fr) * LDP + cc0 + c; uq[a2][pj] = *(const v4u*)(up + C_U); zq[a2][pj] = *(const v4u*)(up + C_ZA); } }
                    bf16x8 wf[2][4]; float av[2], w1v[2], bsv[2];
                    const float* wsrc = w_sp + (size_t)head * 128 * 128;
#pragma unroll
                    for (int pj = 0; pj < 2; ++pj) { const int p = 32 * wp + 16 * pj + fr; float ap = 0.f, w1 = 0.f;
#pragma unroll
                        for (int ks = 0; ks < 4; ++ks) { const int q0 = 32 * ks + 8 * g4;
                            const f32x4 wa = *(const f32x4*)(wsrc + p * 128 + q0), wb = *(const f32x4*)(wsrc + p * 128 + q0 + 4);
                            const f32x4 ra = *(const LAS f32x4*)(st + 128 + q0), rb = *(const LAS f32x4*)(st + 128 + q0 + 4);
                            const f32x4 ma = *(const LAS f32x4*)(st + q0), mb = *(const LAS f32x4*)(st + q0 + 4);
                            const f32x4 sa = wa * ra, sb = wb * rb;
                            ap += (sa.x * ma.x + sa.y * ma.y) + (sa.z * ma.z + sa.w * ma.w) + (sb.x * mb.x + sb.y * mb.y) + (sb.z * mb.z + sb.w * mb.w);
                            w1 += (wa.x + wa.y) + (wa.z + wa.w) + (wb.x + wb.y) + (wb.z + wb.w);
                            v4u pk; pk.x = cvt_pk_bf16(sa.x, sa.y); pk.y = cvt_pk_bf16(sa.z, sa.w); pk.z = cvt_pk_bf16(sb.x, sb.y); pk.w = cvt_pk_bf16(sb.z, sb.w);
                            wf[pj][ks] = __builtin_bit_cast(bf16x8, pk); }
                        ap += __shfl_xor(ap, 16); ap += __shfl_xor(ap, 32); w1 += __shfl_xor(w1, 16); w1 += __shfl_xor(w1, 32);
                        av[pj] = ap; w1v[pj] = w1; bsv[pj] = b_sp[head * 128 + p]; }
                    f32x4 acc[4][2];
#pragma unroll
                    for (int ci = 0; ci < 4; ++ci)
#pragma unroll
                        for (int pj = 0; pj < 2; ++pj) acc[ci][pj] = (f32x4){0.f, 0.f, 0.f, 0.f};
                    const int trq = fr >> 2, trp = fr & 3;
#pragma unroll
                    for (int ci = 0; ci < 4; ++ci)
#pragma unroll
                        for (int ks = 0; ks < 4; ++ks) {
                            typedef short v4s __attribute__((ext_vector_type(4)));
                            const LAS unsigned char* ta = tile + (32 * ks + 8 * g4 + trq) * 288 + (64 * wcx + 32 * (ci >> 1) + 4 * (ci & 1)) * 2 + 16 * trp;
                            const v4s t0 = __builtin_amdgcn_ds_read_tr16_b64_v4i16((LAS v4s*)ta);
                            const v4s t1 = __builtin_amdgcn_ds_read_tr16_b64_v4i16((LAS v4s*)(ta + 4 * 288));
                            const bf16x8 gf = {t0[0], t0[1], t0[2], t0[3], t1[0], t1[1], t1[2], t1[3]};
#pragma unroll
                            for (int pj = 0; pj < 2; ++pj) acc[ci][pj] = __builtin_amdgcn_mfma_f32_16x16x32_bf16(gf, wf[pj][ks], acc[ci][pj], 0, 0, 0);
                        }
#pragma unroll
                    for (int a2 = 0; a2 < 2; ++a2) { const int c = 64 * wcx + 32 * a2 + 8 * g4;
                        const f32x4 gam0 = *(const f32x4*)(ln_g + cc0 + c), bet0 = *(const f32x4*)(ln_b + cc0 + c), gam1 = *(const f32x4*)(ln_g + cc0 + c + 4), bet1 = *(const f32x4*)(ln_b + cc0 + c + 4);
#pragma unroll
                        for (int pj = 0; pj < 2; ++pj) { const int p = 32 * wp + 16 * pj + fr; bf16* up = P + (size_t)(r0 + p) * LDP + cc0 + c;
                            const v4u u4 = uq[a2][pj], z4 = zq[a2][pj];
                            const f32x4 mx0 = gam0 * (acc[2 * a2][pj] - av[pj]) + bet0 * w1v[pj] + bsv[pj], mx1 = gam1 * (acc[2 * a2 + 1][pj] - av[pj]) + bet1 * w1v[pj] + bsv[pj];
                            v4u o; o.x = cvt_pk_bf16(bf_lo(u4.x) * mx0.x * bf_lo(z4.x), bf_hi(u4.x) * mx0.y * bf_hi(z4.x)); o.y = cvt_pk_bf16(bf_lo(u4.y) * mx0.z * bf_lo(z4.y), bf_hi(u4.y) * mx0.w * bf_hi(z4.y));
                            o.z = cvt_pk_bf16(bf_lo(u4.z) * mx1.x * bf_lo(z4.z), bf_hi(u4.z) * mx1.y * bf_hi(z4.z)); o.w = cvt_pk_bf16(bf_lo(u4.w) * mx1.z * bf_lo(z4.w), bf_hi(u4.w) * mx1.w * bf_hi(z4.w));
                            *(v4u*)(up + C_U) = o; } }
                }
                __syncthreads();
            }
            { int gt1 = gt; asm volatile("" : "+v"(gt1));
              s1_items<8>(P, (bf16*)(ws + WS_Z), (const f32x2*)(ws + WS_TW), 0, 8, gt1, NGT);
              int gt2 = gt; asm volatile("" : "+v"(gt2));
              s1_items<16>(P, (bf16*)(ws + WS_Z), (const f32x2*)(ws + WS_TW) + 2048, MPR, 4, gt2, NGT); }
            VM_WAIT(); __syncthreads();
            if (BOTH(pb + 2)) GRID_BAR();
        }

        if (IN(pb + 3)) {
            PHASE_BEGIN();
            OrderD1 S{G, vcu, (const char*)(ws + WS_DC), (const char*)(ws + WS_Z)};
            EpiD1 E{(bf16*)(ws + WS_H)};
            pg8::gemm_phase<EpiD1, OrderD1, PG8_ALIGN, PG8_SP2>(wave0, lds + RING_OFF, 512, 4096, 512, S, E);
            if (BOTH(pb + 3)) GRID_BAR();
        }

        if (IN(pb + 4)) {
            PHASE_BEGIN();
            OrderD2 S{G, vcu, (const char*)(ws + WS_T), (const char*)(ws + WS_H)};
            EpiD2 E{(bf16*)(ws + WS_P)};
            pg8::gemm_phase<EpiD2, OrderD2, PG8_ALIGN, PG8_SP2>(wave0, lds + RING_OFF, 512, 512, 512, S, E);
            if (BOTH(pb + 4)) GRID_BAR();
        }

        if (IN(pb + 5)) {
            PHASE_BEGIN();
            OrderG2 S; S.o.init(MTOT / 256, DM / 256, G, bx, ws + WS_P + (size_t)C_U * 2, (size_t)256 * LDP * 2, ws + WS_WAT, (size_t)256 * DA * 2);
            S.A2 = (const char*)(ws + WS_P + (size_t)C_ZB * 2); S.B2 = (const char*)(ws + WS_WBT);
            Epi2G E{(const bf16*)(ws + WS_P), (bf16*)(ws + WS_H)};
            pg8::gemm_phase<Epi2G, OrderG2, PG8_ALIGN, PG8_SP2>(wave0, lds + RING_OFF, LDP, DA, DA, S, E);
            if (BOTH(pb + 5)) GRID_BAR();
        }

        if (IN(pb + 6)) {
            PHASE_BEGIN();
            pg8::OrderMN S; S.init(MTOT / 256, DM / 256, G, bx, ws + WS_H, (size_t)256 * DM * 2, ws + WS_WOT, (size_t)256 * DM * 2);
            Epi3 E{(bf16*)(ws + WS_X1), (l == 0) ? (float*)(ws + WS_PART) : (float*)nullptr};
            pg8::gemm_phase<Epi3, pg8::OrderMN, PG8_ALIGN, PG8_SP2>(wave0, lds + RING_OFF, DM, DM, DM, S, E);
            if (BOTH(pb + 6)) GRID_BAR();
        }
    }

    if (IN(14)) {
        PHASE_BEGIN();
        const float* final_g = AP->in[12];
        const bf16* X2 = (const bf16*)(ws + WS_X1);
        f32x4 g8[8][2];
#pragma unroll
        for (int j = 0; j < 8; ++j) { g8[j][0] = ((const GAS f32x4*)final_g)[2 * (lane + 64 * j)]; g8[j][1] = ((const GAS f32x4*)final_g)[2 * (lane + 64 * j) + 1]; }
        for (int m = gw; m < MTOT; m += NGW) rms_row_bf16_to_f32(X2 + (size_t)m * DM, g8, out + (size_t)m * DM, lane);
    }
#undef IN
#undef BOTH
}

extern "C" void kernel_launch(void* const* d_in, const int* in_sizes, int n_in, void* d_out, int out_size, void* d_ws, size_t ws_size, hipStream_t stream) {
    static int grid = 0;
    if (grid == 0) {
        if (n_in != 13 || out_size != MTOT * DM || ws_size < WS_END) { fprintf(stderr, "kernel_launch: unexpected shapes (n_in %d out %d ws %zu); nothing launched\n", n_in, out_size, ws_size); grid = -1; return; }
        int dev = 0, cus = 0, per_cu = 0;
        if (hipGetDevice(&dev) != hipSuccess || hipDeviceGetAttribute(&cus, hipDeviceAttributeMultiprocessorCount, dev) != hipSuccess) { grid = -1; return; }
        if (hipFuncSetAttribute((const void*)trunk_fwd, hipFuncAttributeMaxDynamicSharedMemorySize, LDS_BYTES) != hipSuccess) { fprintf(stderr, "kernel_launch: hipFuncSetAttribute failed\n"); grid = -1; return; }
        if (hipOccupancyMaxActiveBlocksPerMultiprocessor(&per_cu, (const void*)trunk_fwd, NWAVES * 64, LDS_BYTES) != hipSuccess || per_cu < 1)
            fprintf(stderr, "kernel_launch: note: occupancy query reports %d workgroups per CU\n", per_cu);
        (void)hipGetLastError();
        grid = cus;
    }
    if (grid < 0) return;
    if (hipMemsetAsync((char*)d_ws + WS_CTL, 0, CTL_ZERO_BYTES, stream) != hipSuccess) return;
    Args a{};
    for (int i = 0; i < 13; ++i) a.in[i] = (const float*)d_in[i];
    a.out = (float*)d_out; a.ws = (unsigned char*)d_ws;
#if MK_PER_PHASE
    for (int p = 0; p < N_PHASES; ++p) { a.ph_lo = p; a.ph_hi = p + 1; a.li = p;
        hipLaunchKernelGGL(trunk_fwd, dim3(grid), dim3(NWAVES * 64), LDS_BYTES, stream, a); }
#else
    a.ph_lo = 0; a.ph_hi = N_PHASES; a.li = 0;
    hipLaunchKernelGGL(trunk_fwd, dim3(grid), dim3(NWAVES * 64), LDS_BYTES, stream, a);
#endif
}
```

```cpp
#include <hip/hip_runtime.h>
#include <cstdio>
#include <cstdint>

#ifndef MK_PER_PHASE
#define MK_PER_PHASE 0
#endif

#define GAS __attribute__((address_space(1)))
#define LAS __attribute__((address_space(3)))
typedef unsigned short bf16;
typedef unsigned v4u __attribute__((ext_vector_type(4)));
typedef unsigned v2u __attribute__((ext_vector_type(2)));
typedef float f32x4 __attribute__((ext_vector_type(4)));
typedef float f32x2 __attribute__((ext_vector_type(2)));
typedef short bf16x8 __attribute__((ext_vector_type(8)));
typedef GAS unsigned gu32;

constexpr int DM = 4096, DIN = 18432, DA = 2048, DB = 2048;
constexpr int MPR = 16384;
constexpr int MTOT = 32768;
constexpr int LDP = DIN;
constexpr int C_U = 0, C_GV = 2048, C_ZA = 4096, C_XB = 6144, C_ZB = 8192, C_GA = 10240, C_GB = 14336;
constexpr float EPS = 1e-6f;
constexpr int NWAVES = 8;
constexpr int N_PHASES = 15;

constexpr size_t MiB = 1u << 20;
constexpr size_t WS_CTL = 0, CTL_ZERO_BYTES = 32768;
constexpr size_t WS_W1T = 1 * MiB;
constexpr size_t WS_WAT = 145 * MiB;
constexpr size_t WS_WBT = 161 * MiB;
constexpr size_t WS_WOT = 177 * MiB;
constexpr size_t WS_DC = 210 * MiB;
constexpr size_t WS_TW = 212 * MiB;
constexpr size_t WS_T = 211 * MiB;
constexpr size_t WS_RSTD = 213 * MiB;
constexpr size_t WS_WSP = 214 * MiB;
constexpr size_t WS_PART = 291 * MiB;
constexpr size_t WS_H = 300 * MiB;
constexpr size_t WS_P = 556 * MiB;
constexpr size_t WS_Z = 1708 * MiB;
constexpr size_t WS_X1 = 1964 * MiB;
constexpr size_t WS_END = 2220 * MiB;
constexpr int CW_BAR = 4096;

constexpr int RING_OFF = 0, RING_BYTES = 131072;
constexpr int LDSCTL_OFF = RING_BYTES, MISC_OFF = LDSCTL_OFF + 320;
constexpr int STAT_OFF = RING_BYTES + 1024;
constexpr int RS_OFF = RING_BYTES + 4096;
constexpr int LDS_BYTES = 147456;

#define RLX_AGENT __ATOMIC_RELAXED, __HIP_MEMORY_SCOPE_AGENT
#define LDS_WAIT() asm volatile("s_waitcnt lgkmcnt(0)" ::: "memory")
#define VM_WAIT() asm volatile("s_waitcnt vmcnt(0)" ::: "memory")

typedef __bf16 bf16x2_t __attribute__((ext_vector_type(2)));
__device__ __forceinline__ unsigned cvt_pk_bf16(float lo, float hi) { const f32x2 v = {lo, hi}; const bf16x2_t b = __builtin_convertvector(v, bf16x2_t); return __builtin_bit_cast(unsigned, b); }
__device__ __forceinline__ int lane_id() { return (int)__builtin_amdgcn_mbcnt_hi(~0u, __builtin_amdgcn_mbcnt_lo(~0u, 0u)); }
__device__ __forceinline__ float bf_lo(unsigned w) { return __builtin_bit_cast(float, w << 16); }
__device__ __forceinline__ float bf_hi(unsigned w) { return __builtin_bit_cast(float, w & 0xffff0000u); }
__device__ __forceinline__ float bf2f(bf16 b) { return __builtin_bit_cast(float, ((unsigned)b) << 16); }
__device__ __forceinline__ unsigned f2bf(float f) { unsigned u = __builtin_bit_cast(unsigned, f); return (u + 0x7fffu + ((u >> 16) & 1u)) >> 16; }
__device__ __forceinline__ unsigned pk2(float lo, float hi) { return f2bf(lo) | (f2bf(hi) << 16); }

namespace pg8 {
constexpr int BM = 256, BK = 64, HALF = 128, HTB = HALF * BK * 2, STAGE_BYTES = 8 * HTB, NXCD = 8, WGM = 8;
__host__ __device__ __forceinline__ int lds_byte(int r, int c) { const int st = (r >> 4) * 2 + (c >> 5), rr = r & 15, cc = c & 31, ob = rr * 64 + cc * 2; return st * 1024 + (ob ^ (((ob >> 9) & 1) << 5)); }
__host__ __device__ __forceinline__ void stage_rc(int b, int& R, int& C) { const int st = b / 1024, sb = b % 1024, swz = sb ^ (((sb >> 9) & 1) << 5); R = (st >> 1) * 16 + swz / 64; C = (st & 1) * 32 + (swz % 64) / 2; }
__host__ __device__ __forceinline__ int perm32(int rho) { const int n = rho >> 4, i = rho & 15; return 8 * (i >> 2) + 4 * n + (i & 3); }

struct Unit { const char* a; const char* b; int pm, pn, aux; };

struct OrderMN {
    int nM, nN, nwg, G, c; const char* A; const char* B; size_t tA, tB;
    __device__ __forceinline__ void init(int nM_, int nN_, int G_, int c_, const void* A_, size_t tA_, const void* B_, size_t tB_) { nM = nM_; nN = nN_; nwg = nM * nN; G = G_; c = c_; A = (const char*)A_; B = (const char*)B_; tA = tA_; tB = tB_; }
    __device__ __forceinline__ bool next(int i, Unit& u) const {
        const long L = (long)i * G + c; if (L >= nwg) return false;
        int wgid = (int)L; { const int q = nwg / NXCD, r = nwg % NXCD, xcd = wgid % NXCD, off = wgid / NXCD; wgid = (xcd < r ? xcd * (q + 1) : r * (q + 1) + (xcd - r) * q) + off; }
        const int nig = WGM * nN, gid = wgid / nig, fm = gid * WGM, gsz = (nM - fm) < WGM ? (nM - fm) : WGM;
        u.pm = fm + ((wgid % nig) % gsz); u.pn = (wgid % nig) / gsz; u.aux = 0;
        u.a = A + (size_t)u.pm * tA; u.b = B + (size_t)u.pn * tB; return true;
    }
    __device__ __forceinline__ void a_ready(const Unit&) const {}
    __device__ __forceinline__ void done(const Unit&) const {}
};

template <class Epi, class Sched, bool ALIGN_EPI, bool SP2>
__device__ __forceinline__ void gemm_phase(const int ws_, LAS unsigned char* lds, const int lda, const int ldb, const int K, const Sched& S, const Epi& E) {
    int tid_ = (ws_ << 6) | lane_id(); asm volatile("" : "+v"(tid_));
    const int tid = tid_, wid = __builtin_amdgcn_readfirstlane(tid >> 6), lane = tid & 63, wr = wid >> 2, wc = wid & 3, fr = lane & 15, fq = lane >> 4;
    const int nt = K / BK;
    unsigned voffA[2], voffB[2];
#pragma unroll
    for (int i = 0; i < 2; ++i) { int R, C; stage_rc(tid * 16 + i * 8192, R, C); const int Rb = Epi::PERM ? ((R & ~31) + perm32(R & 31)) : R;
        voffA[i] = (unsigned)(R * lda + C) * 2u; voffB[i] = (unsigned)(Rb * ldb + C) * 2u; }
    const size_t kstep = (size_t)(BK * 2);
    const size_t hstepA = (size_t)HALF * lda * 2, hstepB = (size_t)HALF * ldb * 2;
    const unsigned ldsw = (unsigned)wid * 1024u;
    const int aoff = lds_byte(wr * 64 + fr, fq * 8), boff = lds_byte(wc * 32 + fr, fq * 8);
#define PG8_SA(b, h) (((b) * 2 + (h)) * HTB)
#define PG8_SB(b, h) ((4 + (b) * 2 + (h)) * HTB)
#define PG8_STAGE(bufoff, gbase, voff) do { _Pragma("unroll") for (int _i = 0; _i < 2; ++_i) \
        __builtin_amdgcn_global_load_lds((const unsigned*)((const char*)(gbase) + (voff)[_i]), (LAS unsigned*)(lds + (bufoff) + ldsw + _i * 8192), 16, 0, 0); } while (0)
#define PG8_LDA(dst, b, h) do { _Pragma("unroll") for (int m = 0; m < 4; ++m) _Pragma("unroll") for (int k = 0; k < 2; ++k) dst[m][k] = *(const LAS bf16x8*)(lds + PG8_SA(b, h) + aoff + m * 2048 + k * 1024); } while (0)
#define PG8_LDB(dst, b, h) do { _Pragma("unroll") for (int n = 0; n < 2; ++n) _Pragma("unroll") for (int k = 0; k < 2; ++k) dst[n][k] = *(const LAS bf16x8*)(lds + PG8_SB(b, h) + boff + n * 2048 + k * 1024); } while (0)
#define PG8_MMA(ai, bj, At, Bt) do { __builtin_amdgcn_s_setprio(1); _Pragma("unroll") for (int m = 0; m < 4; ++m) _Pragma("unroll") for (int n = 0; n < 2; ++n) _Pragma("unroll") for (int k = 0; k < 2; ++k) \
        acc[ai][bj][m][n] = __builtin_amdgcn_mfma_f32_16x16x32_bf16(Bt[n][k], At[m][k], acc[ai][bj][m][n], 0, 0, 0); __builtin_amdgcn_s_setprio(0); } while (0)
#define PG8_WAIT_V(n) asm volatile("s_waitcnt vmcnt(" #n ")" ::: "memory")
#define PG8_WAIT_L(n) asm volatile("s_waitcnt lgkmcnt(" #n ")" ::: "memory")
#define PG8_BAR __builtin_amdgcn_s_barrier()
#define PG8_SCHED __builtin_amdgcn_sched_barrier(0)
    Unit cur, nxt; int ui = 0;
    if (!S.next(0, cur)) return;
    float carry = 0.f;
    if constexpr (Epi::CARRY) carry = E.pre(cur, tid);
    f32x4 acc[2][2][4][2];
#pragma unroll
    for (int a = 0; a < 2; ++a)
#pragma unroll
        for (int b = 0; b < 2; ++b)
#pragma unroll
            for (int m = 0; m < 4; ++m)
#pragma unroll
                for (int n = 0; n < 2; ++n) acc[a][b][m][n] = (f32x4){0.f, 0.f, 0.f, 0.f};
    bf16x8 At[4][2], B0[2][2], B1[2][2];
    const char* cA = cur.a; const char* cB = cur.b;
    S.a_ready(cur);
    if constexpr (SP2) {
        PG8_STAGE(PG8_SB(0, 0), cB, voffB); PG8_STAGE(PG8_SB(0, 1), cB + hstepB, voffB); PG8_STAGE(PG8_SA(0, 0), cA, voffA); PG8_STAGE(PG8_SA(0, 1), cA + hstepA, voffA);
        if (wr == 1) PG8_BAR;
        PG8_WAIT_V(2); PG8_BAR;
        PG8_STAGE(PG8_SB(1, 0), cB + kstep, voffB); PG8_STAGE(PG8_SA(1, 0), cA + kstep, voffA); PG8_STAGE(PG8_SB(1, 1), cB + hstepB + kstep, voffB);
        PG8_WAIT_V(6); PG8_BAR;
    } else {
        PG8_STAGE(PG8_SB(0, 0), cB, voffB); PG8_STAGE(PG8_SA(0, 0), cA, voffA); PG8_STAGE(PG8_SB(0, 1), cB + hstepB, voffB); PG8_STAGE(PG8_SA(0, 1), cA + hstepA, voffA);
        if (wr == 1) PG8_BAR;
        PG8_WAIT_V(4); PG8_BAR;
        PG8_STAGE(PG8_SB(1, 0), cB + kstep, voffB); PG8_STAGE(PG8_SA(1, 0), cA + kstep, voffA); PG8_STAGE(PG8_SB(1, 1), cB + hstepB + kstep, voffB);
        PG8_WAIT_V(6); PG8_BAR;
    }
    for (;;) {
        const bool has_next = S.next(ui + 1, nxt);
        const char* nA = has_next ? nxt.a : cA; const char* nB = has_next ? nxt.b : cB;
        asm volatile(".p2align 8" ::: "memory");
        for (int t = 0; t < nt; t += 2) {
            const bool last = (t == nt - 2);
            const char* a1 = cA + (size_t)(t + 1) * kstep;
            const char* a2 = last ? nA : cA + (size_t)(t + 2) * kstep; const char* b2 = last ? nB : cB + (size_t)(t + 2) * kstep;
            const char* a3 = a2 + kstep; const char* b3 = b2 + kstep;
            if (last && has_next) S.a_ready(nxt);
            if constexpr (SP2) {
            PG8_LDB(B0, 0, 0); PG8_LDB(B1, 0, 1); PG8_SCHED; PG8_LDA(At, 0, 0); PG8_STAGE(PG8_SA(1, 1), a1 + hstepA, voffA);
            PG8_WAIT_V(8); PG8_WAIT_L(0); PG8_BAR; PG8_MMA(0, 0, At, B0); PG8_MMA(0, 1, At, B1); PG8_BAR; PG8_SCHED;
            PG8_LDA(At, 0, 1); PG8_STAGE(PG8_SB(0, 0), b2, voffB); PG8_STAGE(PG8_SB(0, 1), b2 + hstepB, voffB); PG8_STAGE(PG8_SA(0, 0), a2, voffA);
            PG8_WAIT_V(8); PG8_WAIT_L(0); PG8_BAR; PG8_MMA(1, 0, At, B0); PG8_MMA(1, 1, At, B1); PG8_BAR; PG8_SCHED;
            PG8_LDB(B0, 1, 0); PG8_LDB(B1, 1, 1); PG8_SCHED; PG8_LDA(At, 1, 0); PG8_STAGE(PG8_SA(0, 1), a2 + hstepA, voffA);
            PG8_WAIT_V(8); PG8_WAIT_L(0); PG8_BAR; PG8_MMA(0, 0, At, B0); PG8_MMA(0, 1, At, B1); PG8_BAR; PG8_SCHED;
            PG8_LDA(At, 1, 1); PG8_STAGE(PG8_SB(1, 0), b3, voffB); PG8_STAGE(PG8_SB(1, 1), b3 + hstepB, voffB); PG8_STAGE(PG8_SA(1, 0), a3, voffA);
            PG8_WAIT_V(8); PG8_WAIT_L(0); PG8_BAR; PG8_MMA(1, 0, At, B0); PG8_MMA(1, 1, At, B1); PG8_BAR; PG8_SCHED;
            } else {
            PG8_LDB(B0, 0, 0); PG8_SCHED; PG8_LDA(At, 0, 0); PG8_STAGE(PG8_SA(1, 1), a1 + hstepA, voffA);
            PG8_WAIT_L(8); PG8_BAR; PG8_WAIT_L(0); PG8_MMA(0, 0, At, B0); PG8_BAR; PG8_SCHED;
            PG8_LDB(B1, 0, 1); PG8_STAGE(PG8_SB(0, 0), b2, voffB);
            PG8_BAR; PG8_WAIT_L(0); PG8_MMA(0, 1, At, B1); PG8_BAR;
            PG8_LDA(At, 0, 1); PG8_STAGE(PG8_SA(0, 0), a2, voffA);
            PG8_BAR; PG8_WAIT_L(0); PG8_MMA(1, 0, At, B0); PG8_BAR; PG8_SCHED;
            PG8_STAGE(PG8_SB(0, 1), b2 + hstepB, voffB);
            PG8_WAIT_V(6); PG8_BAR; PG8_MMA(1, 1, At, B1); PG8_BAR;
            PG8_LDB(B0, 1, 0); PG8_SCHED; PG8_LDA(At, 1, 0); PG8_STAGE(PG8_SA(0, 1), a2 + hstepA, voffA);
            PG8_WAIT_L(8); PG8_BAR; PG8_WAIT_L(0); PG8_MMA(0, 0, At, B0); PG8_BAR; PG8_SCHED;
            PG8_LDB(B1, 1, 1); PG8_STAGE(PG8_SB(1, 0), b3, voffB);
            PG8_BAR; PG8_WAIT_L(0); PG8_MMA(0, 1, At, B1); PG8_BAR;
            PG8_LDA(At, 1, 1); PG8_STAGE(PG8_SA(1, 0), a3, voffA);
            PG8_BAR; PG8_WAIT_L(0); PG8_MMA(1, 0, At, B0); PG8_BAR; PG8_SCHED;
            PG8_STAGE(PG8_SB(1, 1), b3 + hstepB, voffB);
            PG8_WAIT_V(6); PG8_BAR; PG8_MMA(1, 1, At, B1); PG8_BAR;
            }
        }
        if constexpr (ALIGN_EPI) { if (wr == 0) PG8_BAR; }
        { int l2 = lane_id(); asm volatile("" : "+v"(l2));
          if constexpr (Epi::CARRY) { E(acc, cur, wr, wc, l2 & 15, l2 >> 4, carry, (wid << 6) | l2); if (has_next) carry = E.pre(nxt, (wid << 6) | l2); }
          else E(acc, cur, wr, wc, l2 & 15, l2 >> 4); }
        S.done(cur);
        if (!has_next) break;
        bool zero_acc = true;
        if constexpr (Epi::KEEP) zero_acc = !E.keep(cur);
        if (zero_acc) {
#pragma unroll
        for (int a = 0; a < 2; ++a)
#pragma unroll
            for (int b = 0; b < 2; ++b)
#pragma unroll
                for (int m = 0; m < 4; ++m)
#pragma unroll
                    for (int n = 0; n < 2; ++n) acc[a][b][m][n] = (f32x4){0.f, 0.f, 0.f, 0.f};
        }
        cur = nxt; cA = nA; cB = nB; ++ui;
        if constexpr (ALIGN_EPI) { if (wr == 1) PG8_BAR; }
    }
    PG8_WAIT_V(0);
    if constexpr (!ALIGN_EPI) { if (wr == 0) PG8_BAR; }
    PG8_BAR;
#undef PG8_SA
#undef PG8_SB
#undef PG8_STAGE
#undef PG8_LDA
#undef PG8_LDB
#undef PG8_MMA
#undef PG8_WAIT_V
#undef PG8_WAIT_L
#undef PG8_BAR
#undef PG8_SCHED
}
}

#ifndef PG8_SP2
#define PG8_SP2 true
#endif
#ifndef PG8_ALIGN
#define PG8_ALIGN true
#endif
using pg8::Unit;
typedef const f32x4 (&AccRef)[2][2][4][2];
typedef f32x4 (&AccMut)[2][2][4][2];

__device__ __forceinline__ float act_one(float x, float c1, float c3, float off, bool mulx) {
    const float t = fmaf(x, fmaf(c3, x * x, c1), off);
    const float e = __builtin_amdgcn_exp2f(t * -1.4426950408889634f);
    const float sg = __builtin_amdgcn_rcpf(1.0f + e);
    return (mulx ? x : 1.0f) * sg;
}
template <bool SCALE> __device__ __forceinline__ void epi1_gate(AccRef acc, bf16* P, const float* bgate, const LAS float* rs, int pm, int t, int wr, int wc, int fr, int fq) {
    const int row0 = pm * 256 + wr * 64 + fr, cw = t * 128 + wc * 32 + 8 * fq;
    float rsv[2][4];
#pragma unroll
    for (int ai = 0; ai < 2; ++ai)
#pragma unroll
        for (int m = 0; m < 4; ++m) rsv[ai][m] = SCALE ? rs[wr * 64 + fr + ai * 128 + m * 16] : 1.0f;
    f32x4 ba[2], bb[2];
#pragma unroll
    for (int n = 0; n < 2; ++n) { ba[n] = *(const f32x4*)(bgate + cw + 4 * n) * -1.4426950408889634f; bb[n] = *(const f32x4*)(bgate + DM + cw + 4 * n) * -1.4426950408889634f; }
#pragma unroll
    for (int ai = 0; ai < 2; ++ai)
#pragma unroll
        for (int m = 0; m < 4; ++m) {
            const int row = row0 + ai * 128 + m * 16; bf16* rowp = P + (size_t)row * LDP + cw;
            float orr[8], og[8];
#pragma unroll
            for (int n = 0; n < 2; ++n)
#pragma unroll
                for (int j = 0; j < 4; ++j) { const float xa = SCALE ? acc[ai][0][m][n][j] * rsv[ai][m] : acc[ai][0][m][n][j], xb = SCALE ? acc[ai][1][m][n][j] * rsv[ai][m] : acc[ai][1][m][n][j];
                    const float da = 1.0f + __builtin_amdgcn_exp2f(fmaf(xa, -1.4426950408889634f, ba[n][j]));
                    const float db = 1.0f + __builtin_amdgcn_exp2f(fminf(fmaf(xb, -1.4426950408889634f, bb[n][j]), 64.0f));
                    og[4 * n + j] = __builtin_amdgcn_rcpf(db); orr[4 * n + j] = db * __builtin_amdgcn_rcpf(da); }
            v4u w; w.x = cvt_pk_bf16(orr[0], orr[1]); w.y = cvt_pk_bf16(orr[2], orr[3]); w.z = cvt_pk_bf16(orr[4], orr[5]); w.w = cvt_pk_bf16(orr[6], orr[7]);
            *(v4u*)(rowp + C_GA) = w;
            v4u g; g.x = cvt_pk_bf16(og[0], og[1]); g.y = cvt_pk_bf16(og[2], og[3]); g.z = cvt_pk_bf16(og[4], og[5]); g.w = cvt_pk_bf16(og[6], og[7]);
            *(v4u*)(rowp + C_GB) = g;
        }
}
template <int MODE, bool STATS, bool SCALE> __device__ __forceinline__ void epi1_body(AccRef acc, bf16* P, const float* bgate, f32x2* part, const LAS float* rs, int pm, int pn, int wr, int wc, int fr, int fq) {
    const int row0 = pm * 256 + wr * 64 + fr, col0 = pn * 256 + wc * 32 + 8 * fq;
    float rsv[2][4];
#pragma unroll
    for (int ai = 0; ai < 2; ++ai)
#pragma unroll
        for (int m = 0; m < 4; ++m) rsv[ai][m] = SCALE ? rs[wr * 64 + fr + ai * 128 + m * 16] : 1.0f;
    f32x4 bv[2][2];
    if (MODE == 3) {
#pragma unroll
        for (int bj = 0; bj < 2; ++bj)
#pragma unroll
            for (int n = 0; n < 2; ++n) bv[bj][n] = *(const f32x4*)(bgate + (col0 - C_GA) + bj * 128 + 4 * n) * -1.4426950408889634f;
    }
#pragma unroll
    for (int ai = 0; ai < 2; ++ai)
#pragma unroll
        for (int m = 0; m < 4; ++m) {
            const int row = row0 + ai * 128 + m * 16; bf16* rowp = P + (size_t)row * LDP + col0; float rs = 0.f, rq = 0.f;
#pragma unroll
            for (int bj = 0; bj < 2; ++bj) {
                float o[8];
#pragma unroll
                for (int n = 0; n < 2; ++n)
#pragma unroll
                    for (int j = 0; j < 4; ++j) { const float x = SCALE ? acc[ai][bj][m][n][j] * rsv[ai][m] : acc[ai][bj][m][n][j]; float r;
                        if (MODE == 0) { const float t = x * fmaf(-0.10294324576f, x * x, -2.3022081985f); r = x * __builtin_amdgcn_rcpf(1.0f + __builtin_amdgcn_exp2f(t)); }
                        else if (MODE == 1) { r = x * __builtin_amdgcn_rcpf(1.0f + __builtin_amdgcn_exp2f(x * -1.4426950408889634f)); }
                        else if (MODE == 2) { r = x; }
                        else { r = __builtin_amdgcn_rcpf(1.0f + __builtin_amdgcn_exp2f(fmaf(x, -1.4426950408889634f, bv[bj][n][j]))); }
                        o[4 * n + j] = r; if (STATS) { rs += r; rq += r * r; } }
                v4u w; w.x = cvt_pk_bf16(o[0], o[1]); w.y = cvt_pk_bf16(o[2], o[3]); w.z = cvt_pk_bf16(o[4], o[5]); w.w = cvt_pk_bf16(o[6], o[7]);
                *(v4u*)(rowp + bj * 128) = w;
            }
            if (STATS) { rs += __shfl_xor(rs, 16); rs += __shfl_xor(rs, 32); rq += __shfl_xor(rq, 16); rq += __shfl_xor(rq, 32);
                if (fq == 0) part[(size_t)((pn - 8) * 4 + wc) * MTOT + row] = (f32x2){rs, rq}; }
        }
}
template <bool SCALE> struct Epi1 {
    static constexpr bool PERM = true; static constexpr bool KEEP = false; static constexpr bool CARRY = SCALE;
    bf16* P; const float* bgate; f32x2* part; const float* rs; LAS float* rsl;
    __device__ __forceinline__ float pre(const Unit& u, int tid) const { return rs[u.pm * 256 + (tid & 255)]; }
    __device__ __forceinline__ void body(AccRef acc, const Unit& u, int wr, int wc, int fr, int fq) const {
        const int pn = u.pn;
        if (pn < 8) epi1_body<0, false, SCALE>(acc, P, bgate, part, rsl, u.pm, pn, wr, wc, fr, fq);
        else if (pn < 16) epi1_body<0, true, SCALE>(acc, P, bgate, part, rsl, u.pm, pn, wr, wc, fr, fq);
        else if (pn >= 40) epi1_gate<SCALE>(acc, P, bgate, rsl, u.pm, pn - 40, wr, wc, fr, fq);
        else if (pn >= 24 && pn < 32) epi1_body<2, false, SCALE>(acc, P, bgate, part, rsl, u.pm, pn, wr, wc, fr, fq);
        else epi1_body<1, false, SCALE>(acc, P, bgate, part, rsl, u.pm, pn, wr, wc, fr, fq);
    }
    __device__ __forceinline__ void operator()(AccRef acc, const Unit& u, int wr, int wc, int fr, int fq) const { body(acc, u, wr, wc, fr, fq); }
    __device__ __forceinline__ void operator()(AccRef acc, const Unit& u, int wr, int wc, int fr, int fq, float carry, int tid) const {
        if (tid < 256) rsl[tid] = carry;
        asm volatile("s_waitcnt lgkmcnt(0)" ::: "memory"); __builtin_amdgcn_s_barrier();
        body(acc, u, wr, wc, fr, fq);
    }
};
struct EpiD1 {
    static constexpr bool PERM = true; static constexpr bool KEEP = false; static constexpr bool CARRY = false;
    bf16* YT;
    __device__ __forceinline__ void operator()(AccRef acc, const Unit& u, int wr, int wc, int fr, int fq) const {
        bf16* o0 = YT + ((size_t)u.pn * 2048 + (size_t)(u.aux * 256 + wr * 64 + fr)) * 512 + u.pm * 256 + wc * 32 + 8 * fq;
#pragma unroll
        for (int ai = 0; ai < 2; ++ai)
#pragma unroll
            for (int m = 0; m < 4; ++m) { bf16* rowp = o0 + (size_t)(ai * 128 + m * 16) * 512;
#pragma unroll
                for (int bj = 0; bj < 2; ++bj) { const f32x4 v0 = acc[ai][bj][m][0] * 0.0625f, v1 = acc[ai][bj][m][1] * 0.0625f;
                    v4u w; w.x = cvt_pk_bf16(v0[0], v0[1]); w.y = cvt_pk_bf16(v0[2], v0[3]); w.z = cvt_pk_bf16(v1[0], v1[1]); w.w = cvt_pk_bf16(v1[2], v1[3]);
                    *(v4u*)(rowp + bj * 128) = w; } }
    }
};
struct EpiD2 {
    static constexpr bool PERM = true; static constexpr bool KEEP = false; static constexpr bool CARRY = false;
    bf16* P;
    __device__ __forceinline__ void operator()(AccRef acc, const Unit& u, int wr, int wc, int fr, int fq) const {
        const int rt = u.aux; int tok0, N1;
        if (rt < 64) { N1 = 8; tok0 = (rt >> 3) * 2048 + (rt & 7); } else { N1 = 16; tok0 = MPR + ((rt - 64) >> 4) * 4096 + ((rt - 64) & 15); }
        const float scale = 0.0625f;
        const size_t rstride = (size_t)N1 * LDP;
        const bf16* Pb = P + (size_t)(tok0 + N1 * (wr * 64 + fr)) * LDP + C_ZB + u.pn * 256 + wc * 32 + 8 * fq;
        v4u z[2][4][2];
#pragma unroll
        for (int ai = 0; ai < 2; ++ai)
#pragma unroll
            for (int m = 0; m < 4; ++m)
#pragma unroll
                for (int bj = 0; bj < 2; ++bj) z[ai][m][bj] = *(const v4u*)(Pb + (size_t)(ai * 128 + m * 16) * rstride + bj * 128);
        asm volatile("" ::: "memory");
#pragma unroll
        for (int ai = 0; ai < 2; ++ai)
#pragma unroll
            for (int m = 0; m < 4; ++m) { bf16* rowp = (bf16*)Pb + (size_t)(ai * 128 + m * 16) * rstride;
#pragma unroll
                for (int bj = 0; bj < 2; ++bj) { const v4u zz = z[ai][m][bj]; const f32x4 v0 = acc[ai][bj][m][0] * scale, v1 = acc[ai][bj][m][1] * scale;
                    v4u w; w.x = cvt_pk_bf16(v0[0] * bf_lo(zz.x), v0[1] * bf_hi(zz.x)); w.y = cvt_pk_bf16(v0[2] * bf_lo(zz.y), v0[3] * bf_hi(zz.y));
                    w.z = cvt_pk_bf16(v1[0] * bf_lo(zz.z), v1[1] * bf_hi(zz.z)); w.w = cvt_pk_bf16(v1[2] * bf_lo(zz.w), v1[3] * bf_hi(zz.w));
                    *(v4u*)(rowp + bj * 128) = w; } }
        asm volatile("" ::: "memory");
    }
};
struct OrderG2 {
    pg8::OrderMN o; const char* A2; const char* B2;
    __device__ __forceinline__ bool next(int i, Unit& u) const {
        if (!o.next(i >> 1, u)) return false;
        u.aux = i & 1; if (u.aux) { u.a = A2 + (size_t)u.pm * o.tA; u.b = B2 + (size_t)u.pn * o.tB; } return true; }
    __device__ __forceinline__ void a_ready(const Unit&) const {}
    __device__ __forceinline__ void done(const Unit&) const {}
};
struct Epi2G {
    static constexpr bool PERM = true; static constexpr bool KEEP = true; static constexpr bool CARRY = false;
    const bf16* P; bf16* Mb;
    __device__ __forceinline__ bool keep(const Unit& u) const { return u.aux == 0; }
    __device__ __forceinline__ void operator()(AccMut acc, const Unit& u, int wr, int wc, int fr, int fq) const {
        const int row0 = u.pm * 256 + wr * 64 + fr, col0 = u.pn * 256 + wc * 32 + 8 * fq;
        const bf16* gp = P + (size_t)row0 * LDP + (u.aux ? C_GB : C_GA) + col0;
        v4u g[2][4][2];
#pragma unroll
        for (int ai = 0; ai < 2; ++ai)
#pragma unroll
            for (int m = 0; m < 4; ++m)
#pragma unroll
                for (int bj = 0; bj < 2; ++bj) g[ai][m][bj] = *(const v4u*)(gp + (size_t)(ai * 128 + m * 16) * LDP + bj * 128);
        asm volatile("" ::: "memory");
        if (u.aux == 0) {
#pragma unroll
            for (int ai = 0; ai < 2; ++ai)
#pragma unroll
                for (int m = 0; m < 4; ++m)
#pragma unroll
                    for (int bj = 0; bj < 2; ++bj) { v4u gg = g[ai][m][bj]; asm volatile("" : "+v"(gg.x), "+v"(gg.y), "+v"(gg.z), "+v"(gg.w));
                        acc[ai][bj][m][0] *= (f32x4){bf_lo(gg.x), bf_hi(gg.x), bf_lo(gg.y), bf_hi(gg.y)}; acc[ai][bj][m][1] *= (f32x4){bf_lo(gg.z), bf_hi(gg.z), bf_lo(gg.w), bf_hi(gg.w)}; }
        } else {
#pragma unroll
            for (int ai = 0; ai < 2; ++ai)
#pragma unroll
                for (int m = 0; m < 4; ++m) { bf16* op = Mb + (size_t)(row0 + ai * 128 + m * 16) * DM + col0;
#pragma unroll
                    for (int bj = 0; bj < 2; ++bj) { v4u gg = g[ai][m][bj]; asm volatile("" : "+v"(gg.x), "+v"(gg.y), "+v"(gg.z), "+v"(gg.w)); const f32x4 a0 = acc[ai][bj][m][0], a1 = acc[ai][bj][m][1];
                        v4u w; w.x = cvt_pk_bf16(a0[0] * bf_lo(gg.x), a0[1] * bf_hi(gg.x)); w.y = cvt_pk_bf16(a0[2] * bf_lo(gg.y), a0[3] * bf_hi(gg.y));
                        w.z = cvt_pk_bf16(a1[0] * bf_lo(gg.z), a1[1] * bf_hi(gg.z)); w.w = cvt_pk_bf16(a1[2] * bf_lo(gg.w), a1[3] * bf_hi(gg.w));
                        *(v4u*)(op + bj * 128) = w; } }
            asm volatile("" ::: "memory");
        }
    }
};
struct Epi3 {
    static constexpr bool PERM = true; static constexpr bool KEEP = false; static constexpr bool CARRY = false;
    bf16* x1; float* ss;
    __device__ __forceinline__ void operator()(AccRef acc, const Unit& u, int wr, int wc, int fr, int fq) const {
        const int rt = u.pm * 256;
        const int r0 = wr * 64 + fr, col0 = u.pn * 256 + wc * 32 + 8 * fq;
        bf16* xh = x1 + (size_t)rt * DM;
        const bool want = (ss != nullptr);
        v4u xw[2][4][2];
#pragma unroll
        for (int ai = 0; ai < 2; ++ai)
#pragma unroll
            for (int m = 0; m < 4; ++m)
#pragma unroll
                for (int bj = 0; bj < 2; ++bj) xw[ai][m][bj] = *(const v4u*)(xh + (size_t)(r0 + ai * 128 + m * 16) * DM + col0 + bj * 128);
        asm volatile("" ::: "memory");
#pragma unroll
        for (int ai = 0; ai < 2; ++ai)
#pragma unroll
            for (int m = 0; m < 4; ++m) { float q = 0.f; int rr = r0 + ai * 128 + m * 16; asm volatile("" : "+v"(rr));
#pragma unroll
                for (int bj = 0; bj < 2; ++bj) { v4u w = xw[ai][m][bj]; asm volatile("" : "+v"(w.x), "+v"(w.y), "+v"(w.z), "+v"(w.w));
                    const f32x4 v0 = (f32x4){bf_lo(w.x), bf_hi(w.x), bf_lo(w.y), bf_hi(w.y)} + acc[ai][bj][m][0], v1 = (f32x4){bf_lo(w.z), bf_hi(w.z), bf_lo(w.w), bf_hi(w.w)} + acc[ai][bj][m][1];
                    q += (v0.x * v0.x + v0.y * v0.y) + (v0.z * v0.z + v0.w * v0.w) + (v1.x * v1.x + v1.y * v1.y) + (v1.z * v1.z + v1.w * v1.w);
                    v4u o; o.x = cvt_pk_bf16(v0.x, v0.y); o.y = cvt_pk_bf16(v0.z, v0.w); o.z = cvt_pk_bf16(v1.x, v1.y); o.w = cvt_pk_bf16(v1.z, v1.w);
                    *(v4u*)(xh + (size_t)rr * DM + col0 + bj * 128) = o; }
                if (want) { q += __shfl_xor(q, 16); q += __shfl_xor(q, 32); if (fq == 0) ss[(size_t)(u.pn * 4 + wc) * MTOT + rt + rr] = q; } }
        asm volatile("" ::: "memory");
    }
};

struct OrderD1 {
    int G, c; const char* D; const char* Z;
    __device__ __forceinline__ bool next(int i, Unit& u) const {
        const int L = i * G + c; if (L >= 2048) return false;
        u.pn = L >> 4; u.aux = (L >> 1) & 7; u.pm = L & 1;
        u.a = D + (size_t)u.pm * (256 * 512 * 2); u.b = Z + ((size_t)u.pn * 256 * 4096 + (size_t)u.aux * 512) * 2; return true; }
    __device__ __forceinline__ void a_ready(const Unit&) const {}
    __device__ __forceinline__ void done(const Unit&) const {}
};
struct OrderD2 {
    int G, c; const char* T; const char* YT;
    __device__ __forceinline__ bool next(int i, Unit& u) const {
        const int L = i * G + c; if (L >= 1024) return false;
        u.aux = L >> 3; u.pn = L & 7; u.pm = 0;
        u.a = T; u.b = YT + ((size_t)u.aux * 2048 + (size_t)u.pn * 256) * 512 * 2; return true; }
    __device__ __forceinline__ void a_ready(const Unit&) const {}
    __device__ __forceinline__ void done(const Unit&) const {}
};

__device__ constexpr float C16[16] = {1.0f, 0.9238795325112867f, 0.7071067811865476f, 0.3826834323650898f, 0.0f, -0.3826834323650898f, -0.7071067811865476f, -0.9238795325112867f,
                                      -1.0f, -0.9238795325112867f, -0.7071067811865476f, -0.3826834323650898f, 0.0f, 0.3826834323650898f, 0.7071067811865476f, 0.9238795325112867f};
__device__ constexpr float S16[16] = {0.0f, 0.3826834323650898f, 0.7071067811865476f, 0.9238795325112867f, 1.0f, 0.9238795325112867f, 0.7071067811865476f, 0.3826834323650898f,
                                      0.0f, -0.3826834323650898f, -0.7071067811865476f, -0.9238795325112867f, -1.0f, -0.9238795325112867f, -0.7071067811865476f, -0.3826834323650898f};
template <int N1> __device__ __forceinline__ void s1_items(const bf16* P, bf16* Z, const f32x2* TW, int row_base, int nb, int gt, int NGT) {
    constexpr int S = 256 * N1;
    const int nitems = nb * 256 * 512;
    for (int it = gt; it < nitems; it += NGT) {
        const int cg = it & 511, bn = it >> 9, n2 = bn & 255, b = bn >> 8, ch = cg * 4, g = ch >> 8, c = ch & 255;
        const bf16* src = P + (size_t)(row_base + b * S + n2) * LDP + C_XB + ch;
        float x[N1][4];
#pragma unroll
        for (int n1 = 0; n1 < N1; ++n1) { const v2u w = *(const v2u*)(src + (size_t)n1 * 256 * LDP); x[n1][0] = bf_lo(w.x); x[n1][1] = bf_hi(w.x); x[n1][2] = bf_lo(w.y); x[n1][3] = bf_hi(w.y); }
        bf16* dst = Z + (size_t)(row_base + b * S + n2) * 4096 + g * 512 + c;
#pragma unroll
        for (int k1 = 0; k1 <= N1 / 2; ++k1) {
            float re[4] = {0.f, 0.f, 0.f, 0.f}, im[4] = {0.f, 0.f, 0.f, 0.f};
#pragma unroll
            for (int n1 = 0; n1 < N1; ++n1) { const float cs = C16[((n1 * k1) % N1) * (16 / N1)], sn = S16[((n1 * k1) % N1) * (16 / N1)];
#pragma unroll
                for (int j = 0; j < 4; ++j) { re[j] = fmaf(x[n1][j], cs, re[j]); im[j] = fmaf(x[n1][j], -sn, im[j]); } }
#pragma unroll
            for (int mir = 0; mir < 2; ++mir) {
                if (mir == 1 && (k1 == 0 || k1 == N1 / 2)) continue;
                const int kk = mir ? N1 - k1 : k1;
                float imm[4];
#pragma unroll
                for (int j = 0; j < 4; ++j) imm[j] = mir ? -im[j] : im[j];
                const f32x2 tw = TW[(n2 * kk) & (S - 1)]; const float ct = tw.x, st = tw.y;
                v2u wr_, wi_;
                wr_.x = cvt_pk_bf16(re[0] * ct + imm[0] * st, re[1] * ct + imm[1] * st); wr_.y = cvt_pk_bf16(re[2] * ct + imm[2] * st, re[3] * ct + imm[3] * st);
                wi_.x = cvt_pk_bf16(imm[0] * ct - re[0] * st, imm[1] * ct - re[1] * st); wi_.y = cvt_pk_bf16(imm[2] * ct - re[2] * st, imm[3] * ct - re[3] * st);
                *(v2u*)(dst + (size_t)kk * 256 * 4096) = wr_; *(v2u*)(dst + (size_t)kk * 256 * 4096 + 256) = wi_;
            }
        }
    }
}

#define XB_TMO      128
#define XB_XCNT(j)  (256  + 64 * (j))
#define XB_XSUB(j)  (1280 + 64 * (j))
#define XB_XGEN(j)  (2304 + 64 * (j))
#define XB_TOP      3328
#define XB_TOPGEN   3392
#define XCD_BAR_WORDS 3456
#define XB_SPIN_CAP (1u << 18)
__device__ __forceinline__ unsigned xb_ld(unsigned* p)              { return __hip_atomic_load(p, __ATOMIC_RELAXED, __HIP_MEMORY_SCOPE_AGENT); }
__device__ __forceinline__ unsigned xb_add(unsigned* p, unsigned v) { return __hip_atomic_fetch_add(p, v, __ATOMIC_RELAXED, __HIP_MEMORY_SCOPE_AGENT); }
__device__ __forceinline__ unsigned xb_xcc_id() { return (unsigned)__builtin_amdgcn_s_getreg((3 << 11) | 20) & 0xFu; }
#define XB_SPIN(cond, bar) do { unsigned _sp = 0; while (cond) { __builtin_amdgcn_s_sleep(1); \
    if ((++_sp & 255u) == 0u) { if (xb_ld(&(bar)[XB_TMO])) break; if (_sp > XB_SPIN_CAP) { atomicAdd(&(bar)[XB_TMO], 1u); break; } } } } while (0)
struct XcdBarrier { unsigned* bar; unsigned x; volatile LAS unsigned* st; };
__device__ __forceinline__ XcdBarrier xcd_barrier_post(unsigned* bar, volatile LAS unsigned* st, bool leader) {
    XcdBarrier b; b.bar = bar; b.x = xb_xcc_id(); b.st = st;
    if (leader) (void)xb_add(&bar[XB_XCNT(b.x)], 1u);
    return b;
}
__device__ __forceinline__ void xcd_barrier_complete(unsigned* bar, unsigned x, unsigned& nloc, unsigned& nx) {
    const unsigned G = gridDim.x * gridDim.y * gridDim.z;
    unsigned sum, cnt, mine, sp = 0u;
    for (;;) {
        sum = 0u; cnt = 0u; mine = 0u;
#pragma unroll
        for (unsigned j = 0; j < 16; ++j) { const unsigned c = xb_ld(&bar[XB_XCNT(j)]); sum += c; cnt += (c > 0u) ? 1u : 0u; mine = (j == x) ? c : mine; }
        if (sum == G) break;
        __builtin_amdgcn_s_sleep(1);
        if ((++sp & 255u) == 0u) { if (xb_ld(&bar[XB_TMO])) break; if (sp > XB_SPIN_CAP) { atomicAdd(&bar[XB_TMO], 1u); break; } }
    }
    nloc = mine > 0u ? mine : 1u; nx = cnt > 0u ? cnt : 1u;
}
__device__ __forceinline__ void xcd_barrier(const XcdBarrier& b, bool leader) {
    asm volatile("s_waitcnt vmcnt(0)" ::: "memory");
    __syncthreads();
    if (leader) {
        unsigned* bar = b.bar;
        __builtin_amdgcn_s_waitcnt(0);
        unsigned nloc = b.st[0], nx = b.st[1];
        if (nloc == 0u) { xcd_barrier_complete(bar, b.x, nloc, nx); b.st[0] = nloc; b.st[1] = nx; }
        const unsigned old = xb_add(&bar[XB_XSUB(b.x)], 1u);
        const unsigned gen = old / nloc;
        if (old + 1u == (gen + 1u) * nloc) {
            __builtin_amdgcn_fence(__ATOMIC_RELEASE, "agent");
            asm volatile("s_waitcnt vmcnt(0)" ::: "memory");
            const unsigned og = xb_add(&bar[XB_TOP], 1u);
            const unsigned tg = og / nx;
            if (og + 1u == (tg + 1u) * nx) xb_add(&bar[XB_TOPGEN], 1u);
            else XB_SPIN(xb_ld(&bar[XB_TOPGEN]) == tg, bar);
            __builtin_amdgcn_fence(__ATOMIC_ACQUIRE, "agent");
            xb_add(&bar[XB_XGEN(b.x)], 1u);
            asm volatile("s_waitcnt vmcnt(0)" ::: "memory");
        } else {
            XB_SPIN(xb_ld(&bar[XB_XGEN(b.x)]) == gen, bar);
            __builtin_amdgcn_fence(__ATOMIC_ACQUIRE, "agent");
            asm volatile("s_waitcnt vmcnt(0)" ::: "memory");
        }
    }
    __syncthreads();
}

__device__ __forceinline__ float wave_sum(float v) {
#pragma unroll
    for (int o = 1; o < 64; o <<= 1) v += __shfl_xor(v, o);
    return v;
}
__device__ __forceinline__ void p0_transpose_item(const float* W, int K, int N, bf16* WT, LAS float* scr, int item, int lane, bool deal = false, const float* gk = nullptr) {
    const int nblk = N / 32, kb = item / nblk, nb = item % nblk, k0 = 64 * kb, n0 = 32 * nb;
    f32x4 wv[8];
#pragma unroll
    for (int i = 0; i < 8; ++i) wv[i] = *(const f32x4*)(W + (size_t)(k0 + 8 * i + (lane >> 3)) * N + n0 + 4 * (lane & 7));
#pragma unroll
    for (int i = 0; i < 8; ++i) { LAS float* d = scr + (8 * i + (lane >> 3)) * 33 + 4 * (lane & 7); d[0] = wv[i].x; d[1] = wv[i].y; d[2] = wv[i].z; d[3] = wv[i].w; }
    LDS_WAIT(); asm volatile("" ::: "memory");
    const int c = lane & 7;
    f32x4 ga = {1.f, 1.f, 1.f, 1.f}, gb = {1.f, 1.f, 1.f, 1.f};
    if (gk) { ga = *(const f32x4*)(gk + k0 + 8 * c); gb = *(const f32x4*)(gk + k0 + 8 * c + 4); }
    int nd = n0;
    if (deal && n0 >= C_GA) { const int g = n0 - C_GA, hb = (g >= DM) ? 1 : 0, gg = g - hb * DM; nd = C_GA + ((gg >> 7) << 8) + hb * 128 + (gg & 127); }
#pragma unroll
    for (int j = 0; j < 4; ++j) { const int n = (lane >> 3) + 8 * j; const LAS float* s = scr + (8 * c) * 33 + n;
        v4u o; o.x = pk2(s[0 * 33] * ga.x, s[1 * 33] * ga.y); o.y = pk2(s[2 * 33] * ga.z, s[3 * 33] * ga.w); o.z = pk2(s[4 * 33] * gb.x, s[5 * 33] * gb.y); o.w = pk2(s[6 * 33] * gb.z, s[7 * 33] * gb.w);
        *(GAS v4u*)(WT + (size_t)(nd + n) * K + k0 + 8 * c) = o; }
    LDS_WAIT(); asm volatile("" ::: "memory");
}
__device__ __forceinline__ void x_row_to_bf16(const float* xrow, bf16* orow, float* rs, int lane) {
    const GAS f32x4* xr = (const GAS f32x4*)xrow + lane;
    f32x4 v[16]; float s = 0.f;
#pragma unroll
    for (int j = 0; j < 16; ++j) { v[j] = xr[64 * j]; s += (v[j].x * v[j].x + v[j].y * v[j].y) + (v[j].z * v[j].z + v[j].w * v[j].w); }
    const float rstd = 1.0f / sqrtf(wave_sum(s) * (1.0f / DM) + EPS);
    GAS v2u* o8 = (GAS v2u*)orow + lane;
#pragma unroll
    for (int j = 0; j < 16; ++j) { v2u w; w.x = cvt_pk_bf16(v[j].x, v[j].y); w.y = cvt_pk_bf16(v[j].z, v[j].w); o8[64 * j] = w; }
    if (lane == 0) *rs = rstd;
}
__device__ __forceinline__ void rms_row_bf16_to_f32(const bf16* xrow, const f32x4 (&g8)[8][2], float* orow, int lane) {
    const GAS v4u* xr = (const GAS v4u*)xrow + lane;
    v4u w[8]; float s = 0.f;
#pragma unroll
    for (int j = 0; j < 8; ++j) w[j] = xr[64 * j];
#pragma unroll
    for (int j = 0; j < 8; ++j) { const float a0 = bf_lo(w[j].x), a1 = bf_hi(w[j].x), a2 = bf_lo(w[j].y), a3 = bf_hi(w[j].y), a4 = bf_lo(w[j].z), a5 = bf_hi(w[j].z), a6 = bf_lo(w[j].w), a7 = bf_hi(w[j].w);
        s += (a0 * a0 + a1 * a1) + (a2 * a2 + a3 * a3) + (a4 * a4 + a5 * a5) + (a6 * a6 + a7 * a7); }
    const float rstd = 1.0f / sqrtf(wave_sum(s) * (1.0f / DM) + EPS);
    GAS f32x4* o = (GAS f32x4*)orow + 2 * lane;
#pragma unroll
    for (int j = 0; j < 8; ++j) { const f32x4 ga = g8[j][0] * rstd, gb = g8[j][1] * rstd;
        o[128 * j] = (f32x4){bf_lo(w[j].x) * ga.x, bf_hi(w[j].x) * ga.y, bf_lo(w[j].y) * ga.z, bf_hi(w[j].y) * ga.w};
        o[128 * j + 1] = (f32x4){bf_lo(w[j].z) * gb.x, bf_hi(w[j].z) * gb.y, bf_lo(w[j].w) * gb.z, bf_hi(w[j].w) * gb.w}; }
}

struct Args { const float* in[13]; float* out; unsigned char* ws; int ph_lo, ph_hi, li, pad; };
typedef __attribute__((address_space(4))) const Args CArgs;
#define PHASE_BEGIN() \
    unsigned oz_ = 0u; asm volatile("" : "+s"(oz_));              \
    CArgs* AP = (CArgs*)((__attribute__((address_space(4))) const char*)__builtin_amdgcn_kernarg_segment_ptr() + oz_); \
    int t_ = (wave0 << 6) | (int)__builtin_amdgcn_mbcnt_hi(~0u, __builtin_amdgcn_mbcnt_lo(~0u, oz_)); asm volatile("" : "+v"(t_));       \
    const int tid = t_, lane = tid & 63, wave = __builtin_amdgcn_readfirstlane(tid >> 6); \
    int G = G0, vcu = vcu0, bx = bx0; asm volatile("" : "+s"(G), "+s"(vcu), "+s"(bx)); (void)bx; \
    unsigned char* ws = AP->ws; float* out = AP->out; (void)lane; (void)wave; (void)out; \
    const int gw = vcu * NWAVES + wave, NGW = G * NWAVES, gt = vcu * (NWAVES * 64) + tid, NGT = G * NWAVES * 64; (void)gw; (void)NGW; (void)gt; (void)NGT

__global__ void __launch_bounds__(NWAVES * 64, 2) trunk_fwd(Args args) {
    extern __shared__ __attribute__((aligned(16))) unsigned char lds_raw[];
    LAS unsigned char* lds = (LAS unsigned char*)lds_raw;
    const int G0 = gridDim.x, bx0 = blockIdx.x; const int vcu0 = (G0 % 8 == 0) ? (bx0 % 8) * (G0 / 8) + bx0 / 8 : bx0;
    const int wave0 = __builtin_amdgcn_readfirstlane(threadIdx.x >> 6);
    for (int u = threadIdx.x; u < (LDS_BYTES - LDSCTL_OFF) / 4; u += NWAVES * 64) ((LAS unsigned*)(lds + LDSCTL_OFF))[u] = 0u;
    __syncthreads();
#if !MK_PER_PHASE
    (void)xcd_barrier_post((unsigned*)(args.ws + WS_CTL) + CW_BAR, (volatile LAS unsigned*)(lds + MISC_OFF) + 8, threadIdx.x == 0);
#define GRID_BAR() do { unsigned ozb_ = 0u; asm volatile("" : "+s"(ozb_)); \
        CArgs* AB_ = (CArgs*)((__attribute__((address_space(4))) const char*)__builtin_amdgcn_kernarg_segment_ptr() + ozb_); \
        XcdBarrier b_; b_.bar = (unsigned*)(AB_->ws + WS_CTL) + CW_BAR; b_.x = xb_xcc_id(); b_.st = (volatile LAS unsigned*)(lds + MISC_OFF) + 8; xcd_barrier(b_, wave0 == 0 && lane_id() == 0); } while (0)
#else
#define GRID_BAR() do { } while (0)
#endif
    const int lo = args.ph_lo, hi = args.ph_hi;
#define IN(k) (lo <= (k) && (k) < hi)
#define BOTH(k) (IN(k) && IN((k) + 1))

    if (IN(0)) {
        PHASE_BEGIN();
            bf16* DC = (bf16*)(ws + WS_DC); bf16* TT = (bf16*)(ws + WS_T);
            for (int e = gt; e < 512 * 512 / 8; e += NGT) { const int r = e >> 6, q0 = (e & 63) * 8; const int po = r >> 8, m = r & 255, pi = q0 >> 8, c0 = q0 & 255; float v[8];
#pragma unroll
                for (int j = 0; j < 8; ++j) { const float ph = (float)((m * (c0 + j)) & 255) * (1.0f / 128.0f); v[j] = (po == pi) ? cospif(ph) : ((po == 0) ? sinpif(ph) : -sinpif(ph)); }
                v4u w; w.x = pk2(v[0], v[1]); w.y = pk2(v[2], v[3]); w.z = pk2(v[4], v[5]); w.w = pk2(v[6], v[7]); *(GAS v4u*)(DC + (size_t)e * 8) = w; }
            for (int e = gt; e < 256 * 512 / 8; e += NGT) { const int k2 = e >> 6, q0 = (e & 63) * 8; const int pi = q0 >> 8, n0 = q0 & 255; float v[8];
#pragma unroll
                for (int j = 0; j < 8; ++j) { const float ph = (float)((k2 * (n0 + j)) & 255) * (1.0f / 128.0f); v[j] = pi ? sinpif(ph) : cospif(ph); }
                v4u w; w.x = pk2(v[0], v[1]); w.y = pk2(v[2], v[3]); w.z = pk2(v[4], v[5]); w.w = pk2(v[6], v[7]); *(GAS v4u*)(TT + (size_t)e * 8) = w; }

        { f32x2* TW = (f32x2*)(ws + WS_TW);
          for (int e = gt; e < 2048 + 4096; e += NGT) { const bool big = e >= 2048; const int j = big ? e - 2048 : e; const float ph = (float)j * (big ? (2.0f / 4096.0f) : (2.0f / 2048.0f)), sc = big ? 0.25f : 0.35355339059327373f;
              TW[e] = (f32x2){cospif(ph) * sc, sinpif(ph) * sc}; } }
    }

    for (int l = 0; l < 2; ++l) {
        const int pb = 7 * l;

        if (IN(pb + 0)) {
            PHASE_BEGIN();
            const float* norm_g = AP->in[2] + (size_t)l * DM;
            const float* w_in = AP->in[3] + (size_t)l * DM * DIN;
            const float* w_a = AP->in[8] + (size_t)l * DA * DM;
            const float* w_b = AP->in[9] + (size_t)l * DB * DM;
            const float* w_out = AP->in[11] + (size_t)l * DM * DM;
            bf16* W1T = (bf16*)(ws + WS_W1T); bf16* WAT = (bf16*)(ws + WS_WAT); bf16* WBT = (bf16*)(ws + WS_WBT); bf16* WOT = (bf16*)(ws + WS_WOT);
            LAS float* scr = (LAS float*)(lds + RING_OFF + wave * 16384);
            constexpr int I_1 = (DM / 64) * (DIN / 32), I_A = (DA / 64) * (DM / 32), I_O = (DM / 64) * (DM / 32);
            constexpr int NITEMS = I_1 + 2 * I_A + I_O;
            for (int it = gw; it < NITEMS; it += NGW) {
                int r = it;
                if (r < I_1) { p0_transpose_item(w_in, DM, DIN, W1T, scr, r, lane, true, norm_g); continue; } r -= I_1;
                if (r < I_A) { p0_transpose_item(w_a, DA, DM, WAT, scr, r, lane); continue; } r -= I_A;
                if (r < I_A) { p0_transpose_item(w_b, DB, DM, WBT, scr, r, lane); continue; } r -= I_A;
                p0_transpose_item(w_out, DM, DM, WOT, scr, r, lane);
            }
            if (l == 0) {
                const float* x_prompt = AP->in[0]; const float* x_sample = AP->in[1];
                bf16* X0 = (bf16*)(ws + WS_X1); float* RS0 = (float*)(ws + WS_RSTD);
                for (int m = gw; m < MTOT; m += NGW) {
                    const float* xrow = (m < MPR) ? x_prompt + (size_t)m * DM : x_sample + (size_t)(m - MPR) * DM;
                    x_row_to_bf16(xrow, X0 + (size_t)m * DM, RS0 + m, lane);
                }
            } else {
                float* RS = (float*)(ws + WS_RSTD); const float* SS = (const float*)(ws + WS_PART);
                for (int m = gt; m < MTOT; m += NGT) { float s = 0.f;
#pragma unroll 16
                    for (int j = 0; j < 64; ++j) s += SS[(size_t)j * MTOT + m];
                    RS[m] = 1.0f / sqrtf(s * (1.0f / DM) + EPS); }
            }
            { const float* wsp = AP->in[6] + (size_t)l * 16 * 128 * 128; bf16* wspb = (bf16*)(ws + WS_WSP);
              for (int e = gt; e < 16 * 128 * 128 / 8; e += NGT) { const f32x4 a = *(const f32x4*)(wsp + (size_t)e * 8), b = *(const f32x4*)(wsp + (size_t)e * 8 + 4);
                  v4u o; o.x = cvt_pk_bf16(a.x, a.y); o.y = cvt_pk_bf16(a.z, a.w); o.z = cvt_pk_bf16(b.x, b.y); o.w = cvt_pk_bf16(b.z, b.w); *(v4u*)(wspb + (size_t)e * 8) = o; } }
            VM_WAIT(); __syncthreads();
            if (BOTH(pb + 0)) GRID_BAR();
        }

        if (IN(pb + 1)) {
            PHASE_BEGIN();
            pg8::OrderMN S; S.init(MTOT / 256, DIN / 256, G, bx, ws + WS_X1, (size_t)256 * DM * 2, ws + WS_W1T, (size_t)256 * DM * 2);
            Epi1<true> E{(bf16*)(ws + WS_P), AP->in[10] + (size_t)l * 2 * DM, (f32x2*)(ws + WS_PART), (const float*)(ws + WS_RSTD), (LAS float*)(lds + RS_OFF)};
            pg8::gemm_phase<Epi1<true>, pg8::OrderMN, PG8_ALIGN, PG8_SP2>(wave0, lds + RING_OFF, DM, DM, DM, S, E);
            if (BOTH(pb + 1)) GRID_BAR();
        }

        if (IN(pb + 2)) {
            PHASE_BEGIN();
            const float* ln_g = AP->in[4] + (size_t)l * DA;
            const float* ln_b = AP->in[5] + (size_t)l * DA;
            const float* w_sp = AP->in[6] + (size_t)l * 16 * 128 * 128;
            const float* b_sp = AP->in[7] + (size_t)l * 16 * 128;
            bf16* P = (bf16*)(ws + WS_P); const f32x2* PART = (const f32x2*)(ws + WS_PART);
            LAS unsigned char* tile = lds + RING_OFF;
            LAS float* red = (LAS float*)(lds + RING_OFF + 65536);
            LAS float* st = (LAS float*)(lds + STAT_OFF);
            const int fr = lane & 15, g4 = lane >> 4, wp = wave >> 1, wcx = wave & 1;
            for (int chunk = vcu; chunk < 256; chunk += G) {
                const int r0 = chunk * 128;
                { const int row = tid & 127, grp = tid >> 7; float s = 0.f, q = 0.f;
#pragma unroll
                  for (int k = 0; k < 8; ++k) { const f32x2 p = PART[(size_t)(grp * 8 + k) * MTOT + r0 + row]; s += p.x; q += p.y; }
                  red[(grp * 128 + row) * 2] = s; red[(grp * 128 + row) * 2 + 1] = q; }
                __syncthreads();
                if (tid < 128) { float s = 0.f, q = 0.f;
#pragma unroll
                    for (int k = 0; k < 4; ++k) { s += red[(k * 128 + tid) * 2]; q += red[(k * 128 + tid) * 2 + 1]; }
                    const float mu = s * (1.0f / DA); const float var = q * (1.0f / DA) - mu * mu; st[tid] = mu; st[128 + tid] = 1.0f / sqrtf(var + EPS); }
                const int sq = tid >> 2, spart = tid & 3;
                const bf16* gsrc = P + (size_t)(r0 + sq) * LDP + C_GV + spart * 32;
                v4u gr[4];
#pragma unroll
                for (int j = 0; j < 4; ++j) gr[j] = *(const v4u*)(gsrc + 8 * j);
                for (int head = 0; head < 16; ++head) {
                    const int cc0 = head * 128;
                    int th_ = tid; asm volatile("" : "+v"(th_));
                    const int fr = th_ & 15, g4 = (th_ >> 4) & 3, sq = th_ >> 2, spart = th_ & 3;
                    const bf16* gsrc = P + (size_t)(r0 + sq) * LDP + C_GV + spart * 32;
                    __syncthreads();
#pragma unroll
                    for (int j = 0; j < 4; ++j) *(LAS v4u*)(tile + sq * 288 + spart * 64 + 16 * j) = gr[j];
                    __syncthreads();
                    if (head + 1 < 16) {
#pragma unroll
                        for (int j = 0; j < 4; ++j) gr[j] = *(const v4u*)(gsrc + (cc0 + 128) + 8 * j);
                    }
                    v4u uq[2][2], zq[2][2];
#pragma unroll
                    for (int a2 = 0; a2 < 2; ++a2) { const int c = 64 * wcx + 32 * a2 + 8 * g4;
#pragma unroll
                        for (int pj = 0; pj < 2; ++pj) { const bf16* up = P + (size_t)(r0 + 32 * wp + 16 * pj + fr) * LDP + cc0 + c; uq[a2][pj] = *(const v4u*)(up + C_U); zq[a2][pj] = *(const v4u*)(up + C_ZA); } }
                    bf16x8 wf[2][4]; float av[2], w1v[2], bsv[2];
                    const bf16* wsrc = (const bf16*)(ws + WS_WSP) + (size_t)head * 128 * 128;
#pragma unroll
                    for (int pj = 0; pj < 2; ++pj) { const int p = 32 * wp + 16 * pj + fr; float ap = 0.f, w1 = 0.f;
#pragma unroll
                        for (int ks = 0; ks < 4; ++ks) { const int q0 = 32 * ks + 8 * g4;
                            const v4u w8 = *(const v4u*)(wsrc + p * 128 + q0);
                            const f32x4 wa = {bf_lo(w8.x), bf_hi(w8.x), bf_lo(w8.y), bf_hi(w8.y)}, wb = {bf_lo(w8.z), bf_hi(w8.z), bf_lo(w8.w), bf_hi(w8.w)};
                            const f32x4 ra = *(const LAS f32x4*)(st + 128 + q0), rb = *(const LAS f32x4*)(st + 128 + q0 + 4);
                            const f32x4 ma = *(const LAS f32x4*)(st + q0), mb = *(const LAS f32x4*)(st + q0 + 4);
                            const f32x4 sa = wa * ra, sb = wb * rb;
                            ap += (sa.x * ma.x + sa.y * ma.y) + (sa.z * ma.z + sa.w * ma.w) + (sb.x * mb.x + sb.y * mb.y) + (sb.z * mb.z + sb.w * mb.w);
                            w1 += (wa.x + wa.y) + (wa.z + wa.w) + (wb.x + wb.y) + (wb.z + wb.w);
                            v4u pk; pk.x = cvt_pk_bf16(sa.x, sa.y); pk.y = cvt_pk_bf16(sa.z, sa.w); pk.z = cvt_pk_bf16(sb.x, sb.y); pk.w = cvt_pk_bf16(sb.z, sb.w);
                            wf[pj][ks] = __builtin_bit_cast(bf16x8, pk); }
                        ap += __shfl_xor(ap, 16); ap += __shfl_xor(ap, 32); w1 += __shfl_xor(w1, 16); w1 += __shfl_xor(w1, 32);
                        av[pj] = ap; w1v[pj] = w1; bsv[pj] = b_sp[head * 128 + p]; }
                    f32x4 acc[4][2];
#pragma unroll
                    for (int ci = 0; ci < 4; ++ci)
#pragma unroll
                        for (int pj = 0; pj < 2; ++pj) acc[ci][pj] = (f32x4){0.f, 0.f, 0.f, 0.f};
                    const int trq = fr >> 2, trp = fr & 3;
#pragma unroll
                    for (int ci = 0; ci < 4; ++ci)
#pragma unroll
                        for (int ks = 0; ks < 4; ++ks) {
                            typedef short v4s __attribute__((ext_vector_type(4)));
                            const LAS unsigned char* ta = tile + (32 * ks + 8 * g4 + trq) * 288 + (64 * wcx + 32 * (ci >> 1) + 4 * (ci & 1)) * 2 + 16 * trp;
                            const v4s t0 = __builtin_amdgcn_ds_read_tr16_b64_v4i16((LAS v4s*)ta);
                            const v4s t1 = __builtin_amdgcn_ds_read_tr16_b64_v4i16((LAS v4s*)(ta + 4 * 288));
                            const bf16x8 gf = {t0[0], t0[1], t0[2], t0[3], t1[0], t1[1], t1[2], t1[3]};
#pragma unroll
                            for (int pj = 0; pj < 2; ++pj) acc[ci][pj] = __builtin_amdgcn_mfma_f32_16x16x32_bf16(gf, wf[pj][ks], acc[ci][pj], 0, 0, 0);
                        }
#pragma unroll
                    for (int a2 = 0; a2 < 2; ++a2) { const int c = 64 * wcx + 32 * a2 + 8 * g4;
                        const f32x4 gam0 = *(const f32x4*)(ln_g + cc0 + c), bet0 = *(const f32x4*)(ln_b + cc0 + c), gam1 = *(const f32x4*)(ln_g + cc0 + c + 4), bet1 = *(const f32x4*)(ln_b + cc0 + c + 4);
#pragma unroll
                        for (int pj = 0; pj < 2; ++pj) { const int p = 32 * wp + 16 * pj + fr; bf16* up = P + (size_t)(r0 + p) * LDP + cc0 + c;
                            const v4u u4 = uq[a2][pj], z4 = zq[a2][pj];
                            const f32x4 mx0 = gam0 * (acc[2 * a2][pj] - av[pj]) + bet0 * w1v[pj] + bsv[pj], mx1 = gam1 * (acc[2 * a2 + 1][pj] - av[pj]) + bet1 * w1v[pj] + bsv[pj];
                            v4u o; o.x = cvt_pk_bf16(bf_lo(u4.x) * mx0.x * bf_lo(z4.x), bf_hi(u4.x) * mx0.y * bf_hi(z4.x)); o.y = cvt_pk_bf16(bf_lo(u4.y) * mx0.z * bf_lo(z4.y), bf_hi(u4.y) * mx0.w * bf_hi(z4.y));
                            o.z = cvt_pk_bf16(bf_lo(u4.z) * mx1.x * bf_lo(z4.z), bf_hi(u4.z) * mx1.y * bf_hi(z4.z)); o.w = cvt_pk_bf16(bf_lo(u4.w) * mx1.z * bf_lo(z4.w), bf_hi(u4.w) * mx1.w * bf_hi(z4.w));
                            *(v4u*)(up + C_U) = o; } }
                }
                __syncthreads();
            }
            { int gt1 = gt; asm volatile("" : "+v"(gt1));
              s1_items<8>(P, (bf16*)(ws + WS_Z), (const f32x2*)(ws + WS_TW), 0, 8, gt1, NGT);
              int gt2 = gt; asm volatile("" : "+v"(gt2));
              s1_items<16>(P, (bf16*)(ws + WS_Z), (const f32x2*)(ws + WS_TW) + 2048, MPR, 4, gt2, NGT); }
            VM_WAIT(); __syncthreads();
            if (BOTH(pb + 2)) GRID_BAR();
        }

        if (IN(pb + 3)) {
            PHASE_BEGIN();
            OrderD1 S{G, vcu, (const char*)(ws + WS_DC), (const char*)(ws + WS_Z)};
            EpiD1 E{(bf16*)(ws + WS_H)};
            pg8::gemm_phase<EpiD1, OrderD1, PG8_ALIGN, PG8_SP2>(wave0, lds + RING_OFF, 512, 4096, 512, S, E);
            if (BOTH(pb + 3)) GRID_BAR();
        }

        if (IN(pb + 4)) {
            PHASE_BEGIN();
            OrderD2 S{G, vcu, (const char*)(ws + WS_T), (const char*)(ws + WS_H)};
            EpiD2 E{(bf16*)(ws + WS_P)};
            pg8::gemm_phase<EpiD2, OrderD2, PG8_ALIGN, PG8_SP2>(wave0, lds + RING_OFF, 512, 512, 512, S, E);
            if (BOTH(pb + 4)) GRID_BAR();
        }

        if (IN(pb + 5)) {
            PHASE_BEGIN();
            OrderG2 S; S.o.init(MTOT / 256, DM / 256, G, bx, ws + WS_P + (size_t)C_U * 2, (size_t)256 * LDP * 2, ws + WS_WAT, (size_t)256 * DA * 2);
            S.A2 = (const char*)(ws + WS_P + (size_t)C_ZB * 2); S.B2 = (const char*)(ws + WS_WBT);
            Epi2G E{(const bf16*)(ws + WS_P), (bf16*)(ws + WS_H)};
            pg8::gemm_phase<Epi2G, OrderG2, PG8_ALIGN, PG8_SP2>(wave0, lds + RING_OFF, LDP, DA, DA, S, E);
            if (BOTH(pb + 5)) GRID_BAR();
        }

        if (IN(pb + 6)) {
            PHASE_BEGIN();
            pg8::OrderMN S; S.init(MTOT / 256, DM / 256, G, bx, ws + WS_H, (size_t)256 * DM * 2, ws + WS_WOT, (size_t)256 * DM * 2);
            Epi3 E{(bf16*)(ws + WS_X1), (l == 0) ? (float*)(ws + WS_PART) : (float*)nullptr};
            pg8::gemm_phase<Epi3, pg8::OrderMN, PG8_ALIGN, PG8_SP2>(wave0, lds + RING_OFF, DM, DM, DM, S, E);
            if (BOTH(pb + 6)) GRID_BAR();
        }
    }

    if (IN(14)) {
        PHASE_BEGIN();
        const float* final_g = AP->in[12];
        const bf16* X2 = (const bf16*)(ws + WS_X1);
        f32x4 g8[8][2];
#pragma unroll
        for (int j = 0; j < 8; ++j) { g8[j][0] = ((const GAS f32x4*)final_g)[2 * (lane + 64 * j)]; g8[j][1] = ((const GAS f32x4*)final_g)[2 * (lane + 64 * j) + 1]; }
        for (int m = gw; m < MTOT; m += NGW) rms_row_bf16_to_f32(X2 + (size_t)m * DM, g8, out + (size_t)m * DM, lane);
    }
#undef IN
#undef BOTH
}

extern "C" void kernel_launch(void* const* d_in, const int* in_sizes, int n_in, void* d_out, int out_size, void* d_ws, size_t ws_size, hipStream_t stream) {
    static int grid = 0;
    if (grid == 0) {
        if (n_in != 13 || out_size != MTOT * DM || ws_size < WS_END) { fprintf(stderr, "kernel_launch: unexpected shapes (n_in %d out %d ws %zu); nothing launched\n", n_in, out_size, ws_size); grid = -1; return; }
        int dev = 0, cus = 0, per_cu = 0;
        if (hipGetDevice(&dev) != hipSuccess || hipDeviceGetAttribute(&cus, hipDeviceAttributeMultiprocessorCount, dev) != hipSuccess) { grid = -1; return; }
        if (hipFuncSetAttribute((const void*)trunk_fwd, hipFuncAttributeMaxDynamicSharedMemorySize, LDS_BYTES) != hipSuccess) { fprintf(stderr, "kernel_launch: hipFuncSetAttribute failed\n"); grid = -1; return; }
        if (hipOccupancyMaxActiveBlocksPerMultiprocessor(&per_cu, (const void*)trunk_fwd, NWAVES * 64, LDS_BYTES) != hipSuccess || per_cu < 1)
            fprintf(stderr, "kernel_launch: note: occupancy query reports %d workgroups per CU\n", per_cu);
        (void)hipGetLastError();
        grid = cus;
    }
    if (grid < 0) return;
    if (hipMemsetAsync((char*)d_ws + WS_CTL, 0, CTL_ZERO_BYTES, stream) != hipSuccess) return;
    Args a{};
    for (int i = 0; i < 13; ++i) a.in[i] = (const float*)d_in[i];
    a.out = (float*)d_out; a.ws = (unsigned char*)d_ws;
#if MK_PER_PHASE
    for (int p = 0; p < N_PHASES; ++p) { a.ph_lo = p; a.ph_hi = p + 1; a.li = p;
        hipLaunchKernelGGL(trunk_fwd, dim3(grid), dim3(NWAVES * 64), LDS_BYTES, stream, a); }
#else
    a.ph_lo = 0; a.ph_hi = N_PHASES; a.li = 0;
    hipLaunchKernelGGL(trunk_fwd, dim3(grid), dim3(NWAVES * 64), LDS_BYTES, stream, a);
#endif
}
```

```cpp
#include <hip/hip_runtime.h>
#include <cstdio>
#include <cstdint>

#ifndef MK_PER_PHASE
#define MK_PER_PHASE 0
#endif

#define GAS __attribute__((address_space(1)))
#define LAS __attribute__((address_space(3)))
typedef unsigned short bf16;
typedef unsigned v4u __attribute__((ext_vector_type(4)));
typedef unsigned v2u __attribute__((ext_vector_type(2)));
typedef float f32x4 __attribute__((ext_vector_type(4)));
typedef float f32x2 __attribute__((ext_vector_type(2)));
typedef short bf16x8 __attribute__((ext_vector_type(8)));
typedef GAS unsigned gu32;

constexpr int DM = 4096, DIN = 18432, DA = 2048, DB = 2048;
constexpr int MPR = 16384;
constexpr int MTOT = 32768;
constexpr int LDP = DIN;
constexpr int C_U = 0, C_GV = 2048, C_ZA = 4096, C_XB = 6144, C_ZB = 8192, C_GA = 10240, C_GB = 14336;
constexpr float EPS = 1e-6f;
constexpr int NWAVES = 8;
constexpr int N_PHASES = 15;

constexpr size_t MiB = 1u << 20;
constexpr size_t WS_CTL = 0, CTL_ZERO_BYTES = 32768;
constexpr size_t WS_W1T = 1 * MiB;
constexpr size_t WS_WAT = 145 * MiB;
constexpr size_t WS_WBT = 161 * MiB;
constexpr size_t WS_WOT = 177 * MiB;
constexpr size_t WS_DC = 210 * MiB;
constexpr size_t WS_TW = 212 * MiB;
constexpr size_t WS_T = 211 * MiB;
constexpr size_t WS_RSTD = 213 * MiB;
constexpr size_t WS_WSP = 214 * MiB;
constexpr size_t WS_PART = 291 * MiB;
constexpr size_t WS_H = 300 * MiB;
constexpr size_t WS_P = 556 * MiB;
constexpr size_t WS_Z = 1708 * MiB;
constexpr size_t WS_X1 = 1964 * MiB;
constexpr size_t WS_END = 2220 * MiB;
constexpr int CW_BAR = 4096;

constexpr int RING_OFF = 0, RING_BYTES = 131072;
constexpr int LDSCTL_OFF = RING_BYTES, MISC_OFF = LDSCTL_OFF + 320;
constexpr int STAT_OFF = RING_BYTES + 1024;
constexpr int RS_OFF = RING_BYTES + 4096;
constexpr int LDS_BYTES = 147456;

#define RLX_AGENT __ATOMIC_RELAXED, __HIP_MEMORY_SCOPE_AGENT
#define LDS_WAIT() asm volatile("s_waitcnt lgkmcnt(0)" ::: "memory")
#define VM_WAIT() asm volatile("s_waitcnt vmcnt(0)" ::: "memory")

typedef __bf16 bf16x2_t __attribute__((ext_vector_type(2)));
__device__ __forceinline__ unsigned cvt_pk_bf16(float lo, float hi) { const f32x2 v = {lo, hi}; const bf16x2_t b = __builtin_convertvector(v, bf16x2_t); return __builtin_bit_cast(unsigned, b); }
__device__ __forceinline__ int lane_id() { return (int)__builtin_amdgcn_mbcnt_hi(~0u, __builtin_amdgcn_mbcnt_lo(~0u, 0u)); }
__device__ __forceinline__ float bf_lo(unsigned w) { return __builtin_bit_cast(float, w << 16); }
__device__ __forceinline__ float bf_hi(unsigned w) { return __builtin_bit_cast(float, w & 0xffff0000u); }
__device__ __forceinline__ float bf2f(bf16 b) { return __builtin_bit_cast(float, ((unsigned)b) << 16); }
__device__ __forceinline__ unsigned f2bf(float f) { unsigned u = __builtin_bit_cast(unsigned, f); return (u + 0x7fffu + ((u >> 16) & 1u)) >> 16; }
__device__ __forceinline__ unsigned pk2(float lo, float hi) { return f2bf(lo) | (f2bf(hi) << 16); }

namespace pg8 {
constexpr int BM = 256, BK = 64, HALF = 128, HTB = HALF * BK * 2, STAGE_BYTES = 8 * HTB, NXCD = 8, WGM = 8;
__host__ __device__ __forceinline__ int lds_byte(int r, int c) { const int st = (r >> 4) * 2 + (c >> 5), rr = r & 15, cc = c & 31, ob = rr * 64 + cc * 2; return st * 1024 + (ob ^ (((ob >> 9) & 1) << 5)); }
__host__ __device__ __forceinline__ void stage_rc(int b, int& R, int& C) { const int st = b / 1024, sb = b % 1024, swz = sb ^ (((sb >> 9) & 1) << 5); R = (st >> 1) * 16 + swz / 64; C = (st & 1) * 32 + (swz % 64) / 2; }
__host__ __device__ __forceinline__ int perm32(int rho) { const int n = rho >> 4, i = rho & 15; return 8 * (i >> 2) + 4 * n + (i & 3); }

struct Unit { const char* a; const char* b; int pm, pn, aux; };

struct OrderMN {
    int nM, nN, nwg, G, c; const char* A; const char* B; size_t tA, tB;
    __device__ __forceinline__ void init(int nM_, int nN_, int G_, int c_, const void* A_, size_t tA_, const void* B_, size_t tB_) { nM = nM_; nN = nN_; nwg = nM * nN; G = G_; c = c_; A = (const char*)A_; B = (const char*)B_; tA = tA_; tB = tB_; }
    __device__ __forceinline__ bool next(int i, Unit& u) const {
        const long L = (long)i * G + c; if (L >= nwg) return false;
        int wgid = (int)L; { const int q = nwg / NXCD, r = nwg % NXCD, xcd = wgid % NXCD, off = wgid / NXCD; wgid = (xcd < r ? xcd * (q + 1) : r * (q + 1) + (xcd - r) * q) + off; }
        const int nig = WGM * nN, gid = wgid / nig, fm = gid * WGM, gsz = (nM - fm) < WGM ? (nM - fm) : WGM;
        u.pm = fm + ((wgid % nig) % gsz); u.pn = (wgid % nig) / gsz; u.aux = 0;
        u.a = A + (size_t)u.pm * tA; u.b = B + (size_t)u.pn * tB; return true;
    }
    __device__ __forceinline__ void a_ready(const Unit&) const {}
    __device__ __forceinline__ void done(const Unit&) const {}
};

template <class Epi, class Sched, bool ALIGN_EPI, bool SP2>
__device__ __forceinline__ void gemm_phase(const int ws_, LAS unsigned char* lds, const int lda, const int ldb, const int K, const Sched& S, const Epi& E) {
    int tid_ = (ws_ << 6) | lane_id(); asm volatile("" : "+v"(tid_));
    const int tid = tid_, wid = __builtin_amdgcn_readfirstlane(tid >> 6), lane = tid & 63, wr = wid >> 2, wc = wid & 3, fr = lane & 15, fq = lane >> 4;
    const int nt = K / BK;
    unsigned voffA[2], voffB[2];
#pragma unroll
    for (int i = 0; i < 2; ++i) { int R, C; stage_rc(tid * 16 + i * 8192, R, C); const int Rb = Epi::PERM ? ((R & ~31) + perm32(R & 31)) : R;
        voffA[i] = (unsigned)(R * lda + C) * 2u; voffB[i] = (unsigned)(Rb * ldb + C) * 2u; }
    const size_t kstep = (size_t)(BK * 2);
    const size_t hstepA = (size_t)HALF * lda * 2, hstepB = (size_t)HALF * ldb * 2;
    const unsigned ldsw = (unsigned)wid * 1024u;
    const int aoff = lds_byte(wr * 64 + fr, fq * 8), boff = lds_byte(wc * 32 + fr, fq * 8);
#define PG8_SA(b, h) (((b) * 2 + (h)) * HTB)
#define PG8_SB(b, h) ((4 + (b) * 2 + (h)) * HTB)
#define PG8_STAGE(bufoff, gbase, voff) do { _Pragma("unroll") for (int _i = 0; _i < 2; ++_i) \
        __builtin_amdgcn_global_load_lds((const unsigned*)((const char*)(gbase) + (voff)[_i]), (LAS unsigned*)(lds + (bufoff) + ldsw + _i * 8192), 16, 0, 0); } while (0)
#define PG8_LDA(dst, b, h) do { _Pragma("unroll") for (int m = 0; m < 4; ++m) _Pragma("unroll") for (int k = 0; k < 2; ++k) dst[m][k] = *(const LAS bf16x8*)(lds + PG8_SA(b, h) + aoff + m * 2048 + k * 1024); } while (0)
#define PG8_LDB(dst, b, h) do { _Pragma("unroll") for (int n = 0; n < 2; ++n) _Pragma("unroll") for (int k = 0; k < 2; ++k) dst[n][k] = *(const LAS bf16x8*)(lds + PG8_SB(b, h) + boff + n * 2048 + k * 1024); } while (0)
#define PG8_MMA(ai, bj, At, Bt) do { __builtin_amdgcn_s_setprio(1); _Pragma("unroll") for (int m = 0; m < 4; ++m) _Pragma("unroll") for (int n = 0; n < 2; ++n) _Pragma("unroll") for (int k = 0; k < 2; ++k) \
        acc[ai][bj][m][n] = __builtin_amdgcn_mfma_f32_16x16x32_bf16(Bt[n][k], At[m][k], acc[ai][bj][m][n], 0, 0, 0); __builtin_amdgcn_s_setprio(0); } while (0)
#define PG8_WAIT_V(n) asm volatile("s_waitcnt vmcnt(" #n ")" ::: "memory")
#define PG8_WAIT_L(n) asm volatile("s_waitcnt lgkmcnt(" #n ")" ::: "memory")
#define PG8_BAR __builtin_amdgcn_s_barrier()
#define PG8_SCHED __builtin_amdgcn_sched_barrier(0)
    Unit cur, nxt; int ui = 0;
    if (!S.next(0, cur)) return;
    float carry = 0.f;
    if constexpr (Epi::CARRY) carry = E.pre(cur, tid);
    f32x4 acc[2][2][4][2];
#pragma unroll
    for (int a = 0; a < 2; ++a)
#pragma unroll
        for (int b = 0; b < 2; ++b)
#pragma unroll
            for (int m = 0; m < 4; ++m)
#pragma unroll
                for (int n = 0; n < 2; ++n) acc[a][b][m][n] = (f32x4){0.f, 0.f, 0.f, 0.f};
    bf16x8 At[4][2], B0[2][2], B1[2][2];
    const char* cA = cur.a; const char* cB = cur.b;
    S.a_ready(cur);
    if constexpr (SP2) {
        PG8_STAGE(PG8_SB(0, 0), cB, voffB); PG8_STAGE(PG8_SB(0, 1), cB + hstepB, voffB); PG8_STAGE(PG8_SA(0, 0), cA, voffA); PG8_STAGE(PG8_SA(0, 1), cA + hstepA, voffA);
        if (wr == 1) PG8_BAR;
        PG8_WAIT_V(2); PG8_BAR;
        PG8_STAGE(PG8_SB(1, 0), cB + kstep, voffB); PG8_STAGE(PG8_SA(1, 0), cA + kstep, voffA); PG8_STAGE(PG8_SB(1, 1), cB + hstepB + kstep, voffB);
        PG8_WAIT_V(6); PG8_BAR;
    } else {
        PG8_STAGE(PG8_SB(0, 0), cB, voffB); PG8_STAGE(PG8_SA(0, 0), cA, voffA); PG8_STAGE(PG8_SB(0, 1), cB + hstepB, voffB); PG8_STAGE(PG8_SA(0, 1), cA + hstepA, voffA);
        if (wr == 1) PG8_BAR;
        PG8_WAIT_V(4); PG8_BAR;
        PG8_STAGE(PG8_SB(1, 0), cB + kstep, voffB); PG8_STAGE(PG8_SA(1, 0), cA + kstep, voffA); PG8_STAGE(PG8_SB(1, 1), cB + hstepB + kstep, voffB);
        PG8_WAIT_V(6); PG8_BAR;
    }
    for (;;) {
        const bool has_next = S.next(ui + 1, nxt);
        const char* nA = has_next ? nxt.a : cA; const char* nB = has_next ? nxt.b : cB;
        asm volatile(".p2align 8" ::: "memory");
        for (int t = 0; t < nt; t += 2) {
            const bool last = (t == nt - 2);
            const char* a1 = cA + (size_t)(t + 1) * kstep;
            const char* a2 = last ? nA : cA + (size_t)(t + 2) * kstep; const char* b2 = last ? nB : cB + (size_t)(t + 2) * kstep;
            const char* a3 = a2 + kstep; const char* b3 = b2 + kstep;
            if (last && has_next) S.a_ready(nxt);
            if constexpr (SP2) {
            PG8_LDB(B0, 0, 0); PG8_LDB(B1, 0, 1); PG8_SCHED; PG8_LDA(At, 0, 0); PG8_STAGE(PG8_SA(1, 1), a1 + hstepA, voffA);
            PG8_WAIT_V(8); PG8_WAIT_L(0); PG8_BAR; PG8_MMA(0, 0, At, B0); PG8_MMA(0, 1, At, B1); PG8_BAR; PG8_SCHED;
            PG8_LDA(At, 0, 1); PG8_STAGE(PG8_SB(0, 0), b2, voffB); PG8_STAGE(PG8_SB(0, 1), b2 + hstepB, voffB); PG8_STAGE(PG8_SA(0, 0), a2, voffA);
            PG8_WAIT_V(8); PG8_WAIT_L(0); PG8_BAR; PG8_MMA(1, 0, At, B0); PG8_MMA(1, 1, At, B1); PG8_BAR; PG8_SCHED;
            PG8_LDB(B0, 1, 0); PG8_LDB(B1, 1, 1); PG8_SCHED; PG8_LDA(At, 1, 0); PG8_STAGE(PG8_SA(0, 1), a2 + hstepA, voffA);
            PG8_WAIT_V(8); PG8_WAIT_L(0); PG8_BAR; PG8_MMA(0, 0, At, B0); PG8_MMA(0, 1, At, B1); PG8_BAR; PG8_SCHED;
            PG8_LDA(At, 1, 1); PG8_STAGE(PG8_SB(1, 0), b3, voffB); PG8_STAGE(PG8_SB(1, 1), b3 + hstepB, voffB); PG8_STAGE(PG8_SA(1, 0), a3, voffA);
            PG8_WAIT_V(8); PG8_WAIT_L(0); PG8_BAR; PG8_MMA(1, 0, At, B0); PG8_MMA(1, 1, At, B1); PG8_BAR; PG8_SCHED;
            } else {
            PG8_LDB(B0, 0, 0); PG8_SCHED; PG8_LDA(At, 0, 0); PG8_STAGE(PG8_SA(1, 1), a1 + hstepA, voffA);
            PG8_WAIT_L(8); PG8_BAR; PG8_WAIT_L(0); PG8_MMA(0, 0, At, B0); PG8_BAR; PG8_SCHED;
            PG8_LDB(B1, 0, 1); PG8_STAGE(PG8_SB(0, 0), b2, voffB);
            PG8_BAR; PG8_WAIT_L(0); PG8_MMA(0, 1, At, B1); PG8_BAR;
            PG8_LDA(At, 0, 1); PG8_STAGE(PG8_SA(0, 0), a2, voffA);
            PG8_BAR; PG8_WAIT_L(0); PG8_MMA(1, 0, At, B0); PG8_BAR; PG8_SCHED;
            PG8_STAGE(PG8_SB(0, 1), b2 + hstepB, voffB);
            PG8_WAIT_V(6); PG8_BAR; PG8_MMA(1, 1, At, B1); PG8_BAR;
            PG8_LDB(B0, 1, 0); PG8_SCHED; PG8_LDA(At, 1, 0); PG8_STAGE(PG8_SA(0, 1), a2 + hstepA, voffA);
            PG8_WAIT_L(8); PG8_BAR; PG8_WAIT_L(0); PG8_MMA(0, 0, At, B0); PG8_BAR; PG8_SCHED;
            PG8_LDB(B1, 1, 1); PG8_STAGE(PG8_SB(1, 0), b3, voffB);
            PG8_BAR; PG8_WAIT_L(0); PG8_MMA(0, 1, At, B1); PG8_BAR;
            PG8_LDA(At, 1, 1); PG8_STAGE(PG8_SA(1, 0), a3, voffA);
            PG8_BAR; PG8_WAIT_L(0); PG8_MMA(1, 0, At, B0); PG8_BAR; PG8_SCHED;
            PG8_STAGE(PG8_SB(1, 1), b3 + hstepB, voffB);
            PG8_WAIT_V(6); PG8_BAR; PG8_MMA(1, 1, At, B1); PG8_BAR;
            }
        }
        if constexpr (ALIGN_EPI) { if (wr == 0) PG8_BAR; }
        { int l2 = lane_id(); asm volatile("" : "+v"(l2));
          if constexpr (Epi::CARRY) { E(acc, cur, wr, wc, l2 & 15, l2 >> 4, carry, (wid << 6) | l2); if (has_next) carry = E.pre(nxt, (wid << 6) | l2); }
          else E(acc, cur, wr, wc, l2 & 15, l2 >> 4); }
        S.done(cur);
        if (!has_next) break;
        bool zero_acc = true;
        if constexpr (Epi::KEEP) zero_acc = !E.keep(cur);
        if (zero_acc) {
#pragma unroll
        for (int a = 0; a < 2; ++a)
#pragma unroll
            for (int b = 0; b < 2; ++b)
#pragma unroll
                for (int m = 0; m < 4; ++m)
#pragma unroll
                    for (int n = 0; n < 2; ++n) acc[a][b][m][n] = (f32x4){0.f, 0.f, 0.f, 0.f};
        }
        cur = nxt; cA = nA; cB = nB; ++ui;
        if constexpr (ALIGN_EPI) { if (wr == 1) PG8_BAR; }
    }
    PG8_WAIT_V(0);
    if constexpr (!ALIGN_EPI) { if (wr == 0) PG8_BAR; }
    PG8_BAR;
#undef PG8_SA
#undef PG8_SB
#undef PG8_STAGE
#undef PG8_LDA
#undef PG8_LDB
#undef PG8_MMA
#undef PG8_WAIT_V
#undef PG8_WAIT_L
#undef PG8_BAR
#undef PG8_SCHED
}
}

#ifndef PG8_SP2
#define PG8_SP2 true
#endif
#ifndef PG8_ALIGN
#define PG8_ALIGN true
#endif
using pg8::Unit;
typedef const f32x4 (&AccRef)[2][2][4][2];
typedef f32x4 (&AccMut)[2][2][4][2];

__device__ __forceinline__ float act_one(float x, float c1, float c3, float off, bool mulx) {
    const float t = fmaf(x, fmaf(c3, x * x, c1), off);
    const float e = __builtin_amdgcn_exp2f(t * -1.4426950408889634f);
    const float sg = __builtin_amdgcn_rcpf(1.0f + e);
    return (mulx ? x : 1.0f) * sg;
}
template <bool SCALE> __device__ __forceinline__ void epi1_gate(AccRef acc, bf16* P, const float* bgate, const LAS float* rs, int pm, int t, int wr, int wc, int fr, int fq) {
    const int row0 = pm * 256 + wr * 64 + fr, cw = t * 128 + wc * 32 + 8 * fq;
    float rsv[2][4];
#pragma unroll
    for (int ai = 0; ai < 2; ++ai)
#pragma unroll
        for (int m = 0; m < 4; ++m) rsv[ai][m] = SCALE ? rs[wr * 64 + fr + ai * 128 + m * 16] : 1.0f;
    f32x4 ba[2], bb[2];
#pragma unroll
    for (int n = 0; n < 2; ++n) { ba[n] = *(const f32x4*)(bgate + cw + 4 * n) * -1.4426950408889634f; bb[n] = *(const f32x4*)(bgate + DM + cw + 4 * n) * -1.4426950408889634f; }
#pragma unroll
    for (int ai = 0; ai < 2; ++ai)
#pragma unroll
        for (int m = 0; m < 4; ++m) {
            const int row = row0 + ai * 128 + m * 16; bf16* rowp = P + (size_t)row * LDP + cw;
            float orr[8], og[8];
#pragma unroll
            for (int n = 0; n < 2; ++n)
#pragma unroll
                for (int j = 0; j < 4; ++j) { const float xa = SCALE ? acc[ai][0][m][n][j] * rsv[ai][m] : acc[ai][0][m][n][j], xb = SCALE ? acc[ai][1][m][n][j] * rsv[ai][m] : acc[ai][1][m][n][j];
                    const float da = 1.0f + __builtin_amdgcn_exp2f(fmaf(xa, -1.4426950408889634f, ba[n][j]));
                    const float db = 1.0f + __builtin_amdgcn_exp2f(fminf(fmaf(xb, -1.4426950408889634f, bb[n][j]), 64.0f));
                    og[4 * n + j] = __builtin_amdgcn_rcpf(db); orr[4 * n + j] = db * __builtin_amdgcn_rcpf(da); }
            v4u w; w.x = cvt_pk_bf16(orr[0], orr[1]); w.y = cvt_pk_bf16(orr[2], orr[3]); w.z = cvt_pk_bf16(orr[4], orr[5]); w.w = cvt_pk_bf16(orr[6], orr[7]);
            *(v4u*)(rowp + C_GA) = w;
            v4u g; g.x = cvt_pk_bf16(og[0], og[1]); g.y = cvt_pk_bf16(og[2], og[3]); g.z = cvt_pk_bf16(og[4], og[5]); g.w = cvt_pk_bf16(og[6], og[7]);
            *(v4u*)(rowp + C_GB) = g;
        }
}
template <int MODE, bool STATS, bool SCALE> __device__ __forceinline__ void epi1_body(AccRef acc, bf16* P, const float* bgate, f32x2* part, const LAS float* rs, int pm, int pn, int wr, int wc, int fr, int fq) {
    const int row0 = pm * 256 + wr * 64 + fr, col0 = pn * 256 + wc * 32 + 8 * fq;
    float rsv[2][4];
#pragma unroll
    for (int ai = 0; ai < 2; ++ai)
#pragma unroll
        for (int m = 0; m < 4; ++m) rsv[ai][m] = SCALE ? rs[wr * 64 + fr + ai * 128 + m * 16] : 1.0f;
    f32x4 bv[2][2];
    if (MODE == 3) {
#pragma unroll
        for (int bj = 0; bj < 2; ++bj)
#pragma unroll
            for (int n = 0; n < 2; ++n) bv[bj][n] = *(const f32x4*)(bgate + (col0 - C_GA) + bj * 128 + 4 * n) * -1.4426950408889634f;
    }
#pragma unroll
    for (int ai = 0; ai < 2; ++ai)
#pragma unroll
        for (int m = 0; m < 4; ++m) {
            const int row = row0 + ai * 128 + m * 16; bf16* rowp = P + (size_t)row * LDP + col0; float rs = 0.f, rq = 0.f;
#pragma unroll
            for (int bj = 0; bj < 2; ++bj) {
                float o[8];
#pragma unroll
                for (int n = 0; n < 2; ++n)
#pragma unroll
                    for (int j = 0; j < 4; ++j) { const float x = SCALE ? acc[ai][bj][m][n][j] * rsv[ai][m] : acc[ai][bj][m][n][j]; float r;
                        if (MODE == 0) { const float t = x * fmaf(-0.10294324576f, x * x, -2.3022081985f); r = x * __builtin_amdgcn_rcpf(1.0f + __builtin_amdgcn_exp2f(t)); }
                        else if (MODE == 1) { r = x * __builtin_amdgcn_rcpf(1.0f + __builtin_amdgcn_exp2f(x * -1.4426950408889634f)); }
                        else if (MODE == 2) { r = x; }
                        else { r = __builtin_amdgcn_rcpf(1.0f + __builtin_amdgcn_exp2f(fmaf(x, -1.4426950408889634f, bv[bj][n][j]))); }
                        o[4 * n + j] = r; if (STATS) { rs += r; rq += r * r; } }
                v4u w; w.x = cvt_pk_bf16(o[0], o[1]); w.y = cvt_pk_bf16(o[2], o[3]); w.z = cvt_pk_bf16(o[4], o[5]); w.w = cvt_pk_bf16(o[6], o[7]);
                *(v4u*)(rowp + bj * 128) = w;
            }
            if (STATS) { rs += __shfl_xor(rs, 16); rs += __shfl_xor(rs, 32); rq += __shfl_xor(rq, 16); rq += __shfl_xor(rq, 32);
                if (fq == 0) part[(size_t)((pn - 8) * 4 + wc) * MTOT + row] = (f32x2){rs, rq}; }
        }
}
template <bool SCALE> struct Epi1 {
    static constexpr bool PERM = true; static constexpr bool KEEP = false; static constexpr bool CARRY = SCALE;
    bf16* P; const float* bgate; f32x2* part; const float* rs; LAS float* rsl;
    __device__ __forceinline__ float pre(const Unit& u, int tid) const { return rs[u.pm * 256 + (tid & 255)]; }
    __device__ __forceinline__ void body(AccRef acc, const Unit& u, int wr, int wc, int fr, int fq) const {
        const int pn = u.pn;
        if (pn < 8) epi1_body<0, false, SCALE>(acc, P, bgate, part, rsl, u.pm, pn, wr, wc, fr, fq);
        else if (pn < 16) epi1_body<0, true, SCALE>(acc, P, bgate, part, rsl, u.pm, pn, wr, wc, fr, fq);
        else if (pn >= 40) epi1_gate<SCALE>(acc, P, bgate, rsl, u.pm, pn - 40, wr, wc, fr, fq);
        else if (pn >= 24 && pn < 32) epi1_body<2, false, SCALE>(acc, P, bgate, part, rsl, u.pm, pn, wr, wc, fr, fq);
        else epi1_body<1, false, SCALE>(acc, P, bgate, part, rsl, u.pm, pn, wr, wc, fr, fq);
    }
    __device__ __forceinline__ void operator()(AccRef acc, const Unit& u, int wr, int wc, int fr, int fq) const { body(acc, u, wr, wc, fr, fq); }
    __device__ __forceinline__ void operator()(AccRef acc, const Unit& u, int wr, int wc, int fr, int fq, float carry, int tid) const {
        if (tid < 256) rsl[tid] = carry;
        asm volatile("s_waitcnt lgkmcnt(0)" ::: "memory"); __builtin_amdgcn_s_barrier();
        body(acc, u, wr, wc, fr, fq);
    }
};
struct EpiD1 {
    static constexpr bool PERM = true; static constexpr bool KEEP = false; static constexpr bool CARRY = false;
    bf16* YT;
    __device__ __forceinline__ void operator()(AccRef acc, const Unit& u, int wr, int wc, int fr, int fq) const {
        bf16* o0 = YT + ((size_t)u.pn * 2048 + (size_t)(u.aux * 256 + wr * 64 + fr)) * 512 + u.pm * 256 + wc * 32 + 8 * fq;
#pragma unroll
        for (int ai = 0; ai < 2; ++ai)
#pragma unroll
            for (int m = 0; m < 4; ++m) { bf16* rowp = o0 + (size_t)(ai * 128 + m * 16) * 512;
#pragma unroll
                for (int bj = 0; bj < 2; ++bj) { const f32x4 v0 = acc[ai][bj][m][0] * 0.0625f, v1 = acc[ai][bj][m][1] * 0.0625f;
                    v4u w; w.x = cvt_pk_bf16(v0[0], v0[1]); w.y = cvt_pk_bf16(v0[2], v0[3]); w.z = cvt_pk_bf16(v1[0], v1[1]); w.w = cvt_pk_bf16(v1[2], v1[3]);
                    *(v4u*)(rowp + bj * 128) = w; } }
    }
};
struct EpiD2 {
    static constexpr bool PERM = true; static constexpr bool KEEP = false; static constexpr bool CARRY = false;
    bf16* P;
    __device__ __forceinline__ void operator()(AccRef acc, const Unit& u, int wr, int wc, int fr, int fq) const {
        const int rt = u.aux; int tok0, N1;
        if (rt < 64) { N1 = 8; tok0 = (rt >> 3) * 2048 + (rt & 7); } else { N1 = 16; tok0 = MPR + ((rt - 64) >> 4) * 4096 + ((rt - 64) & 15); }
        const float scale = 0.0625f;
        const size_t rstride = (size_t)N1 * LDP;
        const bf16* Pb = P + (size_t)(tok0 + N1 * (wr * 64 + fr)) * LDP + C_ZB + u.pn * 256 + wc * 32 + 8 * fq;
        v4u z[2][4][2];
#pragma unroll
        for (int ai = 0; ai < 2; ++ai)
#pragma unroll
            for (int m = 0; m < 4; ++m)
#pragma unroll
                for (int bj = 0; bj < 2; ++bj) z[ai][m][bj] = *(const v4u*)(Pb + (size_t)(ai * 128 + m * 16) * rstride + bj * 128);
        asm volatile("" ::: "memory");
#pragma unroll
        for (int ai = 0; ai < 2; ++ai)
#pragma unroll
            for (int m = 0; m < 4; ++m) { bf16* rowp = (bf16*)Pb + (size_t)(ai * 128 + m * 16) * rstride;
#pragma unroll
                for (int bj = 0; bj < 2; ++bj) { const v4u zz = z[ai][m][bj]; const f32x4 v0 = acc[ai][bj][m][0] * scale, v1 = acc[ai][bj][m][1] * scale;
                    v4u w; w.x = cvt_pk_bf16(v0[0] * bf_lo(zz.x), v0[1] * bf_hi(zz.x)); w.y = cvt_pk_bf16(v0[2] * bf_lo(zz.y), v0[3] * bf_hi(zz.y));
                    w.z = cvt_pk_bf16(v1[0] * bf_lo(zz.z), v1[1] * bf_hi(zz.z)); w.w = cvt_pk_bf16(v1[2] * bf_lo(zz.w), v1[3] * bf_hi(zz.w));
                    *(v4u*)(rowp + bj * 128) = w; } }
        asm volatile("" ::: "memory");
    }
};
struct OrderG2 {
    pg8::OrderMN o; const char* A2; const char* B2;
    __device__ __forceinline__ bool next(int i, Unit& u) const {
        if (!o.next(i >> 1, u)) return false;
        u.aux = i & 1; if (u.aux) { u.a = A2 + (size_t)u.pm * o.tA; u.b = B2 + (size_t)u.pn * o.tB; } return true; }
    __device__ __forceinline__ void a_ready(const Unit&) const {}
    __device__ __forceinline__ void done(const Unit&) const {}
};
struct Epi2G {
    static constexpr bool PERM = true; static constexpr bool KEEP = true; static constexpr bool CARRY = false;
    const bf16* P; bf16* Mb;
    __device__ __forceinline__ bool keep(const Unit& u) const { return u.aux == 0; }
    __device__ __forceinline__ void operator()(AccMut acc, const Unit& u, int wr, int wc, int fr, int fq) const {
        const int row0 = u.pm * 256 + wr * 64 + fr, col0 = u.pn * 256 + wc * 32 + 8 * fq;
        const bf16* gp = P + (size_t)row0 * LDP + (u.aux ? C_GB : C_GA) + col0;
        v4u g[2][4][2];
#pragma unroll
        for (int ai = 0; ai < 2; ++ai)
#pragma unroll
            for (int m = 0; m < 4; ++m)
#pragma unroll
                for (int bj = 0; bj < 2; ++bj) g[ai][m][bj] = *(const v4u*)(gp + (size_t)(ai * 128 + m * 16) * LDP + bj * 128);
        asm volatile("" ::: "memory");
        if (u.aux == 0) {
#pragma unroll
            for (int ai = 0; ai < 2; ++ai)
#pragma unroll
                for (int m = 0; m < 4; ++m)
#pragma unroll
                    for (int bj = 0; bj < 2; ++bj) { v4u gg = g[ai][m][bj]; asm volatile("" : "+v"(gg.x), "+v"(gg.y), "+v"(gg.z), "+v"(gg.w));
                        acc[ai][bj][m][0] *= (f32x4){bf_lo(gg.x), bf_hi(gg.x), bf_lo(gg.y), bf_hi(gg.y)}; acc[ai][bj][m][1] *= (f32x4){bf_lo(gg.z), bf_hi(gg.z), bf_lo(gg.w), bf_hi(gg.w)}; }
        } else {
#pragma unroll
            for (int ai = 0; ai < 2; ++ai)
#pragma unroll
                for (int m = 0; m < 4; ++m) { bf16* op = Mb + (size_t)(row0 + ai * 128 + m * 16) * DM + col0;
#pragma unroll
                    for (int bj = 0; bj < 2; ++bj) { v4u gg = g[ai][m][bj]; asm volatile("" : "+v"(gg.x), "+v"(gg.y), "+v"(gg.z), "+v"(gg.w)); const f32x4 a0 = acc[ai][bj][m][0], a1 = acc[ai][bj][m][1];
                        v4u w; w.x = cvt_pk_bf16(a0[0] * bf_lo(gg.x), a0[1] * bf_hi(gg.x)); w.y = cvt_pk_bf16(a0[2] * bf_lo(gg.y), a0[3] * bf_hi(gg.y));
                        w.z = cvt_pk_bf16(a1[0] * bf_lo(gg.z), a1[1] * bf_hi(gg.z)); w.w = cvt_pk_bf16(a1[2] * bf_lo(gg.w), a1[3] * bf_hi(gg.w));
                        *(v4u*)(op + bj * 128) = w; } }
            asm volatile("" ::: "memory");
        }
    }
};
struct Epi3 {
    static constexpr bool PERM = true; static constexpr bool KEEP = false; static constexpr bool CARRY = false;
    bf16* x1; float* ss;
    __device__ __forceinline__ void operator()(AccRef acc, const Unit& u, int wr, int wc, int fr, int fq) const {
        const int rt = u.pm * 256;
        const int r0 = wr * 64 + fr, col0 = u.pn * 256 + wc * 32 + 8 * fq;
        bf16* xh = x1 + (size_t)rt * DM;
        const bool want = (ss != nullptr);
        v4u xw[2][4][2];
#pragma unroll
        for (int ai = 0; ai < 2; ++ai)
#pragma unroll
            for (int m = 0; m < 4; ++m)
#pragma unroll
                for (int bj = 0; bj < 2; ++bj) xw[ai][m][bj] = *(const v4u*)(xh + (size_t)(r0 + ai * 128 + m * 16) * DM + col0 + bj * 128);
        asm volatile("" ::: "memory");
#pragma unroll
        for (int ai = 0; ai < 2; ++ai)
#pragma unroll
            for (int m = 0; m < 4; ++m) { float q = 0.f; int rr = r0 + ai * 128 + m * 16; asm volatile("" : "+v"(rr));
#pragma unroll
                for (int bj = 0; bj < 2; ++bj) { v4u w = xw[ai][m][bj]; asm volatile("" : "+v"(w.x), "+v"(w.y), "+v"(w.z), "+v"(w.w));
                    const f32x4 v0 = (f32x4){bf_lo(w.x), bf_hi(w.x), bf_lo(w.y), bf_hi(w.y)} + acc[ai][bj][m][0], v1 = (f32x4){bf_lo(w.z), bf_hi(w.z), bf_lo(w.w), bf_hi(w.w)} + acc[ai][bj][m][1];
                    q += (v0.x * v0.x + v0.y * v0.y) + (v0.z * v0.z + v0.w * v0.w) + (v1.x * v1.x + v1.y * v1.y) + (v1.z * v1.z + v1.w * v1.w);
                    v4u o; o.x = cvt_pk_bf16(v0.x, v0.y); o.y = cvt_pk_bf16(v0.z, v0.w); o.z = cvt_pk_bf16(v1.x, v1.y); o.w = cvt_pk_bf16(v1.z, v1.w);
                    *(v4u*)(xh + (size_t)rr * DM + col0 + bj * 128) = o; }
                if (want) { q += __shfl_xor(q, 16); q += __shfl_xor(q, 32); if (fq == 0) ss[(size_t)(u.pn * 4 + wc) * MTOT + rt + rr] = q; } }
        asm volatile("" ::: "memory");
    }
};

struct OrderD1 {
    int G, c; const char* D; const char* Z;
    __device__ __forceinline__ bool next(int i, Unit& u) const {
        const int L = i * G + c; if (L >= 2048) return false;
        u.pn = L >> 4; u.aux = (L >> 1) & 7; u.pm = L & 1;
        u.a = D + (size_t)u.pm * (256 * 512 * 2); u.b = Z + ((size_t)u.pn * 256 * 4096 + (size_t)u.aux * 512) * 2; return true; }
    __device__ __forceinline__ void a_ready(const Unit&) const {}
    __device__ __forceinline__ void done(const Unit&) const {}
};
struct OrderD2 {
    int G, c; const char* T; const char* YT;
    __device__ __forceinline__ bool next(int i, Unit& u) const {
        const int L = i * G + c; if (L >= 1024) return false;
        u.aux = L >> 3; u.pn = L & 7; u.pm = 0;
        u.a = T; u.b = YT + ((size_t)u.aux * 2048 + (size_t)u.pn * 256) * 512 * 2; return true; }
    __device__ __forceinline__ void a_ready(const Unit&) const {}
    __device__ __forceinline__ void done(const Unit&) const {}
};

__device__ constexpr float C16[16] = {1.0f, 0.9238795325112867f, 0.7071067811865476f, 0.3826834323650898f, 0.0f, -0.3826834323650898f, -0.7071067811865476f, -0.9238795325112867f,
                                      -1.0f, -0.9238795325112867f, -0.7071067811865476f, -0.3826834323650898f, 0.0f, 0.3826834323650898f, 0.7071067811865476f, 0.9238795325112867f};
__device__ constexpr float S16[16] = {0.0f, 0.3826834323650898f, 0.7071067811865476f, 0.9238795325112867f, 1.0f, 0.9238795325112867f, 0.7071067811865476f, 0.3826834323650898f,
                                      0.0f, -0.3826834323650898f, -0.7071067811865476f, -0.9238795325112867f, -1.0f, -0.9238795325112867f, -0.7071067811865476f, -0.3826834323650898f};
template <int N1> __device__ __forceinline__ void s1_items(const bf16* P, bf16* Z, const f32x2* TW, int row_base, int nb, int gt, int NGT) {
    constexpr int S = 256 * N1;
    const int nitems = nb * 256 * 512;
    for (int it = gt; it < nitems; it += NGT) {
        const int cg = it & 511, bn = it >> 9, n2 = bn & 255, b = bn >> 8, ch = cg * 4, g = ch >> 8, c = ch & 255;
        const bf16* src = P + (size_t)(row_base + b * S + n2) * LDP + C_XB + ch;
        float x[N1][4];
#pragma unroll
        for (int n1 = 0; n1 < N1; ++n1) { const v2u w = *(const v2u*)(src + (size_t)n1 * 256 * LDP); x[n1][0] = bf_lo(w.x); x[n1][1] = bf_hi(w.x); x[n1][2] = bf_lo(w.y); x[n1][3] = bf_hi(w.y); }
        bf16* dst = Z + (size_t)(row_base + b * S + n2) * 4096 + g * 512 + c;
#pragma unroll
        for (int k1 = 0; k1 <= N1 / 2; ++k1) {
            float re[4] = {0.f, 0.f, 0.f, 0.f}, im[4] = {0.f, 0.f, 0.f, 0.f};
#pragma unroll
            for (int n1 = 0; n1 < N1; ++n1) { const float cs = C16[((n1 * k1) % N1) * (16 / N1)], sn = S16[((n1 * k1) % N1) * (16 / N1)];
#pragma unroll
                for (int j = 0; j < 4; ++j) { re[j] = fmaf(x[n1][j], cs, re[j]); im[j] = fmaf(x[n1][j], -sn, im[j]); } }
#pragma unroll
            for (int mir = 0; mir < 2; ++mir) {
                if (mir == 1 && (k1 == 0 || k1 == N1 / 2)) continue;
                const int kk = mir ? N1 - k1 : k1;
                float imm[4];
#pragma unroll
                for (int j = 0; j < 4; ++j) imm[j] = mir ? -im[j] : im[j];
                const f32x2 tw = TW[(n2 * kk) & (S - 1)]; const float ct = tw.x, st = tw.y;
                v2u wr_, wi_;
                wr_.x = cvt_pk_bf16(re[0] * ct + imm[0] * st, re[1] * ct + imm[1] * st); wr_.y = cvt_pk_bf16(re[2] * ct + imm[2] * st, re[3] * ct + imm[3] * st);
                wi_.x = cvt_pk_bf16(imm[0] * ct - re[0] * st, imm[1] * ct - re[1] * st); wi_.y = cvt_pk_bf16(imm[2] * ct - re[2] * st, imm[3] * ct - re[3] * st);
                *(v2u*)(dst + (size_t)kk * 256 * 4096) = wr_; *(v2u*)(dst + (size_t)kk * 256 * 4096 + 256) = wi_;
            }
        }
    }
}

#define XB_TMO      128
#define XB_XCNT(j)  (256  + 64 * (j))
#define XB_XSUB(j)  (1280 + 64 * (j))
#define XB_XGEN(j)  (2304 + 64 * (j))
#define XB_TOP      3328
#define XB_TOPGEN   3392
#define XCD_BAR_WORDS 3456
#define XB_SPIN_CAP (1u << 18)
__device__ __forceinline__ unsigned xb_ld(unsigned* p)              { return __hip_atomic_load(p, __ATOMIC_RELAXED, __HIP_MEMORY_SCOPE_AGENT); }
__device__ __forceinline__ unsigned xb_add(unsigned* p, unsigned v) { return __hip_atomic_fetch_add(p, v, __ATOMIC_RELAXED, __HIP_MEMORY_SCOPE_AGENT); }
__device__ __forceinline__ unsigned xb_xcc_id() { return (unsigned)__builtin_amdgcn_s_getreg((3 << 11) | 20) & 0xFu; }
#define XB_SPIN(cond, bar) do { unsigned _sp = 0; while (cond) { __builtin_amdgcn_s_sleep(1); \
    if ((++_sp & 255u) == 0u) { if (xb_ld(&(bar)[XB_TMO])) break; if (_sp > XB_SPIN_CAP) { atomicAdd(&(bar)[XB_TMO], 1u); break; } } } } while (0)
struct XcdBarrier { unsigned* bar; unsigned x; volatile LAS unsigned* st; };
__device__ __forceinline__ XcdBarrier xcd_barrier_post(unsigned* bar, volatile LAS unsigned* st, bool leader) {
    XcdBarrier b; b.bar = bar; b.x = xb_xcc_id(); b.st = st;
    if (leader) (void)xb_add(&bar[XB_XCNT(b.x)], 1u);
    return b;
}
__device__ __forceinline__ void xcd_barrier_complete(unsigned* bar, unsigned x, unsigned& nloc, unsigned& nx) {
    const unsigned G = gridDim.x * gridDim.y * gridDim.z;
    unsigned sum, cnt, mine, sp = 0u;
    for (;;) {
        sum = 0u; cnt = 0u; mine = 0u;
#pragma unroll
        for (unsigned j = 0; j < 16; ++j) { const unsigned c = xb_ld(&bar[XB_XCNT(j)]); sum += c; cnt += (c > 0u) ? 1u : 0u; mine = (j == x) ? c : mine; }
        if (sum == G) break;
        __builtin_amdgcn_s_sleep(1);
        if ((++sp & 255u) == 0u) { if (xb_ld(&bar[XB_TMO])) break; if (sp > XB_SPIN_CAP) { atomicAdd(&bar[XB_TMO], 1u); break; } }
    }
    nloc = mine > 0u ? mine : 1u; nx = cnt > 0u ? cnt : 1u;
}
__device__ __forceinline__ void xcd_barrier(const XcdBarrier& b, bool leader) {
    asm volatile("s_waitcnt vmcnt(0)" ::: "memory");
    __syncthreads();
    if (leader) {
        unsigned* bar = b.bar;
        __builtin_amdgcn_s_waitcnt(0);
        unsigned nloc = b.st[0], nx = b.st[1];
        if (nloc == 0u) { xcd_barrier_complete(bar, b.x, nloc, nx); b.st[0] = nloc; b.st[1] = nx; }
        const unsigned old = xb_add(&bar[XB_XSUB(b.x)], 1u);
        const unsigned gen = old / nloc;
        if (old + 1u == (gen + 1u) * nloc) {
            __builtin_amdgcn_fence(__ATOMIC_RELEASE, "agent");
            asm volatile("s_waitcnt vmcnt(0)" ::: "memory");
            const unsigned og = xb_add(&bar[XB_TOP], 1u);
            const unsigned tg = og / nx;
            if (og + 1u == (tg + 1u) * nx) xb_add(&bar[XB_TOPGEN], 1u);
            else XB_SPIN(xb_ld(&bar[XB_TOPGEN]) == tg, bar);
            __builtin_amdgcn_fence(__ATOMIC_ACQUIRE, "agent");
            xb_add(&bar[XB_XGEN(b.x)], 1u);
            asm volatile("s_waitcnt vmcnt(0)" ::: "memory");
        } else {
            XB_SPIN(xb_ld(&bar[XB_XGEN(b.x)]) == gen, bar);
            __builtin_amdgcn_fence(__ATOMIC_ACQUIRE, "agent");
            asm volatile("s_waitcnt vmcnt(0)" ::: "memory");
        }
    }
    __syncthreads();
}

__device__ __forceinline__ float wave_sum(float v) {
#pragma unroll
    for (int o = 1; o < 64; o <<= 1) v += __shfl_xor(v, o);
    return v;
}
__device__ __forceinline__ void p0_transpose_item(const float* W, int K, int N, bf16* WT, LAS float* scr, int item, int lane, bool deal = false, const float* gk = nullptr) {
    const int nblk = N / 32, kb = item / nblk, nb = item % nblk, k0 = 64 * kb, n0 = 32 * nb;
    f32x4 wv[8];
#pragma unroll
    for (int i = 0; i < 8; ++i) wv[i] = *(const f32x4*)(W + (size_t)(k0 + 8 * i + (lane >> 3)) * N + n0 + 4 * (lane & 7));
#pragma unroll
    for (int i = 0; i < 8; ++i) { LAS float* d = scr + (8 * i + (lane >> 3)) * 33 + 4 * (lane & 7); d[0] = wv[i].x; d[1] = wv[i].y; d[2] = wv[i].z; d[3] = wv[i].w; }
    LDS_WAIT(); asm volatile("" ::: "memory");
    const int c = lane & 7;
    f32x4 ga = {1.f, 1.f, 1.f, 1.f}, gb = {1.f, 1.f, 1.f, 1.f};
    if (gk) { ga = *(const f32x4*)(gk + k0 + 8 * c); gb = *(const f32x4*)(gk + k0 + 8 * c + 4); }
    int nd = n0;
    if (deal && n0 >= C_GA) { const int g = n0 - C_GA, hb = (g >= DM) ? 1 : 0, gg = g - hb * DM; nd = C_GA + ((gg >> 7) << 8) + hb * 128 + (gg & 127); }
#pragma unroll
    for (int j = 0; j < 4; ++j) { const int n = (lane >> 3) + 8 * j; const LAS float* s = scr + (8 * c) * 33 + n;
        v4u o; o.x = pk2(s[0 * 33] * ga.x, s[1 * 33] * ga.y); o.y = pk2(s[2 * 33] * ga.z, s[3 * 33] * ga.w); o.z = pk2(s[4 * 33] * gb.x, s[5 * 33] * gb.y); o.w = pk2(s[6 * 33] * gb.z, s[7 * 33] * gb.w);
        *(GAS v4u*)(WT + (size_t)(nd + n) * K + k0 + 8 * c) = o; }
    LDS_WAIT(); asm volatile("" ::: "memory");
}
__device__ __forceinline__ void x_row_to_bf16(const float* xrow, bf16* orow, float* rs, int lane) {
    const GAS f32x4* xr = (const GAS f32x4*)xrow + lane;
    f32x4 v[16]; float s = 0.f;
#pragma unroll
    for (int j = 0; j < 16; ++j) { v[j] = xr[64 * j]; s += (v[j].x * v[j].x + v[j].y * v[j].y) + (v[j].z * v[j].z + v[j].w * v[j].w); }
    const float rstd = 1.0f / sqrtf(wave_sum(s) * (1.0f / DM) + EPS);
    GAS v2u* o8 = (GAS v2u*)orow + lane;
#pragma unroll
    for (int j = 0; j < 16; ++j) { v2u w; w.x = cvt_pk_bf16(v[j].x, v[j].y); w.y = cvt_pk_bf16(v[j].z, v[j].w); o8[64 * j] = w; }
    if (lane == 0) *rs = rstd;
}
__device__ __forceinline__ void rms_row_bf16_to_f32(const bf16* xrow, const f32x4 (&g8)[8][2], float* orow, int lane) {
    const GAS v4u* xr = (const GAS v4u*)xrow + lane;
    v4u w[8]; float s = 0.f;
#pragma unroll
    for (int j = 0; j < 8; ++j) w[j] = xr[64 * j];
#pragma unroll
    for (int j = 0; j < 8; ++j) { const float a0 = bf_lo(w[j].x), a1 = bf_hi(w[j].x), a2 = bf_lo(w[j].y), a3 = bf_hi(w[j].y), a4 = bf_lo(w[j].z), a5 = bf_hi(w[j].z), a6 = bf_lo(w[j].w), a7 = bf_hi(w[j].w);
        s += (a0 * a0 + a1 * a1) + (a2 * a2 + a3 * a3) + (a4 * a4 + a5 * a5) + (a6 * a6 + a7 * a7); }
    const float rstd = 1.0f / sqrtf(wave_sum(s) * (1.0f / DM) + EPS);
    GAS f32x4* o = (GAS f32x4*)orow + 2 * lane;
#pragma unroll
    for (int j = 0; j < 8; ++j) { const f32x4 ga = g8[j][0] * rstd, gb = g8[j][1] * rstd;
        o[128 * j] = (f32x4){bf_lo(w[j].x) * ga.x, bf_hi(w[j].x) * ga.y, bf_lo(w[j].y) * ga.z, bf_hi(w[j].y) * ga.w};
        o[128 * j + 1] = (f32x4){bf_lo(w[j].z) * gb.x, bf_hi(w[j].z) * gb.y, bf_lo(w[j].w) * gb.z, bf_hi(w[j].w) * gb.w}; }
}

struct Args { const float* in[13]; float* out; unsigned char* ws; int ph_lo, ph_hi, li, pad; };
typedef __attribute__((address_space(4))) const Args CArgs;
#define PHASE_BEGIN() \
    unsigned oz_ = 0u; asm volatile("" : "+s"(oz_));              \
    CArgs* AP = (CArgs*)((__attribute__((address_space(4))) const char*)__builtin_amdgcn_kernarg_segment_ptr() + oz_); \
    int t_ = (wave0 << 6) | (int)__builtin_amdgcn_mbcnt_hi(~0u, __builtin_amdgcn_mbcnt_lo(~0u, oz_)); asm volatile("" : "+v"(t_));       \
    const int tid = t_, lane = tid & 63, wave = __builtin_amdgcn_readfirstlane(tid >> 6); \
    int G = G0, vcu = vcu0, bx = bx0; asm volatile("" : "+s"(G), "+s"(vcu), "+s"(bx)); (void)bx; \
    unsigned char* ws = AP->ws; float* out = AP->out; (void)lane; (void)wave; (void)out; \
    const int gw = vcu * NWAVES + wave, NGW = G * NWAVES, gt = vcu * (NWAVES * 64) + tid, NGT = G * NWAVES * 64; (void)gw; (void)NGW; (void)gt; (void)NGT

__global__ void __launch_bounds__(NWAVES * 64, 2) trunk_fwd(Args args) {
    extern __shared__ __attribute__((aligned(16))) unsigned char lds_raw[];
    LAS unsigned char* lds = (LAS unsigned char*)lds_raw;
    const int G0 = gridDim.x, bx0 = blockIdx.x; const int vcu0 = (G0 % 8 == 0) ? (bx0 % 8) * (G0 / 8) + bx0 / 8 : bx0;
    const int wave0 = __builtin_amdgcn_readfirstlane(threadIdx.x >> 6);
    for (int u = threadIdx.x; u < (LDS_BYTES - LDSCTL_OFF) / 4; u += NWAVES * 64) ((LAS unsigned*)(lds + LDSCTL_OFF))[u] = 0u;
    __syncthreads();
#if !MK_PER_PHASE
    (void)xcd_barrier_post((unsigned*)(args.ws + WS_CTL) + CW_BAR, (volatile LAS unsigned*)(lds + MISC_OFF) + 8, threadIdx.x == 0);
#define GRID_BAR() do { unsigned ozb_ = 0u; asm volatile("" : "+s"(ozb_)); \
        CArgs* AB_ = (CArgs*)((__attribute__((address_space(4))) const char*)__builtin_amdgcn_kernarg_segment_ptr() + ozb_); \
        XcdBarrier b_; b_.bar = (unsigned*)(AB_->ws + WS_CTL) + CW_BAR; b_.x = xb_xcc_id(); b_.st = (volatile LAS unsigned*)(lds + MISC_OFF) + 8; xcd_barrier(b_, wave0 == 0 && lane_id() == 0); } while (0)
#else
#define GRID_BAR() do { } while (0)
#endif
    const int lo = args.ph_lo, hi = args.ph_hi;
#define IN(k) (lo <= (k) && (k) < hi)
#define BOTH(k) (IN(k) && IN((k) + 1))

    if (IN(0)) {
        PHASE_BEGIN();
            bf16* DC = (bf16*)(ws + WS_DC); bf16* TT = (bf16*)(ws + WS_T);
            for (int e = gt; e < 512 * 512 / 8; e += NGT) { const int r = e >> 6, q0 = (e & 63) * 8; const int po = r >> 8, m = r & 255, pi = q0 >> 8, c0 = q0 & 255; float v[8];
#pragma unroll
                for (int j = 0; j < 8; ++j) { const float ph = (float)((m * (c0 + j)) & 255) * (1.0f / 128.0f); v[j] = (po == pi) ? cospif(ph) : ((po == 0) ? sinpif(ph) : -sinpif(ph)); }
                v4u w; w.x = pk2(v[0], v[1]); w.y = pk2(v[2], v[3]); w.z = pk2(v[4], v[5]); w.w = pk2(v[6], v[7]); *(GAS v4u*)(DC + (size_t)e * 8) = w; }
            for (int e = gt; e < 256 * 512 / 8; e += NGT) { const int k2 = e >> 6, q0 = (e & 63) * 8; const int pi = q0 >> 8, n0 = q0 & 255; float v[8];
#pragma unroll
                for (int j = 0; j < 8; ++j) { const float ph = (float)((k2 * (n0 + j)) & 255) * (1.0f / 128.0f); v[j] = pi ? sinpif(ph) : cospif(ph); }
                v4u w; w.x = pk2(v[0], v[1]); w.y = pk2(v[2], v[3]); w.z = pk2(v[4], v[5]); w.w = pk2(v[6], v[7]); *(GAS v4u*)(TT + (size_t)e * 8) = w; }

        { f32x2* TW = (f32x2*)(ws + WS_TW);
          for (int e = gt; e < 2048 + 4096; e += NGT) { const bool big = e >= 2048; const int j = big ? e - 2048 : e; const float ph = (float)j * (big ? (2.0f / 4096.0f) : (2.0f / 2048.0f)), sc = big ? 0.25f : 0.35355339059327373f;
              TW[e] = (f32x2){cospif(ph) * sc, sinpif(ph) * sc}; } }
    }

    for (int l = 0; l < 2; ++l) {
        const int pb = 7 * l;

        if (IN(pb + 0)) {
            PHASE_BEGIN();
            const float* norm_g = AP->in[2] + (size_t)l * DM;
            const float* w_in = AP->in[3] + (size_t)l * DM * DIN;
            const float* w_a = AP->in[8] + (size_t)l * DA * DM;
            const float* w_b = AP->in[9] + (size_t)l * DB * DM;
            const float* w_out = AP->in[11] + (size_t)l * DM * DM;
            bf16* W1T = (bf16*)(ws + WS_W1T); bf16* WAT = (bf16*)(ws + WS_WAT); bf16* WBT = (bf16*)(ws + WS_WBT); bf16* WOT = (bf16*)(ws + WS_WOT);
            LAS float* scr = (LAS float*)(lds + RING_OFF + wave * 16384);
            constexpr int I_1 = (DM / 64) * (DIN / 32), I_A = (DA / 64) * (DM / 32), I_O = (DM / 64) * (DM / 32);
            constexpr int NITEMS = I_1 + 2 * I_A + I_O;
            for (int it = gw; it < NITEMS; it += NGW) {
                int r = it;
                if (r < I_1) { p0_transpose_item(w_in, DM, DIN, W1T, scr, r, lane, true, norm_g); continue; } r -= I_1;
                if (r < I_A) { p0_transpose_item(w_a, DA, DM, WAT, scr, r, lane); continue; } r -= I_A;
                if (r < I_A) { p0_transpose_item(w_b, DB, DM, WBT, scr, r, lane); continue; } r -= I_A;
                p0_transpose_item(w_out, DM, DM, WOT, scr, r, lane);
            }
            if (l == 0) {
                const float* x_prompt = AP->in[0]; const float* x_sample = AP->in[1];
                bf16* X0 = (bf16*)(ws + WS_X1); float* RS0 = (float*)(ws + WS_RSTD);
                for (int m = gw; m < MTOT; m += NGW) {
                    const float* xrow = (m < MPR) ? x_prompt + (size_t)m * DM : x_sample + (size_t)(m - MPR) * DM;
                    x_row_to_bf16(xrow, X0 + (size_t)m * DM, RS0 + m, lane);
                }
            } else {
                float* RS = (float*)(ws + WS_RSTD); const float* SS = (const float*)(ws + WS_PART);
                for (int m = gt; m < MTOT; m += NGT) { float s = 0.f;
#pragma unroll 16
                    for (int j = 0; j < 64; ++j) s += SS[(size_t)j * MTOT + m];
                    RS[m] = 1.0f / sqrtf(s * (1.0f / DM) + EPS); }
            }
            { const float* wsp = AP->in[6] + (size_t)l * 16 * 128 * 128; bf16* wspb = (bf16*)(ws + WS_WSP);
              for (int e = gt; e < 16 * 128 * 128 / 8; e += NGT) { const f32x4 a = *(const f32x4*)(wsp + (size_t)e * 8), b = *(const f32x4*)(wsp + (size_t)e * 8 + 4);
                  v4u o; o.x = cvt_pk_bf16(a.x, a.y); o.y = cvt_pk_bf16(a.z, a.w); o.z = cvt_pk_bf16(b.x, b.y); o.w = cvt_pk_bf16(b.z, b.w); *(v4u*)(wspb + (size_t)e * 8) = o; } }
            VM_WAIT(); __syncthreads();
            if (BOTH(pb + 0)) GRID_BAR();
        }

        if (IN(pb + 1)) {
            PHASE_BEGIN();
            pg8::OrderMN S; S.init(MTOT / 256, DIN / 256, G, bx, ws + WS_X1, (size_t)256 * DM * 2, ws + WS_W1T, (size_t)256 * DM * 2);
            Epi1<true> E{(bf16*)(ws + WS_P), AP->in[10] + (size_t)l * 2 * DM, (f32x2*)(ws + WS_PART), (const float*)(ws + WS_RSTD), (LAS float*)(lds + RS_OFF)};
            pg8::gemm_phase<Epi1<true>, pg8::OrderMN, PG8_ALIGN, PG8_SP2>(wave0, lds + RING_OFF, DM, DM, DM, S, E);
            if (BOTH(pb + 1)) GRID_BAR();
        }

        if (IN(pb + 2)) {
            PHASE_BEGIN();
            const float* ln_g = AP->in[4] + (size_t)l * DA;
            const float* ln_b = AP->in[5] + (size_t)l * DA;
            const float* w_sp = AP->in[6] + (size_t)l * 16 * 128 * 128;
            const float* b_sp = AP->in[7] + (size_t)l * 16 * 128;
            bf16* P = (bf16*)(ws + WS_P); const f32x2* PART = (const f32x2*)(ws + WS_PART);
            LAS unsigned char* tile = lds + RING_OFF;
            LAS float* red = (LAS float*)(lds + RING_OFF + 65536);
            LAS float* st = (LAS float*)(lds + STAT_OFF);
            const int fr = lane & 15, g4 = lane >> 4, wp = wave >> 1, wcx = wave & 1;
            for (int chunk = vcu; chunk < 256; chunk += G) {
                const int r0 = chunk * 128;
                { const int row = tid & 127, grp = tid >> 7; float s = 0.f, q = 0.f;
#pragma unroll
                  for (int k = 0; k < 8; ++k) { const f32x2 p = PART[(size_t)(grp * 8 + k) * MTOT + r0 + row]; s += p.x; q += p.y; }
                  red[(grp * 128 + row) * 2] = s; red[(grp * 128 + row) * 2 + 1] = q; }
                __syncthreads();
                if (tid < 128) { float s = 0.f, q = 0.f;
#pragma unroll
                    for (int k = 0; k < 4; ++k) { s += red[(k * 128 + tid) * 2]; q += red[(k * 128 + tid) * 2 + 1]; }
                    const float mu = s * (1.0f / DA); const float var = q * (1.0f / DA) - mu * mu; st[tid] = mu; st[128 + tid] = 1.0f / sqrtf(var + EPS); }
                const int sq = tid >> 2, spart = tid & 3;
                const bf16* gsrc = P + (size_t)(r0 + sq) * LDP + C_GV + spart * 32;
                v4u gr[4];
#pragma unroll
                for (int j = 0; j < 4; ++j) gr[j] = *(const v4u*)(gsrc + 8 * j);
                for (int head = 0; head < 16; ++head) {
                    const int cc0 = head * 128;
                    int th_ = tid; asm volatile("" : "+v"(th_));
                    const int fr = th_ & 15, g4 = (th_ >> 4) & 3, sq = th_ >> 2, spart = th_ & 3;
                    const bf16* gsrc = P + (size_t)(r0 + sq) * LDP + C_GV + spart * 32;
                    __syncthreads();
#pragma unroll
                    for (int j = 0; j < 4; ++j) *(LAS v4u*)(tile + sq * 288 + spart * 64 + 16 * j) = gr[j];
                    __syncthreads();
                    v4u w8r[2][4]; float bsr[2];
                    { const bf16* wsrc0 = (const bf16*)(ws + WS_WSP) + (size_t)head * 128 * 128;
#pragma unroll
                      for (int pj = 0; pj < 2; ++pj) { const int p = 32 * wp + 16 * pj + fr; bsr[pj] = b_sp[head * 128 + p];
#pragma unroll
                          for (int ks = 0; ks < 4; ++ks) w8r[pj][ks] = *(const v4u*)(wsrc0 + p * 128 + 32 * ks + 8 * g4); } }
                    asm volatile("" ::: "memory");
                    if (head + 1 < 16) {
#pragma unroll
                        for (int j = 0; j < 4; ++j) gr[j] = *(const v4u*)(gsrc + (cc0 + 128) + 8 * j);
                    }
                    v4u uq[2][2], zq[2][2];
#pragma unroll
                    for (int a2 = 0; a2 < 2; ++a2) { const int c = 64 * wcx + 32 * a2 + 8 * g4;
#pragma unroll
                        for (int pj = 0; pj < 2; ++pj) { const bf16* up = P + (size_t)(r0 + 32 * wp + 16 * pj + fr) * LDP + cc0 + c; uq[a2][pj] = *(const v4u*)(up + C_U); zq[a2][pj] = *(const v4u*)(up + C_ZA); } }
                    bf16x8 wf[2][4]; float av[2], w1v[2], bsv[2];
                    const bf16* wsrc = (const bf16*)(ws + WS_WSP) + (size_t)head * 128 * 128;
#pragma unroll
                    for (int pj = 0; pj < 2; ++pj) { const int p = 32 * wp + 16 * pj + fr; float ap = 0.f, w1 = 0.f;
#pragma unroll
                        for (int ks = 0; ks < 4; ++ks) { const int q0 = 32 * ks + 8 * g4;
                            const v4u w8 = w8r[pj][ks];
                            const f32x4 wa = {bf_lo(w8.x), bf_hi(w8.x), bf_lo(w8.y), bf_hi(w8.y)}, wb = {bf_lo(w8.z), bf_hi(w8.z), bf_lo(w8.w), bf_hi(w8.w)};
                            const f32x4 ra = *(const LAS f32x4*)(st + 128 + q0), rb = *(const LAS f32x4*)(st + 128 + q0 + 4);
                            const f32x4 ma = *(const LAS f32x4*)(st + q0), mb = *(const LAS f32x4*)(st + q0 + 4);
                            const f32x4 sa = wa * ra, sb = wb * rb;
                            ap += (sa.x * ma.x + sa.y * ma.y) + (sa.z * ma.z + sa.w * ma.w) + (sb.x * mb.x + sb.y * mb.y) + (sb.z * mb.z + sb.w * mb.w);
                            w1 += (wa.x + wa.y) + (wa.z + wa.w) + (wb.x + wb.y) + (wb.z + wb.w);
                            v4u pk; pk.x = cvt_pk_bf16(sa.x, sa.y); pk.y = cvt_pk_bf16(sa.z, sa.w); pk.z = cvt_pk_bf16(sb.x, sb.y); pk.w = cvt_pk_bf16(sb.z, sb.w);
                            wf[pj][ks] = __builtin_bit_cast(bf16x8, pk); }
                        ap += __shfl_xor(ap, 16); ap += __shfl_xor(ap, 32); w1 += __shfl_xor(w1, 16); w1 += __shfl_xor(w1, 32);
                        av[pj] = ap; w1v[pj] = w1; bsv[pj] = bsr[pj]; }
                    f32x4 acc[4][2];
#pragma unroll
                    for (int ci = 0; ci < 4; ++ci)
#pragma unroll
                        for (int pj = 0; pj < 2; ++pj) acc[ci][pj] = (f32x4){0.f, 0.f, 0.f, 0.f};
                    const int trq = fr >> 2, trp = fr & 3;
#pragma unroll
                    for (int ci = 0; ci < 4; ++ci)
#pragma unroll
                        for (int ks = 0; ks < 4; ++ks) {
                            typedef short v4s __attribute__((ext_vector_type(4)));
                            const LAS unsigned char* ta = tile + (32 * ks + 8 * g4 + trq) * 288 + (64 * wcx + 32 * (ci >> 1) + 4 * (ci & 1)) * 2 + 16 * trp;
                            const v4s t0 = __builtin_amdgcn_ds_read_tr16_b64_v4i16((LAS v4s*)ta);
                            const v4s t1 = __builtin_amdgcn_ds_read_tr16_b64_v4i16((LAS v4s*)(ta + 4 * 288));
                            const bf16x8 gf = {t0[0], t0[1], t0[2], t0[3], t1[0], t1[1], t1[2], t1[3]};
#pragma unroll
                            for (int pj = 0; pj < 2; ++pj) acc[ci][pj] = __builtin_amdgcn_mfma_f32_16x16x32_bf16(gf, wf[pj][ks], acc[ci][pj], 0, 0, 0);
                        }
#pragma unroll
                    for (int a2 = 0; a2 < 2; ++a2) { const int c = 64 * wcx + 32 * a2 + 8 * g4;
                        const f32x4 gam0 = *(const f32x4*)(ln_g + cc0 + c), bet0 = *(const f32x4*)(ln_b + cc0 + c), gam1 = *(const f32x4*)(ln_g + cc0 + c + 4), bet1 = *(const f32x4*)(ln_b + cc0 + c + 4);
#pragma unroll
                        for (int pj = 0; pj < 2; ++pj) { const int p = 32 * wp + 16 * pj + fr; bf16* up = P + (size_t)(r0 + p) * LDP + cc0 + c;
                            const v4u u4 = uq[a2][pj], z4 = zq[a2][pj];
                            const f32x4 mx0 = gam0 * (acc[2 * a2][pj] - av[pj]) + bet0 * w1v[pj] + bsv[pj], mx1 = gam1 * (acc[2 * a2 + 1][pj] - av[pj]) + bet1 * w1v[pj] + bsv[pj];
                            v4u o; o.x = cvt_pk_bf16(bf_lo(u4.x) * mx0.x * bf_lo(z4.x), bf_hi(u4.x) * mx0.y * bf_hi(z4.x)); o.y = cvt_pk_bf16(bf_lo(u4.y) * mx0.z * bf_lo(z4.y), bf_hi(u4.y) * mx0.w * bf_hi(z4.y));
                            o.z = cvt_pk_bf16(bf_lo(u4.z) * mx1.x * bf_lo(z4.z), bf_hi(u4.z) * mx1.y * bf_hi(z4.z)); o.w = cvt_pk_bf16(bf_lo(u4.w) * mx1.z * bf_lo(z4.w), bf_hi(u4.w) * mx1.w * bf_hi(z4.w));
                            *(v4u*)(up + C_U) = o; } }
                }
                __syncthreads();
            }
            { int gt1 = gt; asm volatile("" : "+v"(gt1));
              s1_items<8>(P, (bf16*)(ws + WS_Z), (const f32x2*)(ws + WS_TW), 0, 8, gt1, NGT);
              int gt2 = gt; asm volatile("" : "+v"(gt2));
              s1_items<16>(P, (bf16*)(ws + WS_Z), (const f32x2*)(ws + WS_TW) + 2048, MPR, 4, gt2, NGT); }
            VM_WAIT(); __syncthreads();
            if (BOTH(pb + 2)) GRID_BAR();
        }

        if (IN(pb + 3)) {
            PHASE_BEGIN();
            OrderD1 S{G, vcu, (const char*)(ws + WS_DC), (const char*)(ws + WS_Z)};
            EpiD1 E{(bf16*)(ws + WS_H)};
            pg8::gemm_phase<EpiD1, OrderD1, PG8_ALIGN, PG8_SP2>(wave0, lds + RING_OFF, 512, 4096, 512, S, E);
            if (BOTH(pb + 3)) GRID_BAR();
        }

        if (IN(pb + 4)) {
            PHASE_BEGIN();
            OrderD2 S{G, vcu, (const char*)(ws + WS_T), (const char*)(ws + WS_H)};
            EpiD2 E{(bf16*)(ws + WS_P)};
            pg8::gemm_phase<EpiD2, OrderD2, PG8_ALIGN, PG8_SP2>(wave0, lds + RING_OFF, 512, 512, 512, S, E);
            if (BOTH(pb + 4)) GRID_BAR();
        }

        if (IN(pb + 5)) {
            PHASE_BEGIN();
            OrderG2 S; S.o.init(MTOT / 256, DM / 256, G, bx, ws + WS_P + (size_t)C_U * 2, (size_t)256 * LDP * 2, ws + WS_WAT, (size_t)256 * DA * 2);
            S.A2 = (const char*)(ws + WS_P + (size_t)C_ZB * 2); S.B2 = (const char*)(ws + WS_WBT);
            Epi2G E{(const bf16*)(ws + WS_P), (bf16*)(ws + WS_H)};
            pg8::gemm_phase<Epi2G, OrderG2, PG8_ALIGN, PG8_SP2>(wave0, lds + RING_OFF, LDP, DA, DA, S, E);
            if (BOTH(pb + 5)) GRID_BAR();
        }

        if (IN(pb + 6)) {
            PHASE_BEGIN();
            pg8::OrderMN S; S.init(MTOT / 256, DM / 256, G, bx, ws + WS_H, (size_t)256 * DM * 2, ws + WS_WOT, (size_t)256 * DM * 2);
            Epi3 E{(bf16*)(ws + WS_X1), (l == 0) ? (float*)(ws + WS_PART) : (float*)nullptr};
            pg8::gemm_phase<Epi3, pg8::OrderMN, PG8_ALIGN, PG8_SP2>(wave0, lds + RING_OFF, DM, DM, DM, S, E);
            if (BOTH(pb + 6)) GRID_BAR();
        }
    }

    if (IN(14)) {
        PHASE_BEGIN();
        const float* final_g = AP->in[12];
        const bf16* X2 = (const bf16*)(ws + WS_X1);
        f32x4 g8[8][2];
#pragma unroll
        for (int j = 0; j < 8; ++j) { g8[j][0] = ((const GAS f32x4*)final_g)[2 * (lane + 64 * j)]; g8[j][1] = ((const GAS f32x4*)final_g)[2 * (lane + 64 * j) + 1]; }
        for (int m = gw; m < MTOT; m += NGW) rms_row_bf16_to_f32(X2 + (size_t)m * DM, g8, out + (size_t)m * DM, lane);
    }
#undef IN
#undef BOTH
}

extern "C" void kernel_launch(void* const* d_in, const int* in_sizes, int n_in, void* d_out, int out_size, void* d_ws, size_t ws_size, hipStream_t stream) {
    static int grid = 0;
    if (grid == 0) {
        if (n_in != 13 || out_size != MTOT * DM || ws_size < WS_END) { fprintf(stderr, "kernel_launch: unexpected shapes (n_in %d out %d ws %zu); nothing launched\n", n_in, out_size, ws_size); grid = -1; return; }
        int dev = 0, cus = 0, per_cu = 0;
        if (hipGetDevice(&dev) != hipSuccess || hipDeviceGetAttribute(&cus, hipDeviceAttributeMultiprocessorCount, dev) != hipSuccess) { grid = -1; return; }
        if (hipFuncSetAttribute((const void*)trunk_fwd, hipFuncAttributeMaxDynamicSharedMemorySize, LDS_BYTES) != hipSuccess) { fprintf(stderr, "kernel_launch: hipFuncSetAttribute failed\n"); grid = -1; return; }
        if (hipOccupancyMaxActiveBlocksPerMultiprocessor(&per_cu, (const void*)trunk_fwd, NWAVES * 64, LDS_BYTES) != hipSuccess || per_cu < 1)
            fprintf(stderr, "kernel_launch: note: occupancy query reports %d workgroups per CU\n", per_cu);
        (void)hipGetLastError();
        grid = cus;
    }
    if (grid < 0) return;
    if (hipMemsetAsync((char*)d_ws + WS_CTL, 0, CTL_ZERO_BYTES, stream) != hipSuccess) return;
    Args a{};
    for (int i = 0; i < 13; ++i) a.in[i] = (const float*)d_in[i];
    a.out = (float*)d_out; a.ws = (unsigned char*)d_ws;
#if MK_PER_PHASE
    for (int p = 0; p < N_PHASES; ++p) { a.ph_lo = p; a.ph_hi = p + 1; a.li = p;
        hipLaunchKernelGGL(trunk_fwd, dim3(grid), dim3(NWAVES * 64), LDS_BYTES, stream, a); }
#else
    a.ph_lo = 0; a.ph_hi = N_PHASES; a.li = 0;
    hipLaunchKernelGGL(trunk_fwd, dim3(grid), dim3(NWAVES * 64), LDS_BYTES, stream, a);
#endif
}
```
